# Optimizing an MI355X kernel written in HIP

```python
import jax, jax.numpy as jnp
from jax import lax
import numpy as np

D_MODEL = 1024
BATCH = 4
SEQ = 4096
DEPTH = 1

HEAD_DIM = 64
A_HEADS = 8
A_KV_HEADS = 2
A_GROUP = A_HEADS // A_KV_HEADS
A_HALF_WINDOW = 128
A_BLOCK = 128
B_HEADS = 8
DILATED_PATTERNS = ((128, 1), (512, 4), (2048, 16))
B_BLOCK = 64
A_Q = A_HEADS * HEAD_DIM
A_KV = A_KV_HEADS * HEAD_DIM
B_W = B_HEADS * HEAD_DIM
MIX_WIDTH = A_Q + B_W
IN_WIDTH = A_Q + 2 * A_KV + 3 * B_W
ROPE_THETA = 500000.0
ROT_DIM = HEAD_DIM // 4
N_EXPERTS = 16
CAPACITY_FACTOR = 2
EXPERT_FF = 2048
NORM_EPS = 1e-6
NEG_INF = -1e30

kernel_name = "hybrid_gqa_sink_dilated_ec_moe"


def rms_norm(x, g):
    xf = x.astype(jnp.float32)
    y = xf * lax.rsqrt(jnp.mean(xf * xf, axis=-1, keepdims=True) + NORM_EPS)
    return (y * g.astype(jnp.float32)).astype(x.dtype)


def rope_tables(seq_len):
    inv_freq = ROPE_THETA ** (-jnp.arange(0, ROT_DIM, 2, dtype=jnp.float32) / ROT_DIM)
    ang = jnp.arange(seq_len, dtype=jnp.float32)[:, None] * inv_freq[None, :]
    return jnp.cos(ang), jnp.sin(ang)


def partial_rope(x, cos, sin):
    half = ROT_DIM // 2
    shape = (1, x.shape[1]) + (1,) * (x.ndim - 3) + (half,)
    c = cos.reshape(shape)
    s = sin.reshape(shape)
    xf = x.astype(jnp.float32)
    x1, x2, rest = xf[..., :half], xf[..., half:ROT_DIM], xf[..., ROT_DIM:]
    out = jnp.concatenate([x1 * c - x2 * s, x2 * c + x1 * s, rest], axis=-1)
    return out.astype(x.dtype)


def banded_attention(q, k, v, half_window, block, sink=None):
    n, L, hk, g, dh = q.shape
    nb = -(-L // block)
    lp = nb * block
    pad = lp - L
    qp = jnp.pad(q, ((0, 0), (0, pad), (0, 0), (0, 0), (0, 0)))
    kp = jnp.pad(k, ((0, 0), (block, block + pad), (0, 0), (0, 0)))
    vp = jnp.pad(v, ((0, 0), (block, block + pad), (0, 0), (0, 0)))

    def windows(t):
        return jnp.concatenate(
            [t[:, i * block:i * block + lp].reshape(n, nb, block, hk, dh) for i in range(3)], axis=2)

    qb = qp.reshape(n, nb, block, hk, g, dh)
    kw, vw = windows(kp), windows(vp)
    qpos = jnp.arange(nb)[:, None] * block + jnp.arange(block)[None, :]
    kpos = (jnp.arange(nb)[:, None] - 1) * block + jnp.arange(3 * block)[None]
    rel = kpos[:, None, :] - qpos[:, :, None]
    valid = (jnp.abs(rel) <= half_window) & (kpos[:, None, :] >= 0) & (kpos[:, None, :] < L)

    s = jnp.einsum('nbqhgd,nbkhd->nbhgqk', qb.astype(jnp.float32), kw.astype(jnp.float32)) * (dh ** -0.5)
    s = jnp.where(valid[None, :, None, None], s, NEG_INF)
    m = jnp.max(s, axis=-1, keepdims=True)
    if sink is not None:
        sk = sink.astype(jnp.float32)[None, None, :, :, None, None]
        m = jnp.maximum(m, sk)
    p = jnp.exp(s - m)
    denom = jnp.sum(p, axis=-1, keepdims=True)
    if sink is not None:
        denom = denom + jnp.exp(sk - m)
    o = jnp.einsum('nbhgqk,nbkhd->nbhgqd', p, vw.astype(jnp.float32)) / denom
    lse = (m + jnp.log(denom))[..., 0]
    o = o.transpose(0, 1, 4, 2, 3, 5).reshape(n, lp, hk, g, dh)[:, :L]
    lse = lse.transpose(0, 1, 4, 2, 3).reshape(n, lp, hk, g)[:, :L]
    return o.astype(q.dtype), lse


def dilated_attention(q, k, v):
    b, s, h, dh = q.shape
    outs, lses = [], []
    for (w, d) in DILATED_PATTERNS:
        hw = w // (2 * d)

        def fold(t):
            return t.reshape(b, s // d, d, h, dh).transpose(0, 2, 1, 3, 4).reshape(b * d, s // d, h, dh)

        o, lse = banded_attention(fold(q)[:, :, :, None], fold(k), fold(v), hw, B_BLOCK)
        o = o[:, :, :, 0].reshape(b, d, s // d, h, dh).transpose(0, 2, 1, 3, 4).reshape(b, s, h, dh)
        lse = lse[..., 0].reshape(b, d, s // d, h).transpose(0, 2, 1, 3).reshape(b, s, h)
        outs.append(o.astype(jnp.float32))
        lses.append(lse)
    alpha = jax.nn.softmax(jnp.stack(lses, axis=0), axis=0)
    out = jnp.sum(alpha[..., None] * jnp.stack(outs, axis=0), axis=0)
    return out.astype(q.dtype)


def expert_choice_moe(h, w_router, w_gate, w_up, w_down):
    b, s, dm = h.shape
    cap = CAPACITY_FACTOR * s // N_EXPERTS
    logits = jnp.einsum('bsd,de->bse', h.astype(jnp.float32), w_router.astype(jnp.float32))
    affinity = jax.nn.softmax(logits, axis=-1)
    gates, idx = lax.top_k(jnp.swapaxes(affinity, 1, 2), cap)
    xe = jax.vmap(lambda hb, ib: hb[ib])(h, idx)
    a = jnp.einsum('becd,edf->becf', xe, w_gate)
    u = jnp.einsum('becd,edf->becf', xe, w_up)
    ye = jnp.einsum('becf,efd->becd', jax.nn.silu(a) * u, w_down)
    ye = ye * gates[..., None].astype(ye.dtype)
    out = jax.vmap(lambda yb, ib: jax.ops.segment_sum(
        yb.reshape(-1, dm), ib.reshape(-1), num_segments=s))(ye, idx)
    return out.astype(h.dtype)


def setup_inputs(seed: int = 0) -> dict:
    key = jax.random.key(seed)
    ks = jax.random.split(key, 14)
    f32 = jnp.float32
    nrm = lambda k, shape, fan: jax.random.normal(k, shape, f32) * (fan ** -0.5)
    gain = lambda k, shape: 1.0 + 0.02 * jax.random.normal(k, shape, f32)
    return {
        "x": jax.random.normal(ks[0], (BATCH, SEQ, D_MODEL), f32),
        "g_mix": gain(ks[1], (DEPTH, D_MODEL)),
        "w_in": nrm(ks[2], (DEPTH, D_MODEL, IN_WIDTH), D_MODEL),
        "a_sink": 0.5 * jax.random.normal(ks[3], (DEPTH, A_HEADS), f32),
        "g_out_a": gain(ks[4], (DEPTH, A_Q)),
        "g_out_b": gain(ks[5], (DEPTH, B_W)),
        "w_out": nrm(ks[6], (DEPTH, MIX_WIDTH, D_MODEL), MIX_WIDTH),
        "g_ffn": gain(ks[7], (DEPTH, D_MODEL)),
        "w_router": nrm(ks[8], (DEPTH, D_MODEL, N_EXPERTS), D_MODEL),
        "w_gate": nrm(ks[9], (DEPTH, N_EXPERTS, D_MODEL, EXPERT_FF), D_MODEL),
        "w_up": nrm(ks[10], (DEPTH, N_EXPERTS, D_MODEL, EXPERT_FF), D_MODEL),
        "w_down": nrm(ks[11], (DEPTH, N_EXPERTS, EXPERT_FF, D_MODEL), EXPERT_FF),
        "g_final": gain(ks[12], (D_MODEL,)),
    }


def reference(x, g_mix, w_in, a_sink, g_out_a, g_out_b, w_out, g_ffn,
              w_router, w_gate, w_up, w_down, g_final):
    b, s, _ = x.shape
    cos, sin = rope_tables(s)
    splits = np.cumsum([A_Q, A_KV, A_KV, B_W, B_W]).tolist()
    for l in range(DEPTH):
        h = rms_norm(x, g_mix[l])
        proj = jnp.einsum('bsd,de->bse', h, w_in[l])
        qa, ka, va, qb, kb, vb = jnp.split(proj, splits, axis=-1)
        qa = partial_rope(qa.reshape(b, s, A_KV_HEADS, A_GROUP, HEAD_DIM), cos, sin)
        ka = partial_rope(ka.reshape(b, s, A_KV_HEADS, HEAD_DIM), cos, sin)
        va = va.reshape(b, s, A_KV_HEADS, HEAD_DIM)
        oa, _ = banded_attention(qa, ka, va, A_HALF_WINDOW, A_BLOCK,
                                 sink=a_sink[l].reshape(A_KV_HEADS, A_GROUP))
        oa = oa.reshape(b, s, A_Q)
        qb = partial_rope(qb.reshape(b, s, B_HEADS, HEAD_DIM), cos, sin)
        kb = partial_rope(kb.reshape(b, s, B_HEADS, HEAD_DIM), cos, sin)
        vb = vb.reshape(b, s, B_HEADS, HEAD_DIM)
        ob = dilated_attention(qb, kb, vb).reshape(b, s, B_W)
        mixed = jnp.concatenate([rms_norm(oa, g_out_a[l]), rms_norm(ob, g_out_b[l])], axis=-1)
        x = x + jnp.einsum('bse,ed->bsd', mixed, w_out[l])
        h2 = rms_norm(x, g_ffn[l])
        x = x + expert_choice_moe(h2, w_router[l], w_gate[l], w_up[l], w_down[l])
    return rms_norm(x, g_final)
```

```cpp
#include <hip/hip_runtime.h>
#include <cstdio>
#include <cstdint>

#ifndef MK_N_LAUNCHES
#define MK_N_LAUNCHES 1
#endif

#define LAS __attribute__((address_space(3)))
#define GAS __attribute__((address_space(1)))
typedef unsigned short h16;
typedef _Float16 half8 __attribute__((ext_vector_type(8)));
typedef _Float16 half2v __attribute__((ext_vector_type(2)));
typedef short s16x4 __attribute__((ext_vector_type(4)));
typedef float f32x4 __attribute__((ext_vector_type(4)));
typedef float f32x16 __attribute__((ext_vector_type(16)));
typedef unsigned u32x2 __attribute__((ext_vector_type(2)));
typedef unsigned u32x4 __attribute__((ext_vector_type(4)));
typedef GAS unsigned gu32;

constexpr int BATCH = 4, SEQ = 4096, DM = 1024, M = BATCH * SEQ;
constexpr int NIN = 2304;
constexpr int OFF_QA = 0, OFF_KA = 512, OFF_VA = 640, OFF_QB = 768, OFF_KB = 1280, OFF_VB = 1792;
constexpr int NE = 16, CAP = 512, FF = 2048, EROWS = BATCH * CAP;
constexpr float NORM_EPS = 1e-6f;
constexpr float LOG2E = 1.4426950408889634f, LN2 = 0.6931471805599453f;
constexpr float QSCALE = 0.18033688011112042f;

constexpr size_t MiB = 1u << 20;
constexpr size_t WS_CTL = 0, CTL_ZERO_BYTES = 64 * 1024;
constexpr size_t WS_ROPE = 1 * MiB;
constexpr size_t WS_AFF = 2 * MiB;
constexpr size_t WS_TOK = 3 * MiB;
constexpr size_t WS_GATE = 3 * MiB + 256 * 1024;
constexpr size_t WS_SLOT = 4 * MiB;
constexpr size_t WS_LSE = 5 * MiB;
constexpr size_t WS_WIN = 8 * MiB;
constexpr size_t WS_WOUT = 13 * MiB;
constexpr size_t WS_WGU = 16 * MiB;
constexpr size_t WS_WD = 144 * MiB;
constexpr size_t WS_H = 208 * MiB;
constexpr size_t WS_PROJ = 240 * MiB;
constexpr size_t WS_OA = 312 * MiB;
constexpr size_t WS_OB = 328 * MiB;
constexpr size_t WS_HMID = 208 * MiB;
constexpr size_t WS_MIXED = 376 * MiB;
constexpr size_t WS_H2 = 408 * MiB;
constexpr size_t WS_YE = 376 * MiB;
constexpr size_t WS_END = 440 * MiB;
constexpr int CW_BAR = 1024;

constexpr int RING_BYTES = 131072;
constexpr int LDSCTL_OFF = 143360, MISC_OFF = LDSCTL_OFF + 320;
constexpr int LDS_BYTES = 147456;
constexpr int NWAVES = 8;

#define RLX_AGENT __ATOMIC_RELAXED, __HIP_MEMORY_SCOPE_AGENT
#define LDS_WAIT() asm volatile("s_waitcnt lgkmcnt(0)" ::: "memory")
#define VM_WAIT() asm volatile("s_waitcnt vmcnt(0)" ::: "memory")

__device__ __forceinline__ unsigned pk_h2(float lo, float hi) { half2v v = {(_Float16)lo, (_Float16)hi}; return __builtin_bit_cast(unsigned, v); }
__device__ __forceinline__ unsigned pk_h2_rtz(float lo, float hi) { return __builtin_bit_cast(unsigned, __builtin_amdgcn_cvt_pkrtz(lo, hi)); }
__device__ __forceinline__ float h2f(unsigned short b) { return (float)__builtin_bit_cast(_Float16, b); }
__device__ __forceinline__ float wave_sum(float v) {
#pragma unroll
    for (int o = 1; o < 64; o <<= 1) v += __shfl_xor(v, o);
    return v;
}

namespace pg8 {
constexpr int BM = 256, BK = 64, HALF = 128, HTB = HALF * BK * 2, STAGE_BYTES = 8 * HTB, NXCD = 8, WGM = 8;
__host__ __device__ __forceinline__ int lds_byte(int r, int c) { const int st = (r >> 4) * 2 + (c >> 5), rr = r & 15, cc = c & 31, ob = rr * 64 + cc * 2; return st * 1024 + (ob ^ (((ob >> 9) & 1) << 5)); }
__host__ __device__ __forceinline__ void stage_rc(int b, int& R, int& C) { const int st = b / 1024, sb = b % 1024, swz = sb ^ (((sb >> 9) & 1) << 5); R = (st >> 1) * 16 + swz / 64; C = (st & 1) * 32 + (swz % 64) / 2; }
__host__ __device__ __forceinline__ int perm32(int rho) { const int n = rho >> 4, i = rho & 15; return 8 * (i >> 2) + 4 * n + (i & 3); }

struct Unit { int pm, pn, g; };

struct DenseOrder {
    int nM, nN, nwg, G, c;
    __device__ void init(int M_, int N_, int G_, int c_) { nM = M_ / BM; nN = N_ / BM; nwg = nM * nN; G = G_; c = c_; }
    __device__ bool next(int i, Unit& u) const {
        const long L = (long)i * G + c; if (L >= nwg) return false;
        int wgid = (int)L; { const int q = nwg / NXCD, r = nwg % NXCD, xcd = wgid % NXCD, off = wgid / NXCD; wgid = (xcd < r ? xcd * (q + 1) : r * (q + 1) + (xcd - r) * q) + off; }
        const int nig = WGM * nN, gid = wgid / nig, fm = gid * WGM, gsz = (nM - fm) < WGM ? (nM - fm) : WGM;
        u.pm = fm + ((wgid % nig) % gsz); u.pn = (wgid % nig) / gsz; u.g = 0; return true;
    }
};
struct GroupOrder {
    int nPM, nPN, total, G, c;
    __device__ void init(int nPM_, int nPN_, int groups, int G_, int c_) { nPM = nPM_; nPN = nPN_; total = nPM_ * nPN_ * groups; G = G_; c = c_; }
    __device__ bool next(int i, Unit& u) const {
        const int L = i * G + c; if (L >= total) return false;
        const int per = nPM * nPN; u.g = L / per; const int rem = L % per; u.pn = rem / nPM; u.pm = rem % nPM; return true;
    }
};

struct DenseProb {
    const char* A; const char* Bt; int K;
    __device__ __forceinline__ unsigned a_row(const Unit& u, int r) const { return (unsigned)(u.pm * BM + r); }
    __device__ __forceinline__ const char* b_base(const Unit& u) const { return Bt + (size_t)u.pn * BM * K * 2; }
};
struct Moe1Prob {
    const char* A; const char* Bt; int K; const int* tok;
    __device__ __forceinline__ unsigned a_row(const Unit& u, int r) const { return (unsigned)tok[u.g * EROWS + u.pm * BM + r]; }
    __device__ __forceinline__ const char* b_base(const Unit& u) const { return Bt + ((size_t)u.g * 4096 + (size_t)u.pn * BM) * K * 2; }
};
struct Moe2Prob {
    const char* A; const char* Bt; int K;
    __device__ __forceinline__ unsigned a_row(const Unit& u, int r) const { return (unsigned)(u.g * EROWS + u.pm * BM + r); }
    __device__ __forceinline__ const char* b_base(const Unit& u) const { return Bt + ((size_t)u.g * 1024 + (size_t)u.pn * BM) * K * 2; }
};

struct EpiInProj {
    static constexpr bool PERM = true;
    h16* O; const float* rope;
    __device__ __forceinline__ void operator()(const f32x4 (&acc)[2][2][4][2], const Unit& u, int wr, int wc, int fr, int fq) const {
        const int row0 = u.pm * BM + wr * 64 + fr;
#pragma unroll
        for (int bj = 0; bj < 2; ++bj) {
            const int ct = u.pn * BM + bj * HALF;
            const bool rope_tile = (ct < OFF_VA) || (ct >= OFF_QB && ct < OFF_VB);
            const bool do_rope = rope_tile && ((wc & 1) == 0);
            const int col0 = ct + wc * 32 + 8 * fq;
#pragma unroll
            for (int ai = 0; ai < 2; ++ai)
#pragma unroll
                for (int m = 0; m < 4; ++m) {
                    const int row = row0 + ai * HALF + m * 16;
                    f32x4 v0 = acc[ai][bj][m][0], v1 = acc[ai][bj][m][1];
                    if (do_rope) {
                        f32x4 p0, p1;
#pragma unroll
                        for (int j = 0; j < 4; ++j) { p0[j] = __shfl_xor(v0[j], 16); p1[j] = __shfl_xor(v1[j], 16); }
                        const float* rp = rope + (size_t)(row & (SEQ - 1)) * 16;
                        const f32x4 c0 = *(const f32x4*)(rp), c1 = *(const f32x4*)(rp + 4), s0 = *(const f32x4*)(rp + 8), s1 = *(const f32x4*)(rp + 12);
                        const float sg = (fq == 0) ? -1.f : 1.f;
                        if (fq < 2) { v0 = v0 * c0 + (p0 * s0) * sg; v1 = v1 * c1 + (p1 * s1) * sg; }
                    }
                    u32x4 w; w.x = pk_h2(v0[0], v0[1]); w.y = pk_h2(v0[2], v0[3]); w.z = pk_h2(v1[0], v1[1]); w.w = pk_h2(v1[2], v1[3]);
                    *(u32x4*)(O + (size_t)row * NIN + col0) = w;
                }
        }
    }
};
struct EpiResidual {
    static constexpr bool PERM = false;
    const float* base; float* out;
    __device__ __forceinline__ void operator()(const f32x4 (&acc)[2][2][4][2], const Unit& u, int wr, int wc, int fr, int fq) const {
        const int row0 = u.pm * BM + wr * 64 + fr, col0 = u.pn * BM + wc * 32 + 4 * fq;
#pragma unroll
        for (int ai = 0; ai < 2; ++ai)
#pragma unroll
            for (int m = 0; m < 4; ++m) {
                const size_t off = (size_t)(row0 + ai * HALF + m * 16) * DM + col0;
#pragma unroll
                for (int bj = 0; bj < 2; ++bj)
#pragma unroll
                    for (int n = 0; n < 2; ++n) { const f32x4 b = *(const f32x4*)(base + off + bj * HALF + n * 16); *(f32x4*)(out + off + bj * HALF + n * 16) = b + acc[ai][bj][m][n]; }
            }
    }
};
struct EpiSwiGLU {
    static constexpr bool PERM = true;
    h16* O;
    __device__ __forceinline__ void operator()(const f32x4 (&acc)[2][2][4][2], const Unit& u, int wr, int wc, int fr, int fq) const {
        const int row0 = u.g * EROWS + u.pm * BM + wr * 64 + fr, col0 = u.pn * HALF + wc * 32 + 8 * fq;
#pragma unroll
        for (int ai = 0; ai < 2; ++ai)
#pragma unroll
            for (int m = 0; m < 4; ++m) {
                float r[8];
#pragma unroll
                for (int n = 0; n < 2; ++n)
#pragma unroll
                    for (int j = 0; j < 4; ++j) { const float a = acc[ai][0][m][n][j], up = acc[ai][1][m][n][j];
                        r[n * 4 + j] = a * __builtin_amdgcn_rcpf(1.0f + __builtin_amdgcn_exp2f(-a * LOG2E)) * up; }
                u32x4 w; w.x = pk_h2(r[0], r[1]); w.y = pk_h2(r[2], r[3]); w.z = pk_h2(r[4], r[5]); w.w = pk_h2(r[6], r[7]);
                *(u32x4*)(O + (size_t)(row0 + ai * HALF + m * 16) * FF + col0) = w;
            }
    }
};
struct EpiDown {
    static constexpr bool PERM = true;
    h16* O; const float* gate;
    __device__ __forceinline__ void operator()(const f32x4 (&acc)[2][2][4][2], const Unit& u, int wr, int wc, int fr, int fq) const {
        const int row0 = u.g * EROWS + u.pm * BM + wr * 64 + fr, col0 = u.pn * BM + wc * 32 + 8 * fq;
#pragma unroll
        for (int ai = 0; ai < 2; ++ai)
#pragma unroll
            for (int m = 0; m < 4; ++m) {
                const int row = row0 + ai * HALF + m * 16; const float gt = gate[row];
#pragma unroll
                for (int bj = 0; bj < 2; ++bj) { const f32x4 v0 = acc[ai][bj][m][0] * gt, v1 = acc[ai][bj][m][1] * gt;
                    u32x4 w; w.x = pk_h2(v0[0], v0[1]); w.y = pk_h2(v0[2], v0[3]); w.z = pk_h2(v1[0], v1[1]); w.w = pk_h2(v1[2], v1[3]);
                    *(u32x4*)(O + (size_t)row * DM + col0 + bj * HALF) = w; }
            }
    }
};

template <class Prob, class Epi, class Sched, bool ALIGN_EPI>
__device__ __forceinline__ void gemm_phase(LAS unsigned char* lds, const Prob P, const Sched& S, const Epi& E) {
    const int tid = threadIdx.x, wid = __builtin_amdgcn_readfirstlane(tid >> 6), lane = tid & 63, wr = wid >> 2, wc = wid & 3, fr = lane & 15, fq = lane >> 4;
    const int K = P.K, nt = K / BK;
    int RA[2]; unsigned CA2[2], voffB[2];
#pragma unroll
    for (int i = 0; i < 2; ++i) { int R, C; stage_rc(tid * 16 + i * 8192, R, C); const int Rb = Epi::PERM ? ((R & ~31) + perm32(R & 31)) : R;
        RA[i] = R; CA2[i] = (unsigned)C * 2u; voffB[i] = (unsigned)(Rb * K + C) * 2u; }
    const unsigned kstep = (unsigned)(BK * 2);
    const size_t hstep = (size_t)HALF * K * 2;
    const unsigned rowb = (unsigned)K * 2u;
    const unsigned ldsw = (unsigned)wid * 1024u;
    const int aoff = lds_byte(wr * 64 + fr, fq * 8), boff = lds_byte(wc * 32 + fr, fq * 8);
#define PG8_SA(b, h) (((b) * 2 + (h)) * HTB)
#define PG8_SB(b, h) ((4 + (b) * 2 + (h)) * HTB)
#define PG8_STAGE_B(bufoff, gbase) do { _Pragma("unroll") for (int _i = 0; _i < 2; ++_i) \
        __builtin_amdgcn_global_load_lds((const unsigned*)((const char*)(gbase) + voffB[_i]), (LAS unsigned*)(lds + (bufoff) + ldsw + _i * 8192), 16, 0, 0); } while (0)
#define PG8_STAGE_A(bufoff, kb, offs) do { _Pragma("unroll") for (int _i = 0; _i < 2; ++_i) \
        __builtin_amdgcn_global_load_lds((const unsigned*)(P.A + (size_t)(kb) + (offs)[_i]), (LAS unsigned*)(lds + (bufoff) + ldsw + _i * 8192), 16, 0, 0); } while (0)
#define PG8_LDA(dst, b, h) do { _Pragma("unroll") for (int m = 0; m < 4; ++m) _Pragma("unroll") for (int k = 0; k < 2; ++k) dst[m][k] = *(const LAS half8*)(lds + PG8_SA(b, h) + aoff + m * 2048 + k * 1024); } while (0)
#define PG8_LDB(dst, b, h) do { _Pragma("unroll") for (int n = 0; n < 2; ++n) _Pragma("unroll") for (int k = 0; k < 2; ++k) dst[n][k] = *(const LAS half8*)(lds + PG8_SB(b, h) + boff + n * 2048 + k * 1024); } while (0)
#define PG8_MMA(ai, bj, At, Bt) do { __builtin_amdgcn_s_setprio(1); _Pragma("unroll") for (int m = 0; m < 4; ++m) _Pragma("unroll") for (int n = 0; n < 2; ++n) _Pragma("unroll") for (int k = 0; k < 2; ++k) \
        acc[ai][bj][m][n] = __builtin_amdgcn_mfma_f32_16x16x32_f16(Bt[n][k], At[m][k], acc[ai][bj][m][n], 0, 0, 0); __builtin_amdgcn_s_setprio(0); } while (0)
#define PG8_WAIT_V(n) asm volatile("s_waitcnt vmcnt(" #n ")" ::: "memory")
#define PG8_WAIT_L(n) asm volatile("s_waitcnt lgkmcnt(" #n ")" ::: "memory")
#define PG8_BAR __builtin_amdgcn_s_barrier()
#define PG8_SCHED __builtin_amdgcn_sched_barrier(0)
#define PG8_AOFF(dst, un) do { _Pragma("unroll") for (int _h = 0; _h < 2; ++_h) _Pragma("unroll") for (int _i = 0; _i < 2; ++_i) dst[_h][_i] = P.a_row(un, _h * HALF + RA[_i]) * rowb + CA2[_i]; } while (0)
    Unit cur, nxt; int ui = 0;
    if (!S.next(0, cur)) return;
    f32x4 acc[2][2][4][2];
#pragma unroll
    for (int a = 0; a < 2; ++a)
#pragma unroll
        for (int b = 0; b < 2; ++b)
#pragma unroll
            for (int m = 0; m < 4; ++m)
#pragma unroll
                for (int n = 0; n < 2; ++n) acc[a][b][m][n] = (f32x4){0.f, 0.f, 0.f, 0.f};
    half8 At[4][2], B0[2][2], B1[2][2];
    unsigned cuo[2][2], nxo[2][2];
    PG8_AOFF(cuo, cur);
    const char* cB = P.b_base(cur);
    PG8_STAGE_B(PG8_SB(0, 0), cB); PG8_STAGE_B(PG8_SB(0, 1), cB + hstep); PG8_STAGE_A(PG8_SA(0, 0), 0, cuo[0]); PG8_STAGE_A(PG8_SA(0, 1), 0, cuo[1]);
    if (wr == 1) PG8_BAR;
    PG8_WAIT_V(2); PG8_BAR;
    PG8_STAGE_B(PG8_SB(1, 0), cB + kstep); PG8_STAGE_A(PG8_SA(1, 0), kstep, cuo[0]); PG8_STAGE_B(PG8_SB(1, 1), cB + hstep + kstep);
    PG8_WAIT_V(6); PG8_BAR;
    for (;;) {
        const bool has_next = S.next(ui + 1, nxt);
        if (!has_next) nxt = cur;
        PG8_AOFF(nxo, nxt);
        const char* nB = P.b_base(nxt);
        for (int t = 0; t < nt; t += 2) {
            const bool last = (t == nt - 2);
            const unsigned k1 = (unsigned)(t + 1) * kstep;
            const unsigned k2 = last ? 0u : (unsigned)(t + 2) * kstep, k3 = k2 + kstep;
            const char* b2 = last ? nB : cB + (size_t)(t + 2) * kstep; const char* b3 = b2 + kstep;
            unsigned o20[2], o21[2];
#pragma unroll
            for (int i = 0; i < 2; ++i) { o20[i] = last ? nxo[0][i] : cuo[0][i]; o21[i] = last ? nxo[1][i] : cuo[1][i]; }
            PG8_LDB(B0, 0, 0); PG8_LDB(B1, 0, 1); PG8_SCHED; PG8_LDA(At, 0, 0); PG8_STAGE_A(PG8_SA(1, 1), k1, cuo[1]);
            PG8_WAIT_V(8); PG8_WAIT_L(0); PG8_BAR; PG8_MMA(0, 0, At, B0); PG8_MMA(0, 1, At, B1); PG8_BAR; PG8_SCHED;
            PG8_LDA(At, 0, 1); PG8_STAGE_B(PG8_SB(0, 0), b2); PG8_STAGE_B(PG8_SB(0, 1), b2 + hstep); PG8_STAGE_A(PG8_SA(0, 0), k2, o20);
            PG8_WAIT_V(8); PG8_WAIT_L(0); PG8_BAR; PG8_MMA(1, 0, At, B0); PG8_MMA(1, 1, At, B1); PG8_BAR; PG8_SCHED;
            PG8_LDB(B0, 1, 0); PG8_LDB(B1, 1, 1); PG8_SCHED; PG8_LDA(At, 1, 0); PG8_STAGE_A(PG8_SA(0, 1), k2, o21);
            PG8_WAIT_V(8); PG8_WAIT_L(0); PG8_BAR; PG8_MMA(0, 0, At, B0); PG8_MMA(0, 1, At, B1); PG8_BAR; PG8_SCHED;
            PG8_LDA(At, 1, 1); PG8_STAGE_B(PG8_SB(1, 0), b3); PG8_STAGE_B(PG8_SB(1, 1), b3 + hstep); PG8_STAGE_A(PG8_SA(1, 0), k3, o20);
            PG8_WAIT_V(8); PG8_WAIT_L(0); PG8_BAR; PG8_MMA(1, 0, At, B0); PG8_MMA(1, 1, At, B1); PG8_BAR; PG8_SCHED;
        }
        if constexpr (ALIGN_EPI) { if (wr == 0) PG8_BAR; }
        E(acc, cur, wr, wc, fr, fq);
        if (!has_next) break;
#pragma unroll
        for (int a = 0; a < 2; ++a)
#pragma unroll
            for (int b = 0; b < 2; ++b)
#pragma unroll
                for (int m = 0; m < 4; ++m)
#pragma unroll
                    for (int n = 0; n < 2; ++n) acc[a][b][m][n] = (f32x4){0.f, 0.f, 0.f, 0.f};
        cur = nxt; cB = nB; ++ui;
#pragma unroll
        for (int h = 0; h < 2; ++h)
#pragma unroll
            for (int i = 0; i < 2; ++i) cuo[h][i] = nxo[h][i];
        if constexpr (ALIGN_EPI) { if (wr == 1) PG8_BAR; }
    }
    PG8_WAIT_V(0);
    if constexpr (!ALIGN_EPI) { if (wr == 0) PG8_BAR; }
    PG8_BAR;
#undef PG8_SA
#undef PG8_SB
#undef PG8_STAGE_A
#undef PG8_STAGE_B
#undef PG8_LDA
#undef PG8_LDB
#undef PG8_MMA
#undef PG8_WAIT_V
#undef PG8_WAIT_L
#undef PG8_BAR
#undef PG8_SCHED
#undef PG8_AOFF
}
}

#define XB_TMO      128
#define XB_XCNT(j)  (256  + 64 * (j))
#define XB_XSUB(j)  (1280 + 64 * (j))
#define XB_XGEN(j)  (2304 + 64 * (j))
#define XB_TOP      3328
#define XB_TOPGEN   3392
#define XCD_BAR_WORDS 3456
#define XB_SPIN_CAP (1u << 18)
__device__ __forceinline__ unsigned xb_ld(unsigned* p)              { return __hip_atomic_load(p, __ATOMIC_RELAXED, __HIP_MEMORY_SCOPE_AGENT); }
__device__ __forceinline__ unsigned xb_add(unsigned* p, unsigned v) { return __hip_atomic_fetch_add(p, v, __ATOMIC_RELAXED, __HIP_MEMORY_SCOPE_AGENT); }
__device__ __forceinline__ unsigned xb_xcc_id() { return (unsigned)__builtin_amdgcn_s_getreg((3 << 11) | 20) & 0xFu; }
#define XB_SPIN(cond, bar) do { unsigned _sp = 0; while (cond) { __builtin_amdgcn_s_sleep(1); \
    if ((++_sp & 255u) == 0u) { if (xb_ld(&(bar)[XB_TMO])) break; if (_sp > XB_SPIN_CAP) { atomicAdd(&(bar)[XB_TMO], 1u); break; } } } } while (0)
struct XcdBarrier { unsigned* bar; unsigned x; volatile LAS unsigned* st; };
__device__ __forceinline__ XcdBarrier xcd_barrier_post(unsigned* bar, volatile LAS unsigned* st) {
    XcdBarrier b; b.bar = bar; b.x = xb_xcc_id(); b.st = st;
    if (threadIdx.x == 0) (void)xb_add(&bar[XB_XCNT(b.x)], 1u);
    return b;
}
__device__ __forceinline__ void xcd_barrier_complete(unsigned* bar, unsigned x, unsigned& nloc, unsigned& nx) {
    const unsigned G = gridDim.x * gridDim.y * gridDim.z;
    unsigned sum, cnt, mine, sp = 0u;
    for (;;) {
        sum = 0u; cnt = 0u; mine = 0u;
#pragma unroll
        for (unsigned j = 0; j < 16; ++j) { const unsigned c = xb_ld(&bar[XB_XCNT(j)]); sum += c; cnt += (c > 0u) ? 1u : 0u; mine = (j == x) ? c : mine; }
        if (sum == G) break;
        __builtin_amdgcn_s_sleep(1);
        if ((++sp & 255u) == 0u) { if (xb_ld(&bar[XB_TMO])) break; if (sp > XB_SPIN_CAP) { atomicAdd(&bar[XB_TMO], 1u); break; } }
    }
    nloc = mine > 0u ? mine : 1u; nx = cnt > 0u ? cnt : 1u;
}
__device__ __forceinline__ void xcd_barrier(const XcdBarrier& b) {
    asm volatile("s_waitcnt vmcnt(0)" ::: "memory");
    __syncthreads();
    if (threadIdx.x == 0) {
        unsigned* bar = b.bar;
        __builtin_amdgcn_s_waitcnt(0);
        unsigned nloc = b.st[0], nx = b.st[1];
        if (nloc == 0u) { xcd_barrier_complete(bar, b.x, nloc, nx); b.st[0] = nloc; b.st[1] = nx; }
        const unsigned old = xb_add(&bar[XB_XSUB(b.x)], 1u);
        const unsigned gen = old / nloc;
        if (old + 1u == (gen + 1u) * nloc) {
            __builtin_amdgcn_fence(__ATOMIC_RELEASE, "agent");
            asm volatile("s_waitcnt vmcnt(0)" ::: "memory");
            const unsigned og = xb_add(&bar[XB_TOP], 1u);
            const unsigned tg = og / nx;
            if (og + 1u == (tg + 1u) * nx) xb_add(&bar[XB_TOPGEN], 1u);
            else XB_SPIN(xb_ld(&bar[XB_TOPGEN]) == tg, bar);
            __builtin_amdgcn_fence(__ATOMIC_ACQUIRE, "agent");
            xb_add(&bar[XB_XGEN(b.x)], 1u);
            asm volatile("s_waitcnt vmcnt(0)" ::: "memory");
        } else {
            XB_SPIN(xb_ld(&bar[XB_XGEN(b.x)]) == gen, bar);
            __builtin_amdgcn_fence(__ATOMIC_ACQUIRE, "agent");
            asm volatile("s_waitcnt vmcnt(0)" ::: "memory");
        }
    }
    __syncthreads();
}

struct Frame {
    LAS unsigned char* lds;
    int tid, lane, wave, vcu, G;
    const float *x, *g_mix, *w_in, *a_sink, *g_out_a, *g_out_b, *w_out, *g_ffn, *w_router, *w_gate, *w_up, *w_down, *g_final;
    float* out; unsigned char* ws;
};

__device__ __forceinline__ void p0_transpose_item(const float* W, int K, int N, h16* WT, int k0, int n0, int drow0, float sc, LAS float* scr, int lane) {
#pragma unroll 8
    for (int i = 0; i < 32; ++i) { const int kk = 2 * i + (lane >> 5); scr[kk * 33 + (lane & 31)] = W[(size_t)(k0 + kk) * N + n0 + (lane & 31)]; }
    LDS_WAIT(); asm volatile("" ::: "memory");
    const int c = lane & 7;
#pragma unroll
    for (int j = 0; j < 4; ++j) { const int n = (lane >> 3) + 8 * j; const LAS float* s = scr + (8 * c) * 33 + n;
        u32x4 o; o.x = pk_h2(s[0 * 33] * sc, s[1 * 33] * sc); o.y = pk_h2(s[2 * 33] * sc, s[3 * 33] * sc); o.z = pk_h2(s[4 * 33] * sc, s[5 * 33] * sc); o.w = pk_h2(s[6 * 33] * sc, s[7 * 33] * sc);
        *(GAS u32x4*)(WT + (size_t)(drow0 + n) * K + k0 + 8 * c) = o; }
    LDS_WAIT(); asm volatile("" ::: "memory");
}
__device__ __forceinline__ void sincos_d(double a, float& s, float& c) {
    const double q = __builtin_rint(a * 0.63661977236758134308);
    double r = __builtin_fma(-q, 1.570796325802803, a); r = __builtin_fma(-q, 9.920935796805404e-10, r);
    const double r2 = r * r;
    double sp = -7.6471637318198164759e-13;
    sp = sp * r2 + 1.6059043836821614599e-10; sp = sp * r2 - 2.5052108385441718775e-08; sp = sp * r2 + 2.7557319223985890653e-06;
    sp = sp * r2 - 1.9841269841269841270e-04; sp = sp * r2 + 8.3333333333333333333e-03; sp = sp * r2 - 1.6666666666666666667e-01;
    const double sn = r + r * r2 * sp;
    double cp = 4.7794773323873852974e-14;
    cp = cp * r2 - 1.1470745597729724714e-11; cp = cp * r2 + 2.0876756987868098979e-09; cp = cp * r2 - 2.7557319223985890653e-07;
    cp = cp * r2 + 2.4801587301587301587e-05; cp = cp * r2 - 1.3888888888888888889e-03; cp = cp * r2 + 4.1666666666666666667e-02; cp = cp * r2 - 0.5;
    const double cs = 1.0 + r2 * cp;
    const int qi = (int)q & 3;
    const double ss = (qi & 1) ? cs : sn, cc = (qi & 1) ? sn : cs;
    s = (float)((qi & 2) ? -ss : ss); c = (float)(((qi + 1) & 2) ? -cc : cc);
}

__device__ __forceinline__ void p0_prologue(Frame& F) {
    LAS float* scr = (LAS float*)(F.lds + F.wave * 16384);
    const int gw = F.vcu * NWAVES + F.wave, NGW = F.G * NWAVES;
    {
        const double invf[8] = {1.0, 0.19392274474868576, 0.03760603093086393, 0.007292664737217109, 0.001414213562373095, 0.0002742481756762073, 5.318295896944988e-05, 1.031338537721246e-05};
        float* rope = (float*)(F.ws + WS_ROPE);
        for (int idx = F.vcu * 512 + F.tid; idx < SEQ * 8; idx += F.G * 512) {
            const int pos = idx >> 3, i = idx & 7;
            double f = invf[0];
#pragma unroll
            for (int j = 1; j < 8; ++j) f = (i == j) ? invf[j] : f;
            float s, c; sincos_d((double)pos * f, s, c);
            rope[pos * 16 + i] = c; rope[pos * 16 + 8 + i] = s;
        }
    }
    {
        h16* H = (h16*)(F.ws + WS_H);
        for (int m = gw; m < M; m += NGW) {
            const GAS f32x4* xr = (const GAS f32x4*)(F.x + (size_t)m * DM) + F.lane;
            f32x4 v[4]; float s = 0.f;
#pragma unroll
            for (int j = 0; j < 4; ++j) { v[j] = xr[64 * j]; s += (v[j].x * v[j].x + v[j].y * v[j].y) + (v[j].z * v[j].z + v[j].w * v[j].w); }
            const float rs = 1.0f / sqrtf(wave_sum(s) * (1.0f / DM) + NORM_EPS);
            GAS u32x2* o8 = (GAS u32x2*)(H + (size_t)m * DM) + F.lane;
#pragma unroll
            for (int j = 0; j < 4; ++j) { const f32x4 g = ((const GAS f32x4*)F.g_mix)[F.lane + 64 * j]; const f32x4 y = v[j] * rs * g;
                u32x2 w; w.x = pk_h2(y.x, y.y); w.y = pk_h2(y.z, y.w); o8[64 * j] = w; }
        }
    }
    {
        constexpr int I_IN = (DM / 64) * (NIN / 32), I_OUT = (DM / 64) * (DM / 32), I_G = (DM / 64) * (FF / 32), I_D = (FF / 64) * (DM / 32);
        constexpr int NITEMS = I_IN + I_OUT + NE * (2 * I_G + I_D);
        for (int it = gw; it < NITEMS; it += NGW) {
            int r = it;
            if (r < I_IN) { const int nblk = NIN / 32, kb = r / nblk, nb = r % nblk, n0 = 32 * nb;
                const float sc = (n0 < OFF_KA || (n0 >= OFF_QB && n0 < OFF_KB)) ? QSCALE : 1.0f;
                p0_transpose_item(F.w_in, DM, NIN, (h16*)(F.ws + WS_WIN), 64 * kb, n0, n0, sc, scr, F.lane); continue; }
            r -= I_IN;
            if (r < I_OUT) { const int nblk = DM / 32, kb = r / nblk, nb = r % nblk, n0 = 32 * nb;
                p0_transpose_item(F.w_out, DM, DM, (h16*)(F.ws + WS_WOUT), 64 * kb, n0, n0, 1.0f, scr, F.lane); continue; }
            r -= I_OUT;
            const int e = r / (2 * I_G + I_D); r -= e * (2 * I_G + I_D);
            if (r < 2 * I_G) { const int which = r / I_G; r -= which * I_G; const int nblk = FF / 32, kb = r / nblk, nb = r % nblk, n0 = 32 * nb;
                const float* W = (which ? F.w_up : F.w_gate) + (size_t)e * DM * FF;
                p0_transpose_item(W, DM, FF, (h16*)(F.ws + WS_WGU) + (size_t)e * 4096 * DM, 64 * kb, n0, (n0 >> 7) * 256 + which * 128 + (n0 & 127), 1.0f, scr, F.lane); continue; }
            r -= 2 * I_G;
            { const int nblk = DM / 32, kb = r / nblk, nb = r % nblk, n0 = 32 * nb;
              p0_transpose_item(F.w_down + (size_t)e * FF * DM, FF, DM, (h16*)(F.ws + WS_WD) + (size_t)e * DM * FF, 64 * kb, n0, n0, 1.0f, scr, F.lane); }
        }
    }
}

namespace att {
__device__ __forceinline__ int crow(int r, int hi) { return (r & 3) + 8 * (r >> 2) + 4 * hi; }
constexpr float THR = 8.0f;
constexpr int TILE_BYTES = 16384;
constexpr int WSF_OFF = 98304, STG_OFF = 100352;

__device__ __forceinline__ void tile_step(f32x16& o0, f32x16& o1, float& m, float& l, const half8 (&qr)[4],
                                          LAS const unsigned char* kt, LAS const unsigned char* vt, LAS float* wsf, int lane, int r32, int hi,
                                          bool need_mask, int rel0, int lo, unsigned span) {
    f32x16 p0, p1;
#pragma unroll
    for (int r = 0; r < 16; ++r) { p0[r] = 0.f; p1[r] = 0.f; }
    LAS const unsigned char* kb = kt + hi * 1024 + r32 * 16;
#pragma unroll
    for (int d0 = 0; d0 < 4; ++d0) {
        const half8 a0 = *(LAS const half8*)(kb + d0 * 2048), a1 = *(LAS const half8*)(kb + d0 * 2048 + 512);
        p0 = __builtin_amdgcn_mfma_f32_32x32x16_f16(a0, qr[d0], p0, 0, 0, 0);
        p1 = __builtin_amdgcn_mfma_f32_32x32x16_f16(a1, qr[d0], p1, 0, 0, 0);
    }
    if (need_mask) {
        const float NINF = -__builtin_inff();
#pragma unroll
        for (int r = 0; r < 16; ++r) { const int rel = rel0 + (r & 3) + 8 * (r >> 2);
            if ((unsigned)(rel - lo) > span) p0[r] = NINF;
            if ((unsigned)(rel + 32 - lo) > span) p1[r] = NINF; }
    }
    float rm = fmaxf(p0[0], p1[0]);
#pragma unroll
    for (int r = 1; r < 16; ++r) rm = fmaxf(rm, fmaxf(p0[r], p1[r]));
    { auto rr = __builtin_amdgcn_permlane32_swap(__float_as_uint(rm), __float_as_uint(rm), false, false); rm = fmaxf(__uint_as_float(rr[0]), __uint_as_float(rr[1])); }
    if (__any(rm > m + THR)) {
        const float mn = fmaxf(m, rm); const float f = __builtin_amdgcn_exp2f(m - mn); l *= f; m = mn;
        if (hi == 0) wsf[r32] = f;
        LDS_WAIT();
#pragma unroll
        for (int r = 0; r < 16; ++r) { const float fr_ = wsf[crow(r, hi)]; o0[r] *= fr_; o1[r] *= fr_; }
    }
    float s = 0.f;
#pragma unroll
    for (int r = 0; r < 16; ++r) { p0[r] = __builtin_amdgcn_exp2f(p0[r] - m); p1[r] = __builtin_amdgcn_exp2f(p1[r] - m); s += p0[r] + p1[r]; }
    l += s;
    u32x4 pw[4];
#pragma unroll
    for (int j = 0; j < 4; ++j) { pw[0][j] = pk_h2_rtz(p0[2 * j], p0[2 * j + 1]); pw[1][j] = pk_h2_rtz(p0[8 + 2 * j], p0[9 + 2 * j]);
                                  pw[2][j] = pk_h2_rtz(p1[2 * j], p1[2 * j + 1]); pw[3][j] = pk_h2_rtz(p1[8 + 2 * j], p1[9 + 2 * j]); }
    LAS const unsigned char* vb = vt + (4 * hi + ((lane & 15) >> 2)) * 64 + ((lane >> 4) & 1) * 32 + (lane & 3) * 8;
#pragma unroll
    for (int ks = 0; ks < 4; ++ks) {
        const half8 pa = __builtin_bit_cast(half8, pw[ks]);
#pragma unroll
        for (int d0 = 0; d0 < 2; ++d0) {
            const s16x4 vlo = __builtin_amdgcn_ds_read_tr16_b64_v4i16((LAS s16x4*)(vb + d0 * 4096 + ks * 1024));
            const s16x4 vhi = __builtin_amdgcn_ds_read_tr16_b64_v4i16((LAS s16x4*)(vb + d0 * 4096 + ks * 1024 + 512));
            typedef short s16x8 __attribute__((ext_vector_type(8)));
            const s16x8 vv = {vlo[0], vlo[1], vlo[2], vlo[3], vhi[0], vhi[1], vhi[2], vhi[3]};
            const half8 vf = __builtin_bit_cast(half8, vv);
            if (d0 == 0) o0 = __builtin_amdgcn_mfma_f32_32x32x16_f16(pa, vf, o0, 0, 0, 0);
            else         o1 = __builtin_amdgcn_mfma_f32_32x32x16_f16(pa, vf, o1, 0, 0, 0);
        }
    }
}

__device__ __forceinline__ void load_tile_regs(u32x4& kreg, u32x4& vreg, const h16* proj, int tokb, int dil, int LF, int tt0, int kcol, int vcol, int wid, int lane) {
    int tk = tt0 + lane; tk = tk < 0 ? 0 : (tk >= LF ? LF - 1 : tk);
    kreg = *(const u32x4*)(proj + (size_t)(tokb + tk * dil) * NIN + kcol + wid * 8);
    int tv = tt0 + (wid & 3) * 16 + (lane >> 2); tv = tv < 0 ? 0 : (tv >= LF ? LF - 1 : tv);
    vreg = *(const u32x4*)(proj + (size_t)(tokb + tv * dil) * NIN + vcol + (wid >> 2) * 32 + (lane & 3) * 8);
}

template <int NT>
__device__ __forceinline__ void load_tiles(LAS unsigned char* L, const h16* proj, int tokb, int dil, int LF, int tt_first, int kcol, int vcol, int wid, int lane) {
    u32x4 kr[NT], vr[NT];
#pragma unroll
    for (int j = 0; j < NT; ++j) { const int tt0 = tt_first + 64 * j; if (tt0 >= 0 && tt0 < LF) load_tile_regs(kr[j], vr[j], proj, tokb, dil, LF, tt0, kcol, vcol, wid, lane); }
#pragma unroll
    for (int j = 0; j < NT; ++j) { const int tt0 = tt_first + 64 * j; if (tt0 >= 0 && tt0 < LF) {
        *(LAS u32x4*)(L + j * TILE_BYTES + wid * 1024 + lane * 16) = kr[j];
        *(LAS u32x4*)(L + j * TILE_BYTES + 8192 + wid * 1024 + lane * 16) = vr[j]; } }
}

__device__ __forceinline__ void store_out(const f32x16& o0, const f32x16& o1, float l_tot, LAS float* wsf, LAS h16* stg, h16* dst, size_t pitch, int tok0, int dil, int lane, int r32, int hi) {
    if (hi == 0) wsf[32 + r32] = l_tot;
    LDS_WAIT();
#pragma unroll
    for (int r = 0; r < 16; ++r) { const int orow = crow(r, hi); const float rl = __builtin_amdgcn_rcpf(wsf[32 + orow]);
        stg[orow * 64 + r32] = __builtin_bit_cast(h16, (_Float16)(o0[r] * rl)); stg[orow * 64 + 32 + r32] = __builtin_bit_cast(h16, (_Float16)(o1[r] * rl)); }
    LDS_WAIT();
#pragma unroll
    for (int i = 0; i < 4; ++i) { const int row = i * 8 + (lane >> 3), ch = lane & 7; const u32x4 v = *(LAS const u32x4*)(stg + row * 64 + ch * 8);
        *(u32x4*)(dst + (size_t)(tok0 + row * dil) * pitch + ch * 8) = v; }
    LDS_WAIT();
}

__device__ __forceinline__ void attn_phase(Frame& F) {
    const int lane = F.lane, wid = F.wave, r32 = lane & 31, hi = lane >> 5;
    LAS unsigned char* L = F.lds;
    LAS float* wsf = (LAS float*)(L + WSF_OFF) + wid * 64;
    LAS h16* stg = (LAS h16*)(L + STG_OFF + wid * 4096);
    const h16* proj = (const h16*)(F.ws + WS_PROJ);
    for (int u = F.vcu; u < 2048; u += F.G) {
        if (u < 512) {
            const int qb = u & 63, g = (u >> 6) & 1, b = u >> 7, q0 = qb * 64, tokb = b * SEQ;
            load_tiles<5>(L, proj, tokb, 1, SEQ, q0 - 128, OFF_KA + g * 64, OFF_VA + g * 64, wid, lane);
            const int head = 4 * g + (wid & 3), sub = wid >> 2, tq = q0 + 32 * sub + r32;
            half8 qr[4];
            { const h16* qp = proj + (size_t)(tokb + tq) * NIN + OFF_QA + head * 64 + hi * 8;
#pragma unroll
              for (int d0 = 0; d0 < 4; ++d0) qr[d0] = *(const half8*)(qp + d0 * 16); }
            f32x16 o0, o1;
#pragma unroll
            for (int r = 0; r < 16; ++r) { o0[r] = 0.f; o1[r] = 0.f; }
            float m = F.a_sink[head] * LOG2E, l = (hi == 0) ? 1.0f : 0.0f;
            const int lo = (-128 > -tq) ? -128 : -tq, hi_ = (128 < SEQ - 1 - tq) ? 128 : (SEQ - 1 - tq); const unsigned span = (unsigned)(hi_ - lo);
            __syncthreads();
#pragma unroll 1
            for (int j = 0; j < 5; ++j) {
                const int tt0 = q0 - 128 + 64 * j; if (tt0 < 0 || tt0 >= SEQ) continue;
                const int qw0 = q0 + 32 * sub;
                const bool need_mask = (tt0 - (qw0 + 31) < -128) || (tt0 + 63 - qw0 > 128);
                tile_step(o0, o1, m, l, qr, L + j * TILE_BYTES, L + j * TILE_BYTES + 8192, wsf, lane, r32, hi, need_mask, tt0 + 4 * hi - tq, lo, span);
            }
            { auto rr = __builtin_amdgcn_permlane32_swap(__float_as_uint(l), __float_as_uint(l), false, false); l = __uint_as_float(rr[0]) + __uint_as_float(rr[1]); }
            store_out(o0, o1, l, wsf, stg, (h16*)(F.ws + WS_OA) + head * 64, 512, tokb + q0 + 32 * sub, 1, lane, r32, hi);
            __syncthreads();
        } else {
            const int v = u - 512, u16 = v & 15, p = (v >> 4) % 3, bh = v / 48, h = bh & 7, b = bh >> 3;
            const int sh = 2 * p, dil = 1 << sh, LF = SEQ >> sh, res = u16 & (dil - 1), qb = u16 >> sh, tokb = b * SEQ + res;
            load_tiles<6>(L, proj, tokb, dil, LF, 256 * qb - 64, OFF_KB + h * 64, OFF_VB + h * 64, wid, lane);
            const int tq = 256 * qb + 32 * wid + r32;
            half8 qr[4];
            { const h16* qp = proj + (size_t)(tokb + tq * dil) * NIN + OFF_QB + h * 64 + hi * 8;
#pragma unroll
              for (int d0 = 0; d0 < 4; ++d0) qr[d0] = *(const half8*)(qp + d0 * 16); }
            f32x16 o0, o1;
#pragma unroll
            for (int r = 0; r < 16; ++r) { o0[r] = 0.f; o1[r] = 0.f; }
            float m = -1e30f, l = 0.f;
            const int lo = (-64 > -tq) ? -64 : -tq, hi_ = (64 < LF - 1 - tq) ? 64 : (LF - 1 - tq); const unsigned span = (unsigned)(hi_ - lo);
            __syncthreads();
            const int j0 = wid >> 1;
#pragma unroll 1
            for (int jj = 0; jj < 3; ++jj) {
                const int j = j0 + jj, tt0 = 256 * qb - 64 + 64 * j; if (tt0 < 0 || tt0 >= LF) continue;
                const int qw0 = 256 * qb + 32 * wid;
                const bool need_mask = (tt0 - (qw0 + 31) < -64) || (tt0 + 63 - qw0 > 64);
                tile_step(o0, o1, m, l, qr, L + j * TILE_BYTES, L + j * TILE_BYTES + 8192, wsf, lane, r32, hi, need_mask, tt0 + 4 * hi - tq, lo, span);
            }
            { auto rr = __builtin_amdgcn_permlane32_swap(__float_as_uint(l), __float_as_uint(l), false, false); l = __uint_as_float(rr[0]) + __uint_as_float(rr[1]); }
            if (hi == 0) ((float*)(F.ws + WS_LSE))[((size_t)p * M + tokb + tq * dil) * 8 + h] = (m + __builtin_amdgcn_logf(l)) * LN2;
            store_out(o0, o1, l, wsf, stg, (h16*)(F.ws + WS_OB) + (size_t)p * M * 512 + h * 64, 512, tokb + (256 * qb + 32 * wid) * dil, dil, lane, r32, hi);
            __syncthreads();
        }
    }
}
}

__device__ __forceinline__ void p3_combine(Frame& F) {
    const int gw = F.vcu * NWAVES + F.wave, NGW = F.G * NWAVES, lane = F.lane;
    const h16* OA = (const h16*)(F.ws + WS_OA); const h16* OB = (const h16*)(F.ws + WS_OB); const float* LSE = (const float*)(F.ws + WS_LSE);
    h16* MX = (h16*)(F.ws + WS_MIXED);
    f32x4 ga[2], gb[2];
#pragma unroll
    for (int i = 0; i < 2; ++i) { ga[i] = *(const f32x4*)(F.g_out_a + 8 * lane + 4 * i); gb[i] = *(const f32x4*)(F.g_out_b + 8 * lane + 4 * i); }
    for (int t = gw; t < M; t += NGW) {
        const u32x4 ra = *(const u32x4*)(OA + (size_t)t * 512 + 8 * lane);
        u32x4 rb[3]; float ls[3];
#pragma unroll
        for (int p = 0; p < 3; ++p) { rb[p] = *(const u32x4*)(OB + ((size_t)p * M + t) * 512 + 8 * lane); ls[p] = LSE[((size_t)p * M + t) * 8 + (lane >> 3)]; }
        float a[8], bsum[8];
#pragma unroll
        for (int i = 0; i < 4; ++i) { a[2 * i] = h2f((unsigned short)(ra[i] & 0xffffu)); a[2 * i + 1] = h2f((unsigned short)(ra[i] >> 16)); }
        const float mx = fmaxf(ls[0], fmaxf(ls[1], ls[2]));
        float w[3]; float ws_ = 0.f;
#pragma unroll
        for (int p = 0; p < 3; ++p) { w[p] = __expf(ls[p] - mx); ws_ += w[p]; }
        const float inv = 1.0f / ws_;
#pragma unroll
        for (int i = 0; i < 8; ++i) bsum[i] = 0.f;
#pragma unroll
        for (int p = 0; p < 3; ++p) { const float wp = w[p] * inv;
#pragma unroll
            for (int i = 0; i < 4; ++i) { bsum[2 * i] += wp * h2f((unsigned short)(rb[p][i] & 0xffffu)); bsum[2 * i + 1] += wp * h2f((unsigned short)(rb[p][i] >> 16)); } }
        float sa = 0.f, sb = 0.f;
#pragma unroll
        for (int i = 0; i < 8; ++i) { sa += a[i] * a[i]; sb += bsum[i] * bsum[i]; }
        const float rsa = 1.0f / sqrtf(wave_sum(sa) * (1.0f / 512.0f) + NORM_EPS), rsb = 1.0f / sqrtf(wave_sum(sb) * (1.0f / 512.0f) + NORM_EPS);
        u32x4 wa, wb;
#pragma unroll
        for (int i = 0; i < 4; ++i) { wa[i] = pk_h2(a[2 * i] * rsa * ga[i >> 1][(2 * i) & 3], a[2 * i + 1] * rsa * ga[i >> 1][(2 * i + 1) & 3]);
                                      wb[i] = pk_h2(bsum[2 * i] * rsb * gb[i >> 1][(2 * i) & 3], bsum[2 * i + 1] * rsb * gb[i >> 1][(2 * i + 1) & 3]); }
        *(u32x4*)(MX + (size_t)t * DM + 8 * lane) = wa;
        *(u32x4*)(MX + (size_t)t * DM + 512 + 8 * lane) = wb;
    }
}

__device__ __forceinline__ void p5_router(Frame& F) {
    const int gw = F.vcu * NWAVES + F.wave, NGW = F.G * NWAVES, lane = F.lane;
    LAS unsigned char* L = F.lds;
    for (int i = F.tid; i < DM * 4; i += NWAVES * 64) { const int k = i >> 2, c = i & 3; *(LAS f32x4*)(L + k * 64 + (k >> 2) * 16 + c * 16) = *(const f32x4*)(F.w_router + k * 16 + c * 4); }
    __syncthreads();
    const float* X1 = F.out; h16* H2 = (h16*)(F.ws + WS_H2); float* AFF = (float*)(F.ws + WS_AFF);
    f32x4 g[4];
#pragma unroll
    for (int j = 0; j < 4; ++j) g[j] = ((const f32x4*)F.g_ffn)[lane + 64 * j];
    for (int t = gw; t < M; t += NGW) {
        const f32x4* xr = (const f32x4*)(X1 + (size_t)t * DM) + lane;
        f32x4 v[4]; float s = 0.f;
#pragma unroll
        for (int j = 0; j < 4; ++j) { v[j] = xr[64 * j]; s += (v[j].x * v[j].x + v[j].y * v[j].y) + (v[j].z * v[j].z + v[j].w * v[j].w); }
        const float rs = 1.0f / sqrtf(wave_sum(s) * (1.0f / DM) + NORM_EPS);
        u32x2* o8 = (u32x2*)(H2 + (size_t)t * DM) + lane;
        float acc[16];
#pragma unroll
        for (int e = 0; e < 16; ++e) acc[e] = 0.f;
#pragma unroll
        for (int j = 0; j < 4; ++j) {
            const f32x4 y = v[j] * rs * g[j];
            u32x2 w; w.x = pk_h2(y.x, y.y); w.y = pk_h2(y.z, y.w); o8[64 * j] = w;
#pragma unroll
            for (int c = 0; c < 4; ++c) {
                const int k = 256 * j + 4 * lane + c; LAS const f32x4* wr = (LAS const f32x4*)(L + k * 64 + (k >> 2) * 16);
#pragma unroll
                for (int q = 0; q < 4; ++q) { const f32x4 wv = wr[q];
#pragma unroll
                    for (int z = 0; z < 4; ++z) acc[4 * q + z] += y[c] * wv[z]; }
                if (c & 1) asm volatile("" ::: "memory");
            }
        }
        { const bool up = (lane & 32) != 0;
#pragma unroll
          for (int i = 0; i < 8; ++i) { const float send = up ? acc[i] : acc[i + 8], keep = up ? acc[i + 8] : acc[i]; acc[i] = keep + __shfl_xor(send, 32); } }
        { const bool up = (lane & 16) != 0;
#pragma unroll
          for (int i = 0; i < 4; ++i) { const float send = up ? acc[i] : acc[i + 4], keep = up ? acc[i + 4] : acc[i]; acc[i] = keep + __shfl_xor(send, 16); } }
        { const bool up = (lane & 8) != 0;
#pragma unroll
          for (int i = 0; i < 2; ++i) { const float send = up ? acc[i] : acc[i + 2], keep = up ? acc[i + 2] : acc[i]; acc[i] = keep + __shfl_xor(send, 8); } }
        float lg;
        { const bool up = (lane & 4) != 0; const float send = up ? acc[0] : acc[1], keep = up ? acc[1] : acc[0]; lg = keep + __shfl_xor(send, 4); }
        lg += __shfl_xor(lg, 2); lg += __shfl_xor(lg, 1);
        float mx = lg;
#pragma unroll
        for (int o = 4; o < 64; o <<= 1) mx = fmaxf(mx, __shfl_xor(mx, o));
        const float ex = __expf(lg - mx); float sm = ex;
#pragma unroll
        for (int o = 4; o < 64; o <<= 1) sm += __shfl_xor(sm, o);
        if ((lane & 3) == 0) { const int e = lane >> 2, b = t >> 12, sidx = t & (SEQ - 1); AFF[((size_t)(b * NE + e)) * SEQ + sidx] = ex / sm; }
    }
}

__device__ __forceinline__ void p6_topk(Frame& F) {
    LAS unsigned* cnt = (LAS unsigned*)F.lds;
    const int tid = F.tid, lane = F.lane, wid = F.wave;
    const float* AFF = (const float*)(F.ws + WS_AFF);
    int* TOK = (int*)(F.ws + WS_TOK); float* GATE = (float*)(F.ws + WS_GATE); int* SLOT = (int*)(F.ws + WS_SLOT);
    for (int pair = F.vcu; pair < BATCH * NE; pair += F.G) {
        const int b = pair >> 4, e = pair & 15;
        const float* a = AFF + (size_t)pair * SEQ + 8 * tid;
        const f32x4 a0 = *(const f32x4*)a, a1 = *(const f32x4*)(a + 4);
        unsigned key[8];
#pragma unroll
        for (int j = 0; j < 4; ++j) { key[j] = __float_as_uint(a0[j]); key[4 + j] = __float_as_uint(a1[j]); }
        unsigned prefix = 0u;
        __syncthreads();
#pragma unroll 1
        for (int bit = 31; bit >= 0; --bit) {
            const unsigned cand = prefix | (1u << bit);
            unsigned c = 0;
#pragma unroll
            for (int j = 0; j < 8; ++j) c += (unsigned)__popcll(__ballot(key[j] >= cand));
            LAS unsigned* cc = cnt + ((bit & 1) ? 8 : 0);
            if (lane == 0) cc[wid] = c;
            __syncthreads();
            unsigned tot = 0;
#pragma unroll
            for (int w = 0; w < 8; ++w) tot += cc[w];
            if (tot >= (unsigned)CAP) prefix = cand;
        }
        unsigned cg = 0, ce = 0;
#pragma unroll
        for (int j = 0; j < 8; ++j) { cg += key[j] > prefix; ce += key[j] == prefix; }
        unsigned pk = (ce << 16) | cg, inc = pk;
#pragma unroll
        for (int o = 1; o < 64; o <<= 1) { const unsigned n = __shfl_up(inc, o); if (lane >= o) inc += n; }
        __syncthreads();
        LAS unsigned* ws_ = cnt + 16;
        if (lane == 63) ws_[wid] = inc;
        __syncthreads();
        unsigned base = 0, total = 0;
#pragma unroll
        for (int w = 0; w < 8; ++w) { const unsigned x = ws_[w]; if (w < wid) base += x; total += x; }
        const unsigned exc = base + inc - pk;
        unsigned gtb = exc & 0xffffu, eqb = exc >> 16;
        const unsigned need = (unsigned)CAP - (total & 0xffffu);
#pragma unroll
        for (int j = 0; j < 8; ++j) {
            const int sidx = 8 * tid + j; int slot = -1;
            if (key[j] > prefix) { slot = (int)(gtb + (eqb < need ? eqb : need)); ++gtb; }
            else if (key[j] == prefix) { if (eqb < need) slot = (int)(gtb + eqb); ++eqb; }
            SLOT[((size_t)(b * SEQ + sidx)) * NE + e] = slot;
            if (slot >= 0) { TOK[e * EROWS + b * CAP + slot] = b * SEQ + sidx; GATE[e * EROWS + b * CAP + slot] = __uint_as_float(key[j]); }
        }
        __syncthreads();
    }
}

__device__ __forceinline__ void p9_final(Frame& F) {
    const int gw = F.vcu * NWAVES + F.wave, NGW = F.G * NWAVES, lane = F.lane;
    const int* SLOT = (const int*)(F.ws + WS_SLOT); const h16* YE = (const h16*)(F.ws + WS_YE);
    f32x4 g[4];
#pragma unroll
    for (int j = 0; j < 4; ++j) g[j] = ((const f32x4*)F.g_final)[lane + 64 * j];
    for (int t = gw; t < M; t += NGW) {
        f32x4* xr = (f32x4*)(F.out + (size_t)t * DM) + lane;
        f32x4 v[4];
#pragma unroll
        for (int j = 0; j < 4; ++j) v[j] = xr[64 * j];
        const int myslot = SLOT[(size_t)t * NE + (lane & 15)];
        const int b = t >> 12;
#pragma unroll 1
        for (int e = 0; e < NE; ++e) {
            const int sl = __builtin_amdgcn_readlane(myslot, e);
            if (sl >= 0) {
                const u32x2* yr = (const u32x2*)(YE + ((size_t)e * EROWS + b * CAP + sl) * DM) + lane;
#pragma unroll
                for (int j = 0; j < 4; ++j) { const u32x2 w = yr[64 * j];
                    v[j].x += h2f((unsigned short)(w.x & 0xffffu)); v[j].y += h2f((unsigned short)(w.x >> 16)); v[j].z += h2f((unsigned short)(w.y & 0xffffu)); v[j].w += h2f((unsigned short)(w.y >> 16)); }
            }
        }
        float s = 0.f;
#pragma unroll
        for (int j = 0; j < 4; ++j) s += (v[j].x * v[j].x + v[j].y * v[j].y) + (v[j].z * v[j].z + v[j].w * v[j].w);
        const float rs = 1.0f / sqrtf(wave_sum(s) * (1.0f / DM) + NORM_EPS);
#pragma unroll
        for (int j = 0; j < 4; ++j) xr[64 * j] = v[j] * rs * g[j];
    }
}

constexpr int NPHASE = 10;
struct Args { const float* in[13]; float* out; unsigned char* ws; int ph_lo, ph_hi, li, pad; };

__global__ void __launch_bounds__(NWAVES * 64, 2) mk_fwd(Args args) {
    extern __shared__ __attribute__((aligned(16))) unsigned char lds[];
    Frame F;
    F.lds = (LAS unsigned char*)lds;
    F.tid = threadIdx.x; F.lane = F.tid & 63; F.wave = __builtin_amdgcn_readfirstlane(F.tid >> 6);
    F.G = gridDim.x; { const int bx = blockIdx.x; F.vcu = (F.G % 8 == 0) ? (bx % 8) * (F.G / 8) + bx / 8 : bx; }
    F.x = args.in[0]; F.g_mix = args.in[1]; F.w_in = args.in[2]; F.a_sink = args.in[3]; F.g_out_a = args.in[4]; F.g_out_b = args.in[5]; F.w_out = args.in[6];
    F.g_ffn = args.in[7]; F.w_router = args.in[8]; F.w_gate = args.in[9]; F.w_up = args.in[10]; F.w_down = args.in[11]; F.g_final = args.in[12];
    F.out = args.out; F.ws = args.ws;
    volatile LAS unsigned* MISC = (volatile LAS unsigned*)(F.lds + MISC_OFF);
    for (int u = F.tid; u < (LDS_BYTES - LDSCTL_OFF) / 4; u += NWAVES * 64) ((LAS unsigned*)(F.lds + LDSCTL_OFF))[u] = 0u;
    __syncthreads();
    const int lo = args.ph_lo, hi = args.ph_hi;
    const bool multi = (hi - lo) > 1;
    unsigned* barw = (unsigned*)(F.ws + WS_CTL) + CW_BAR + args.li * XCD_BAR_WORDS;
    XcdBarrier bar; bar.bar = barw; bar.x = 0; bar.st = nullptr;
    if (multi) bar = xcd_barrier_post(barw, MISC + 8);
#define IN(k) (lo <= (k) && (k) < hi)
#define SEAM(k) do { if (IN(k) && IN((k) + 1)) xcd_barrier(bar); } while (0)

    if (IN(0)) { p0_prologue(F); SEAM(0); }
    if (IN(1)) {
        pg8::DenseProb P{(const char*)(F.ws + WS_H), (const char*)(F.ws + WS_WIN), DM};
        pg8::DenseOrder S; S.init(M, NIN, F.G, (int)blockIdx.x);
        pg8::EpiInProj E{(h16*)(F.ws + WS_PROJ), (const float*)(F.ws + WS_ROPE)};
        pg8::gemm_phase<pg8::DenseProb, pg8::EpiInProj, pg8::DenseOrder, true>(F.lds, P, S, E);
        SEAM(1);
    }
    if (IN(2)) { att::attn_phase(F); SEAM(2); }
    if (IN(3)) { p3_combine(F); SEAM(3); }
    if (IN(4)) {
        pg8::DenseProb P{(const char*)(F.ws + WS_MIXED), (const char*)(F.ws + WS_WOUT), DM};
        pg8::DenseOrder S; S.init(M, DM, F.G, (int)blockIdx.x);
        pg8::EpiResidual E{F.x, F.out};
        pg8::gemm_phase<pg8::DenseProb, pg8::EpiResidual, pg8::DenseOrder, true>(F.lds, P, S, E);
        SEAM(4);
    }
    if (IN(5)) { p5_router(F); SEAM(5); }
    if (IN(6)) { p6_topk(F); SEAM(6); }
    if (IN(7)) {
        pg8::Moe1Prob P{(const char*)(F.ws + WS_H2), (const char*)(F.ws + WS_WGU), DM, (const int*)(F.ws + WS_TOK)};
        pg8::GroupOrder S; S.init(EROWS / 256, 4096 / 256, NE, F.G, F.vcu);
        pg8::EpiSwiGLU E{(h16*)(F.ws + WS_HMID)};
        pg8::gemm_phase<pg8::Moe1Prob, pg8::EpiSwiGLU, pg8::GroupOrder, true>(F.lds, P, S, E);
        SEAM(7);
    }
    if (IN(8)) {
        pg8::Moe2Prob P{(const char*)(F.ws + WS_HMID), (const char*)(F.ws + WS_WD), FF};
        pg8::GroupOrder S; S.init(EROWS / 256, DM / 256, NE, F.G, F.vcu);
        pg8::EpiDown E{(h16*)(F.ws + WS_YE), (const float*)(F.ws + WS_GATE)};
        pg8::gemm_phase<pg8::Moe2Prob, pg8::EpiDown, pg8::GroupOrder, true>(F.lds, P, S, E);
        SEAM(8);
    }
    if (IN(9)) { p9_final(F); }
#undef IN
#undef SEAM
}

extern "C" void kernel_launch(void* const* d_in, const int* in_sizes, int n_in, void* d_out, int out_size, void* d_ws, size_t ws_size, hipStream_t stream) {
    static int grid = 0;
    if (grid == 0) {
        if (n_in != 13 || in_sizes[0] != M * DM || out_size != M * DM || ws_size < WS_END) { fprintf(stderr, "kernel_launch: unexpected problem (n_in %d, ws %zu)\n", n_in, ws_size); grid = -1; return; }
        int dev = 0, cus = 0, per_cu = 0;
        if (hipGetDevice(&dev) != hipSuccess || hipDeviceGetAttribute(&cus, hipDeviceAttributeMultiprocessorCount, dev) != hipSuccess) { grid = -1; return; }
        if (hipFuncSetAttribute((const void*)mk_fwd, hipFuncAttributeMaxDynamicSharedMemorySize, LDS_BYTES) != hipSuccess) { fprintf(stderr, "kernel_launch: hipFuncSetAttribute failed\n"); grid = -1; return; }
        if (hipOccupancyMaxActiveBlocksPerMultiprocessor(&per_cu, (const void*)mk_fwd, NWAVES * 64, LDS_BYTES) != hipSuccess || per_cu < 1)
            fprintf(stderr, "kernel_launch: occupancy query reports %d blocks per CU\n", per_cu);
        (void)hipGetLastError();
        grid = cus;
    }
    if (grid < 0) return;
    (void)hipMemsetAsync((char*)d_ws + WS_CTL, 0, CTL_ZERO_BYTES, stream);
    Args a{};
    for (int i = 0; i < 13; ++i) a.in[i] = (const float*)d_in[i];
    a.out = (float*)d_out; a.ws = (unsigned char*)d_ws;
    if (MK_N_LAUNCHES == 1) {
        a.ph_lo = 0; a.ph_hi = NPHASE; a.li = 0;
        hipLaunchKernelGGL(mk_fwd, dim3(grid), dim3(NWAVES * 64), LDS_BYTES, stream, a);
    } else {
        for (int li = 0; li < NPHASE; ++li) { a.ph_lo = li; a.ph_hi = li + 1; a.li = 0;
            hipLaunchKernelGGL(mk_fwd, dim3(grid), dim3(NWAVES * 64), LDS_BYTES, stream, a); }
    }
}
```

```cpp
#include <hip/hip_runtime.h>
#include <cstdio>
#include <cstdint>

#ifndef MK_N_LAUNCHES
#define MK_N_LAUNCHES 1
#endif
#ifndef TIME_PHASE
#define TIME_PHASE -1
#endif
#ifndef TIME_SCALE
#define TIME_SCALE 1.0f
#endif
#ifndef PH_MASK
#define PH_MASK 0x3ff
#endif
#ifndef REP_ALL
#define REP_ALL 1
#endif
#ifndef REP_MASK
#define REP_MASK 0
#endif

#define LAS __attribute__((address_space(3)))
#define GAS __attribute__((address_space(1)))
typedef unsigned short h16;
typedef _Float16 half8 __attribute__((ext_vector_type(8)));
typedef _Float16 half2v __attribute__((ext_vector_type(2)));
typedef short s16x4 __attribute__((ext_vector_type(4)));
typedef float f32x4 __attribute__((ext_vector_type(4)));
typedef float f32x16 __attribute__((ext_vector_type(16)));
typedef unsigned u32x2 __attribute__((ext_vector_type(2)));
typedef unsigned u32x4 __attribute__((ext_vector_type(4)));
typedef GAS unsigned gu32;

constexpr int BATCH = 4, SEQ = 4096, DM = 1024, M = BATCH * SEQ;
constexpr int NIN = 2304;
constexpr int OFF_QA = 0, OFF_KA = 512, OFF_VA = 640, OFF_QB = 768, OFF_KB = 1280, OFF_VB = 1792;
constexpr int NE = 16, CAP = 512, FF = 2048, EROWS = BATCH * CAP;
constexpr float NORM_EPS = 1e-6f;
constexpr float LOG2E = 1.4426950408889634f, LN2 = 0.6931471805599453f;
constexpr float QSCALE = 0.18033688011112042f;
constexpr float S_H2 = 4.f, S_W = 32.f, S_HM = 2.f, S_YE = 16.f;

constexpr size_t MiB = 1u << 20;
constexpr size_t WS_CTL = 0, CTL_ZERO_BYTES = 64 * 1024;
constexpr size_t WS_ROPE = 1 * MiB;
constexpr size_t WS_AFF = 2 * MiB;
constexpr size_t WS_TOK = 3 * MiB;
constexpr size_t WS_GATE = 3 * MiB + 256 * 1024;
constexpr size_t WS_SLOT = 4 * MiB;
constexpr size_t WS_LSE = 5 * MiB;
constexpr size_t WS_WIN = 8 * MiB;
constexpr size_t WS_WOUT = 13 * MiB;
constexpr size_t WS_WGU = 16 * MiB;
constexpr size_t WS_WD = 144 * MiB;
constexpr size_t WS_H = 208 * MiB;
constexpr size_t WS_PROJ = 240 * MiB;
constexpr size_t WS_OA = 312 * MiB;
constexpr size_t WS_OB = 328 * MiB;
constexpr size_t WS_HMID = 208 * MiB;
constexpr size_t WS_MIXED = 376 * MiB;
constexpr size_t WS_H2 = 408 * MiB;
constexpr size_t WS_YE = 376 * MiB;
constexpr size_t WS_X1 = 440 * MiB;
constexpr size_t WS_END = 504 * MiB;
constexpr int CW_CONV = 64, CW_P1DONE = 128;
constexpr int CW_BAR = 1024;

constexpr int RING_BYTES = 131072;
constexpr int LDSCTL_OFF = 143360, MISC_OFF = LDSCTL_OFF + 320;
constexpr int LDS_BYTES = 147456;
constexpr int NWAVES = 8;

#define RLX_AGENT __ATOMIC_RELAXED, __HIP_MEMORY_SCOPE_AGENT
#define LDS_WAIT() asm volatile("s_waitcnt lgkmcnt(0)" ::: "memory")
#define VM_WAIT() asm volatile("s_waitcnt vmcnt(0)" ::: "memory")

__device__ __forceinline__ unsigned pk_h2(float lo, float hi) { half2v v = {(_Float16)lo, (_Float16)hi}; return __builtin_bit_cast(unsigned, v); }
__device__ __forceinline__ unsigned pk_h2_rtz(float lo, float hi) { return __builtin_bit_cast(unsigned, __builtin_amdgcn_cvt_pkrtz(lo, hi)); }
__device__ __forceinline__ unsigned pk_fp8x4(float a, float b, float c, float d) {
    int w = __builtin_amdgcn_cvt_pk_fp8_f32(a, b, 0, false); w = __builtin_amdgcn_cvt_pk_fp8_f32(c, d, w, true); return (unsigned)w; }
__device__ __forceinline__ float clamp8(float x) { return fminf(fmaxf(x, -448.f), 448.f); }
__device__ __forceinline__ float h2f(unsigned short b) { return (float)__builtin_bit_cast(_Float16, b); }
__device__ __forceinline__ float wave_sum(float v) {
#pragma unroll
    for (int o = 1; o < 64; o <<= 1) v += __shfl_xor(v, o);
    return v;
}


constexpr unsigned CV_PER = (DM / 64) * (FF / 32);
constexpr unsigned CV_TOTAL = (unsigned)NE * 3u * CV_PER;
__device__ __forceinline__ void conv8_item(const float* W, int K, int N, unsigned char* WT, int k0, int n0, int drow0, LAS float* scr, int lane) {
#pragma unroll 8
    for (int i = 0; i < 32; ++i) { const int kk = 2 * i + (lane >> 5); scr[kk * 33 + (lane & 31)] = W[(size_t)(k0 + kk) * N + n0 + (lane & 31)]; }
    LDS_WAIT(); asm volatile("" ::: "memory");
    const int n = lane >> 1, kh = (lane & 1) * 32; const LAS float* s = scr + kh * 33 + n;
    u32x4 o0, o1;
#pragma unroll
    for (int q = 0; q < 4; ++q) {
        o0[q] = pk_fp8x4(s[(4 * q) * 33] * S_W, s[(4 * q + 1) * 33] * S_W, s[(4 * q + 2) * 33] * S_W, s[(4 * q + 3) * 33] * S_W);
        o1[q] = pk_fp8x4(s[(16 + 4 * q) * 33] * S_W, s[(17 + 4 * q) * 33] * S_W, s[(18 + 4 * q) * 33] * S_W, s[(19 + 4 * q) * 33] * S_W); }
    unsigned char* d = WT + (size_t)(drow0 + n) * K + k0 + kh;
    *(GAS u32x4*)d = o0; *(GAS u32x4*)(d + 16) = o1;
    LDS_WAIT(); asm volatile("" ::: "memory");
}
constexpr unsigned CV_BATCH = 64;
__device__ __forceinline__ void conv8_one(const float* wg, const float* wu, const float* wd, unsigned char* ws, unsigned it, LAS float* scr, int lane) {
    if (it < (unsigned)NE * 2u * CV_PER) {
        const unsigned e = it / (2u * CV_PER); unsigned r = it - e * 2u * CV_PER; const unsigned which = r / CV_PER; r -= which * CV_PER;
        const int kb = (int)(r / (FF / 32)), n0 = 32 * (int)(r % (FF / 32));
        const float* W = (which ? wu : wg) + (size_t)e * DM * FF;
        conv8_item(W, DM, FF, ws + WS_WGU + (size_t)e * 4096 * DM, 64 * kb, n0, (n0 >> 7) * 256 + (int)which * 128 + (n0 & 127), scr, lane);
    } else {
        const unsigned r0 = it - (unsigned)NE * 2u * CV_PER, e = r0 / CV_PER, r = r0 - e * CV_PER;
        const int kb = (int)(r / (DM / 32)), n0 = 32 * (int)(r % (DM / 32));
        conv8_item(wd + (size_t)e * FF * DM, FF, DM, ws + WS_WD + (size_t)e * DM * FF, 64 * kb, n0, n0, scr, lane);
    }
}
__device__ __forceinline__ void conv8_dynamic(const float* wg, const float* wu, const float* wd, unsigned char* ws, unsigned* ctr, unsigned* done_ctr, unsigned until_done,
                                              LAS float* scr, volatile LAS unsigned* sh, int tid, int wave, int lane) {
    for (;;) {
        if (tid == 0) { sh[0] = __hip_atomic_fetch_add(ctr, CV_BATCH, __ATOMIC_RELAXED, __HIP_MEMORY_SCOPE_AGENT);
                        sh[1] = until_done ? __hip_atomic_load(done_ctr, __ATOMIC_RELAXED, __HIP_MEMORY_SCOPE_AGENT) : 0u; }
        __syncthreads();
        const unsigned b0 = sh[0]; const bool stop = until_done && sh[1] >= until_done;
        __syncthreads();
        if (b0 >= CV_TOTAL) break;
#pragma unroll 1
        for (unsigned q = 0; q < CV_BATCH / 8; ++q) { const unsigned it = b0 + (unsigned)wave * (CV_BATCH / 8) + q; if (it < CV_TOTAL) conv8_one(wg, wu, wd, ws, it, scr, lane); }
        if (stop) break;
    }
}
struct NoSide { static constexpr bool ON = false; };

namespace pg8 {
constexpr int BM = 256, BK = 64, HALF = 128, HTB = HALF * BK * 2, STAGE_BYTES = 8 * HTB, NXCD = 8, WGM = 8;
__host__ __device__ __forceinline__ int lds_byte(int r, int c) { const int st = (r >> 4) * 2 + (c >> 5), rr = r & 15, cc = c & 31, ob = rr * 64 + cc * 2; return st * 1024 + (ob ^ (((ob >> 9) & 1) << 5)); }
__host__ __device__ __forceinline__ void stage_rc(int b, int& R, int& C) { const int st = b / 1024, sb = b % 1024, swz = sb ^ (((sb >> 9) & 1) << 5); R = (st >> 1) * 16 + swz / 64; C = (st & 1) * 32 + (swz % 64) / 2; }
__host__ __device__ __forceinline__ int perm32(int rho) { const int n = rho >> 4, i = rho & 15; return 8 * (i >> 2) + 4 * n + (i & 3); }

struct Unit { int pm, pn, g; };

struct DenseOrder {
    int nM, nN, nwg, G, c, reps;
    __device__ void init(int M_, int N_, int G_, int c_, int reps_ = 1) { nM = M_ / BM; nN = N_ / BM; nwg = nM * nN; G = G_; c = c_; reps = reps_; }
    __device__ bool next(int i, Unit& u) const {
        const int mine = (nwg - c + G - 1) / G; if (mine <= 0 || i >= mine * reps) return false; i %= mine;
        const long L = (long)i * G + c;
        int wgid = (int)L; { const int q = nwg / NXCD, r = nwg % NXCD, xcd = wgid % NXCD, off = wgid / NXCD; wgid = (xcd < r ? xcd * (q + 1) : r * (q + 1) + (xcd - r) * q) + off; }
        const int nig = WGM * nN, gid = wgid / nig, fm = gid * WGM, gsz = (nM - fm) < WGM ? (nM - fm) : WGM;
        u.pm = fm + ((wgid % nig) % gsz); u.pn = (wgid % nig) / gsz; u.g = 0; return true;
    }
};
struct GroupOrder {
    int nPM, nPN, total, G, c, reps;
    __device__ void init(int nPM_, int nPN_, int groups, int G_, int c_, int reps_ = 1) { nPM = nPM_; nPN = nPN_; total = nPM_ * nPN_ * groups; G = G_; c = c_; reps = reps_; }
    __device__ bool next(int i, Unit& u) const {
        const int mine = (total - c + G - 1) / G; if (mine <= 0 || i >= mine * reps) return false; i %= mine;
        const int L = i * G + c;
        const int per = nPM * nPN; u.g = L / per; const int rem = L % per; u.pn = rem / nPM; u.pm = rem % nPM; return true;
    }
};

struct DenseProb {
    static constexpr bool BKN = false, FP8 = false;
    const char* A; const char* Bt; int KB;
    __device__ __forceinline__ unsigned a_row(const Unit& u, int r) const { return (unsigned)(u.pm * BM + r); }
    __device__ __forceinline__ const char* b_base(const Unit& u, int half) const { return Bt + ((size_t)u.pn * BM + (size_t)half * HALF) * KB; }
    __device__ __forceinline__ size_t b_kstep() const { return (size_t)BK * 2; }
    __device__ __forceinline__ unsigned b_pitch() const { return (unsigned)KB; }
};
struct Moe1Prob {
    static constexpr bool BKN = false, FP8 = true;
    const char* A; const char* Bt; int KB; const int* tok;
    __device__ __forceinline__ unsigned a_row(const Unit& u, int r) const { return (unsigned)tok[u.g * EROWS + u.pm * BM + r]; }
    __device__ __forceinline__ const char* b_base(const Unit& u, int half) const { return Bt + ((size_t)u.g * 4096 + (size_t)u.pn * BM + (size_t)half * HALF) * KB; }
    __device__ __forceinline__ size_t b_kstep() const { return (size_t)BK * 2; }
    __device__ __forceinline__ unsigned b_pitch() const { return (unsigned)KB; }
};
struct Moe2Prob {
    static constexpr bool BKN = false, FP8 = true;
    const char* A; const char* Bt; int KB;
    __device__ __forceinline__ unsigned a_row(const Unit& u, int r) const { return (unsigned)(u.g * EROWS + u.pm * BM + r); }
    __device__ __forceinline__ const char* b_base(const Unit& u, int half) const { return Bt + ((size_t)u.g * DM + (size_t)u.pn * BM + (size_t)half * HALF) * KB; }
    __device__ __forceinline__ size_t b_kstep() const { return (size_t)BK * 2; }
    __device__ __forceinline__ unsigned b_pitch() const { return (unsigned)KB; }
};

struct EpiInProj {
    static constexpr bool PERM = true;
    h16* O; const float* rope;
    __device__ __forceinline__ void operator()(const f32x4 (&acc)[2][2][4][2], const Unit& u, int wr, int wc, int fr, int fq) const {
        const int row0 = u.pm * BM + wr * 64 + fr;
        const int ct0 = u.pn * BM;
        const bool rt0 = (ct0 < OFF_VA) || (ct0 >= OFF_QB && ct0 < OFF_VB), rt1 = (ct0 + HALF < OFF_VA) || (ct0 + HALF >= OFF_QB && ct0 + HALF < OFF_VB);
        const bool any_rope = (rt0 || rt1) && ((wc & 1) == 0);
        float c[8], s[8];
        if (any_rope) { const float* rp = rope + (size_t)(row0 & (SEQ - 1)) * 16;
            const f32x4 c0 = *(const f32x4*)(rp), c1 = *(const f32x4*)(rp + 4), s0 = *(const f32x4*)(rp + 8), s1 = *(const f32x4*)(rp + 12);
#pragma unroll
            for (int j = 0; j < 4; ++j) { c[j] = c0[j]; c[4 + j] = c1[j]; s[j] = s0[j]; s[4 + j] = s1[j]; } }
        else {
#pragma unroll
            for (int j = 0; j < 8; ++j) { c[j] = 1.f; s[j] = 0.f; } }
        const float cd16[8] = {-9.576594803e-01f, -9.992462593e-01f, 8.243765146e-01f, 9.932003012e-01f, 9.997440109e-01f, 9.999903729e-01f, 9.999996380e-01f, 9.999999864e-01f};
        const float sd16[8] = {-2.879033167e-01f, 3.881898152e-02f, 5.660418378e-01f, 1.164180468e-01f, 2.262548617e-02f, 4.387956730e-03f, 8.509272408e-04f, 1.650141653e-04f};
        const float cd80[8] = {-1.103872438e-01f, -9.812132344e-01f, -9.911539132e-01f, 8.345872775e-01f, 9.936068238e-01f, 9.997593311e-01f, 9.999909490e-01f, 9.999996596e-01f};
        const float sd80[8] = {-9.938886539e-01f, 1.929263812e-01f, 1.327174458e-01f, 5.508757358e-01f, 1.128958803e-01f, 2.193809395e-02f, 4.254623881e-03f, 8.250707366e-04f};
        const float sg = (fq == 0) ? -1.f : 1.f;
#pragma unroll
        for (int ai = 0; ai < 2; ++ai)
#pragma unroll
            for (int m = 0; m < 4; ++m) {
                const int row = row0 + ai * HALF + m * 16;
                if (any_rope && (ai | m) != 0) {
#pragma unroll
                    for (int j = 0; j < 8; ++j) { const float cdv = (m == 0) ? cd80[j] : cd16[j], sdv = (m == 0) ? sd80[j] : sd16[j];
                        const float cn = c[j] * cdv - s[j] * sdv, sn = s[j] * cdv + c[j] * sdv; c[j] = cn; s[j] = sn; }
                }
#pragma unroll
                for (int bj = 0; bj < 2; ++bj) {
                    const bool do_rope = (bj ? rt1 : rt0) && ((wc & 1) == 0);
                    const int col0 = ct0 + bj * HALF + wc * 32 + 8 * fq;
                    f32x4 v0 = acc[ai][bj][m][0], v1 = acc[ai][bj][m][1];
                    if (do_rope) {
                        f32x4 p0, p1;
#pragma unroll
                        for (int j = 0; j < 4; ++j) { p0[j] = __shfl_xor(v0[j], 16); p1[j] = __shfl_xor(v1[j], 16); }
                        if (fq < 2) {
#pragma unroll
                            for (int j = 0; j < 4; ++j) { v0[j] = v0[j] * c[j] + (p0[j] * s[j]) * sg; v1[j] = v1[j] * c[4 + j] + (p1[j] * s[4 + j]) * sg; } }
                    }
                    u32x4 w; w.x = pk_h2(v0[0], v0[1]); w.y = pk_h2(v0[2], v0[3]); w.z = pk_h2(v1[0], v1[1]); w.w = pk_h2(v1[2], v1[3]);
                    *(u32x4*)(O + (size_t)row * NIN + col0) = w;
                }
            }
    }
};
struct EpiResidual {
    static constexpr bool PERM = true;
    const float* base; h16* out;
    __device__ __forceinline__ void operator()(const f32x4 (&acc)[2][2][4][2], const Unit& u, int wr, int wc, int fr, int fq) const {
        const int row0 = u.pm * BM + wr * 64 + fr, col0 = u.pn * BM + wc * 32 + 8 * fq;
#pragma unroll
        for (int ai = 0; ai < 2; ++ai)
#pragma unroll
            for (int m = 0; m < 4; ++m) {
                const size_t off = (size_t)(row0 + ai * HALF + m * 16) * DM + col0;
#pragma unroll
                for (int bj = 0; bj < 2; ++bj) { const f32x4 b0 = *(const f32x4*)(base + off + bj * HALF), b1 = *(const f32x4*)(base + off + bj * HALF + 4);
                    const f32x4 v0 = b0 + acc[ai][bj][m][0], v1 = b1 + acc[ai][bj][m][1];
                    u32x4 w; w.x = pk_h2(v0[0], v0[1]); w.y = pk_h2(v0[2], v0[3]); w.z = pk_h2(v1[0], v1[1]); w.w = pk_h2(v1[2], v1[3]);
                    *(u32x4*)(out + off + bj * HALF) = w; }
            }
    }
};
struct EpiSwiGLU {
    static constexpr bool PERM = true;
    unsigned char* O;
    __device__ __forceinline__ void operator()(const f32x4 (&acc)[2][2][4][2], const Unit& u, int wr, int wc, int fr, int fq) const {
        const int row0 = u.g * EROWS + u.pm * BM + wr * 64 + fr, col0 = u.pn * HALF + wc * 32 + 8 * fq;
        constexpr float IS = 1.0f / (S_H2 * S_W);
#pragma unroll
        for (int ai = 0; ai < 2; ++ai)
#pragma unroll
            for (int m = 0; m < 4; ++m) {
                float r[8];
#pragma unroll
                for (int n = 0; n < 2; ++n)
#pragma unroll
                    for (int j = 0; j < 4; ++j) { const float a = acc[ai][0][m][n][j] * IS, up = acc[ai][1][m][n][j] * (IS * S_HM);
                        r[n * 4 + j] = clamp8(a * __builtin_amdgcn_rcpf(1.0f + __builtin_amdgcn_exp2f(-a * LOG2E)) * up); }
                u32x2 w; w.x = pk_fp8x4(r[0], r[1], r[2], r[3]); w.y = pk_fp8x4(r[4], r[5], r[6], r[7]);
                *(u32x2*)(O + (size_t)(row0 + ai * HALF + m * 16) * FF + col0) = w;
            }
    }
};
struct EpiDown {
    static constexpr bool PERM = true;
    unsigned char* O; const float* gate;
    __device__ __forceinline__ void operator()(const f32x4 (&acc)[2][2][4][2], const Unit& u, int wr, int wc, int fr, int fq) const {
        const int row0 = u.g * EROWS + u.pm * BM + wr * 64 + fr, col0 = u.pn * BM + wc * 32 + 8 * fq;
#pragma unroll
        for (int ai = 0; ai < 2; ++ai)
#pragma unroll
            for (int m = 0; m < 4; ++m) {
                const int row = row0 + ai * HALF + m * 16; const float gt = gate[row] * (S_YE / (S_HM * S_W));
#pragma unroll
                for (int bj = 0; bj < 2; ++bj) { const f32x4 v0 = acc[ai][bj][m][0] * gt, v1 = acc[ai][bj][m][1] * gt;
                    u32x2 w; w.x = pk_fp8x4(clamp8(v0[0]), clamp8(v0[1]), clamp8(v0[2]), clamp8(v0[3])); w.y = pk_fp8x4(clamp8(v1[0]), clamp8(v1[1]), clamp8(v1[2]), clamp8(v1[3]));
                    *(u32x2*)(O + (size_t)row * DM + col0 + bj * HALF) = w; }
            }
    }
};

template <class Prob, class Epi, class Sched, bool ALIGN_EPI, class Side = NoSide>
__device__ __forceinline__ void gemm_phase(LAS unsigned char* lds, const Prob P, const Sched& S, const Epi& E, const Side SD = Side()) {
    const int tid = threadIdx.x, wid = __builtin_amdgcn_readfirstlane(tid >> 6), lane = tid & 63, wr = wid >> 2, wc = wid & 3, fr = lane & 15, fq = lane >> 4;
    const int KB = P.KB, nt = KB / 128;
    int RA[2]; unsigned CA2[2], voffB[2];
#pragma unroll
    for (int i = 0; i < 2; ++i) { int R, C; stage_rc(tid * 16 + i * 8192, R, C); const int Rb = Epi::PERM ? ((R & ~31) + perm32(R & 31)) : R;
        RA[i] = R; CA2[i] = (unsigned)C * 2u;
        if constexpr (Prob::BKN) {
            static_assert(Epi::PERM, "the [K][N] B path is written for PERM epilogues");
            const int r = 4 * wid + 32 * i + (lane >> 4), g = (r & 3) | (((r >> 3) & 1) << 2), c = (lane & 15) ^ (g << 1);
            voffB[i] = (unsigned)r * P.b_pitch() + (unsigned)c * 16u;
        } else voffB[i] = (unsigned)(Rb * KB) + (unsigned)C * 2u; }
    const unsigned kstep = (unsigned)(BK * 2);
    const size_t kstepB = P.b_kstep();
    int btr[2];
    { const int q = fr >> 2, p = fr & 3, X = ((q | ((fq & 1) << 2)) << 2) | (q & 1);
#pragma unroll
      for (int n = 0; n < 2; ++n) btr[n] = (8 * fq + q) * 256 + (((8 * wc + 2 * p + n) ^ X) * 8); }
    const unsigned lds_u32 = (unsigned)(__UINTPTR_TYPE__)lds;
    unsigned bta[2]; bta[0] = lds_u32 + (unsigned)btr[0]; bta[1] = lds_u32 + (unsigned)btr[1];
    const unsigned rowb = (unsigned)KB;
    const unsigned ldsw = (unsigned)wid * 1024u;
    const int aoff = lds_byte(wr * 64 + fr, fq * 8), boff = lds_byte(wc * 32 + fr, fq * 8);
#define PG8_SA(b, h) (((b) * 2 + (h)) * HTB)
#define PG8_SB(b, h) ((4 + (b) * 2 + (h)) * HTB)
#define PG8_STAGE_B(bufoff, gbase) do { _Pragma("unroll") for (int _i = 0; _i < 2; ++_i) \
        __builtin_amdgcn_global_load_lds((const unsigned*)((const char*)(gbase) + voffB[_i]), (LAS unsigned*)(lds + (bufoff) + ldsw + _i * 8192), 16, 0, 0); } while (0)
#define PG8_STAGE_A(bufoff, kb, offs) do { _Pragma("unroll") for (int _i = 0; _i < 2; ++_i) \
        __builtin_amdgcn_global_load_lds((const unsigned*)(P.A + (size_t)(kb) + (offs)[_i]), (LAS unsigned*)(lds + (bufoff) + ldsw + _i * 8192), 16, 0, 0); } while (0)
#define PG8_LDA(dst, b, h) do { if constexpr (Prob::FP8) { _Pragma("unroll") for (int m = 0; m < 4; ++m) { dst##8[m].lo = *(const LAS v4i_*)(lds + PG8_SA(b, h) + aoff + m * 2048); dst##8[m].hi = *(const LAS v4i_*)(lds + PG8_SA(b, h) + aoff + m * 2048 + 1024); } } \
        else { _Pragma("unroll") for (int m = 0; m < 4; ++m) _Pragma("unroll") for (int k = 0; k < 2; ++k) dst[m][k] = *(const LAS half8*)(lds + PG8_SA(b, h) + aoff + m * 2048 + k * 1024); } } while (0)
#define PG8_LDB(dst, b, h) do { if constexpr (Prob::BKN) { _Pragma("unroll") for (int n = 0; n < 2; ++n) { const unsigned ad_ = bta[n] + (unsigned)PG8_SB(b, h); _Pragma("unroll") for (int k = 0; k < 2; ++k) { \
            asm volatile("ds_read_b64_tr_b16 %0, %1 offset:%c2" : "=&v"(dst##lo[n][k]) : "v"(ad_), "i"(k * 8192) : "memory"); \
            asm volatile("ds_read_b64_tr_b16 %0, %1 offset:%c2" : "=&v"(dst##hi[n][k]) : "v"(ad_), "i"(k * 8192 + 1024) : "memory"); } } } \
        else if constexpr (Prob::FP8) { _Pragma("unroll") for (int n = 0; n < 2; ++n) { dst##8[n].lo = *(const LAS v4i_*)(lds + PG8_SB(b, h) + boff + n * 2048); dst##8[n].hi = *(const LAS v4i_*)(lds + PG8_SB(b, h) + boff + n * 2048 + 1024); } } \
        else { _Pragma("unroll") for (int n = 0; n < 2; ++n) _Pragma("unroll") for (int k = 0; k < 2; ++k) dst[n][k] = *(const LAS half8*)(lds + PG8_SB(b, h) + boff + n * 2048 + k * 1024); } } while (0)
#define PG8_BFIX(dst) do { if constexpr (Prob::BKN) { typedef short s16x8_ __attribute__((ext_vector_type(8))); _Pragma("unroll") for (int n = 0; n < 2; ++n) _Pragma("unroll") for (int k = 0; k < 2; ++k) { \
            const s16x8_ v_ = __builtin_shufflevector(dst##lo[n][k], dst##hi[n][k], 0, 1, 2, 3, 4, 5, 6, 7); dst[n][k] = __builtin_bit_cast(half8, v_); } } } while (0)
#define PG8_MMA(ai, bj, At, Bt) do { __builtin_amdgcn_s_setprio(1); _Pragma("unroll") for (int m = 0; m < 4; ++m) _Pragma("unroll") for (int n = 0; n < 2; ++n) { \
        if constexpr (Prob::FP8) asm volatile("v_mfma_f32_16x16x128_f8f6f4 %0, %1, %2, %0" : "+v"(acc[ai][bj][m][n]) : "v"(Bt##8[n]), "v"(At##8[m])); \
        else { _Pragma("unroll") for (int k = 0; k < 2; ++k) acc[ai][bj][m][n] = __builtin_amdgcn_mfma_f32_16x16x32_f16(Bt[n][k], At[m][k], acc[ai][bj][m][n], 0, 0, 0); } } \
        __builtin_amdgcn_s_setprio(0); } while (0)
#define PG8_WAIT_V(n) asm volatile("s_waitcnt vmcnt(" #n ")" ::: "memory")
#define PG8_WAIT_L(n) asm volatile("s_waitcnt lgkmcnt(" #n ")" ::: "memory")
#define PG8_BAR __builtin_amdgcn_s_barrier()
#define PG8_SCHED __builtin_amdgcn_sched_barrier(0)
#define PG8_SIDE_ISSUE(slot) do { if constexpr (Side::ON) { sfly = SD.L->pending() && (((slot) % SD.every) == 0); \
        if (sfly) { scc = SD.L->chunk(SD.L->done); const float* sp_ = SD.L->src_of(SD.L->wa, SD.L->wb, scc); \
            asm volatile("global_load_dwordx4 %0, %2, off\n\tglobal_load_dwordx4 %1, %2, off offset:16" : "=&v"(sr0), "=&v"(sr1) : "v"(sp_) : "memory"); } } } while (0)
#define PG8_SIDE_FINISH() do { if constexpr (Side::ON) { if (sfly) { asm volatile("" : "+v"(sr0), "+v"(sr1)); SD.L->store(SD.L->da, scc, sr0, sr1); SD.L->done += 1; } PG8_SCHED; } } while (0)
#define PG8_WAIT_VS(extra) do { if constexpr (Side::ON) { if (sfly) { if ((extra) == 2) PG8_WAIT_V(10); else PG8_WAIT_V(9); } else PG8_WAIT_V(8); } else PG8_WAIT_V(8); } while (0)
#define PG8_AOFF(dst, un) do { _Pragma("unroll") for (int _h = 0; _h < 2; ++_h) _Pragma("unroll") for (int _i = 0; _i < 2; ++_i) dst[_h][_i] = P.a_row(un, _h * HALF + RA[_i]) * rowb + CA2[_i]; } while (0)
    Unit cur, nxt; int ui = 0;
    if (!S.next(0, cur)) return;
    bool sfly = false; f32x4 sr0, sr1; unsigned scc = 0;
    f32x4 acc[2][2][4][2];
#pragma unroll
    for (int a = 0; a < 2; ++a)
#pragma unroll
        for (int b = 0; b < 2; ++b)
#pragma unroll
            for (int m = 0; m < 4; ++m)
#pragma unroll
                for (int n = 0; n < 2; ++n) acc[a][b][m][n] = (f32x4){0.f, 0.f, 0.f, 0.f};
    typedef int v4i_ __attribute__((ext_vector_type(4))); typedef int v8i_ __attribute__((ext_vector_type(8)));
    half8 At[4][2], B0[2][2], B1[2][2];
    s16x4 B0lo[2][2], B0hi[2][2], B1lo[2][2], B1hi[2][2];
    v8i_ At8[4], B08[2], B18[2];
    unsigned cuo[2][2], nxo[2][2];
    PG8_AOFF(cuo, cur);
    const char* cB0 = P.b_base(cur, 0); const char* cB1 = P.b_base(cur, 1);
    PG8_STAGE_B(PG8_SB(0, 0), cB0); PG8_STAGE_B(PG8_SB(0, 1), cB1); PG8_STAGE_A(PG8_SA(0, 0), 0, cuo[0]); PG8_STAGE_A(PG8_SA(0, 1), 0, cuo[1]);
    if (wr == 1) PG8_BAR;
    PG8_WAIT_V(2); PG8_BAR;
    PG8_STAGE_B(PG8_SB(1, 0), cB0 + kstepB); PG8_STAGE_A(PG8_SA(1, 0), kstep, cuo[0]); PG8_STAGE_B(PG8_SB(1, 1), cB1 + kstepB);
    PG8_WAIT_V(6); PG8_BAR;
    for (;;) {
        const bool has_next = S.next(ui + 1, nxt);
        if (!has_next) nxt = cur;
        PG8_AOFF(nxo, nxt);
        const char* nB0 = P.b_base(nxt, 0); const char* nB1 = P.b_base(nxt, 1);
        for (int t = 0; t < nt; t += 2) {
            const bool last = (t == nt - 2);
            const unsigned k1 = (unsigned)(t + 1) * kstep;
            const unsigned k2 = last ? 0u : (unsigned)(t + 2) * kstep, k3 = k2 + kstep;
            const char* b20 = last ? nB0 : cB0 + (size_t)(t + 2) * kstepB; const char* b21 = last ? nB1 : cB1 + (size_t)(t + 2) * kstepB;
            const char* b30 = b20 + kstepB; const char* b31 = b21 + kstepB;
            unsigned o20[2], o21[2];
#pragma unroll
            for (int i = 0; i < 2; ++i) { o20[i] = last ? nxo[0][i] : cuo[0][i]; o21[i] = last ? nxo[1][i] : cuo[1][i]; }
            PG8_LDB(B0, 0, 0); PG8_LDB(B1, 0, 1); PG8_SCHED; PG8_LDA(At, 0, 0); PG8_STAGE_A(PG8_SA(1, 1), k1, cuo[1]); PG8_SIDE_ISSUE((ui * nt + t) >> 1);
            PG8_WAIT_VS(2);
            PG8_WAIT_L(0); PG8_SCHED; PG8_BFIX(B0); PG8_BFIX(B1); PG8_BAR; PG8_MMA(0, 0, At, B0); PG8_MMA(0, 1, At, B1); PG8_BAR; PG8_SCHED;
            PG8_LDA(At, 0, 1); PG8_STAGE_B(PG8_SB(0, 0), b20); PG8_STAGE_B(PG8_SB(0, 1), b21); PG8_STAGE_A(PG8_SA(0, 0), k2, o20);
            PG8_WAIT_VS(2); PG8_WAIT_L(0); PG8_BAR; PG8_MMA(1, 0, At, B0); PG8_MMA(1, 1, At, B1); PG8_BAR; PG8_SCHED;
            PG8_LDB(B0, 1, 0); PG8_LDB(B1, 1, 1); PG8_SCHED; PG8_LDA(At, 1, 0); PG8_STAGE_A(PG8_SA(0, 1), k2, o21);
            PG8_WAIT_V(8);
            PG8_WAIT_L(0); PG8_SCHED; PG8_BFIX(B0); PG8_BFIX(B1); PG8_BAR; PG8_MMA(0, 0, At, B0); PG8_MMA(0, 1, At, B1); PG8_BAR; PG8_SCHED;
            PG8_SIDE_FINISH();
            PG8_LDA(At, 1, 1); PG8_STAGE_B(PG8_SB(1, 0), b30); PG8_STAGE_B(PG8_SB(1, 1), b31); PG8_STAGE_A(PG8_SA(1, 0), k3, o20);
            PG8_WAIT_VS(1); PG8_WAIT_L(0); PG8_BAR; PG8_MMA(1, 0, At, B0); PG8_MMA(1, 1, At, B1); PG8_BAR; PG8_SCHED;
            if constexpr (Side::ON) sfly = false;
        }
        if constexpr (ALIGN_EPI) { if (wr == 0) PG8_BAR; }
        if constexpr (Prob::FP8) asm volatile("s_nop 15\n\ts_nop 15" ::: "memory");
        E(acc, cur, wr, wc, fr, fq);
        if (!has_next) break;
#pragma unroll
        for (int a = 0; a < 2; ++a)
#pragma unroll
            for (int b = 0; b < 2; ++b)
#pragma unroll
                for (int m = 0; m < 4; ++m)
#pragma unroll
                    for (int n = 0; n < 2; ++n) acc[a][b][m][n] = (f32x4){0.f, 0.f, 0.f, 0.f};
        cur = nxt; cB0 = nB0; cB1 = nB1; ++ui;
#pragma unroll
        for (int h = 0; h < 2; ++h)
#pragma unroll
            for (int i = 0; i < 2; ++i) cuo[h][i] = nxo[h][i];
        if constexpr (ALIGN_EPI) { if (wr == 1) PG8_BAR; }
    }
    PG8_WAIT_V(0);
    if constexpr (!ALIGN_EPI) { if (wr == 0) PG8_BAR; }
    PG8_BAR;
#undef PG8_SA
#undef PG8_SB
#undef PG8_STAGE_A
#undef PG8_STAGE_B
#undef PG8_LDA
#undef PG8_LDB
#undef PG8_BFIX
#undef PG8_MMA
#undef PG8_WAIT_V
#undef PG8_WAIT_L
#undef PG8_BAR
#undef PG8_SCHED
#undef PG8_AOFF
#undef PG8_SIDE_ISSUE
#undef PG8_SIDE_FINISH
#undef PG8_WAIT_VS
}
}

#define XB_TMO      128
#define XB_XCNT(j)  (256  + 64 * (j))
#define XB_XSUB(j)  (1280 + 64 * (j))
#define XB_XGEN(j)  (2304 + 64 * (j))
#define XB_TOP      3328
#define XB_TOPGEN   3392
#define XCD_BAR_WORDS 3456
#define XB_SPIN_CAP (1u << 18)
__device__ __forceinline__ unsigned xb_ld(unsigned* p)              { return __hip_atomic_load(p, __ATOMIC_RELAXED, __HIP_MEMORY_SCOPE_AGENT); }
__device__ __forceinline__ unsigned xb_add(unsigned* p, unsigned v) { return __hip_atomic_fetch_add(p, v, __ATOMIC_RELAXED, __HIP_MEMORY_SCOPE_AGENT); }
__device__ __forceinline__ unsigned xb_xcc_id() { return (unsigned)__builtin_amdgcn_s_getreg((3 << 11) | 20) & 0xFu; }
#define XB_SPIN(cond, bar) do { unsigned _sp = 0; while (cond) { __builtin_amdgcn_s_sleep(1); \
    if ((++_sp & 255u) == 0u) { if (xb_ld(&(bar)[XB_TMO])) break; if (_sp > XB_SPIN_CAP) { atomicAdd(&(bar)[XB_TMO], 1u); break; } } } } while (0)
struct XcdBarrier { unsigned* bar; unsigned x; volatile LAS unsigned* st; };
__device__ __forceinline__ XcdBarrier xcd_barrier_post(unsigned* bar, volatile LAS unsigned* st) {
    XcdBarrier b; b.bar = bar; b.x = xb_xcc_id(); b.st = st;
    if (threadIdx.x == 0) (void)xb_add(&bar[XB_XCNT(b.x)], 1u);
    return b;
}
__device__ __forceinline__ void xcd_barrier_complete(unsigned* bar, unsigned x, unsigned& nloc, unsigned& nx) {
    const unsigned G = gridDim.x * gridDim.y * gridDim.z;
    unsigned sum, cnt, mine, sp = 0u;
    for (;;) {
        sum = 0u; cnt = 0u; mine = 0u;
#pragma unroll
        for (unsigned j = 0; j < 16; ++j) { const unsigned c = xb_ld(&bar[XB_XCNT(j)]); sum += c; cnt += (c > 0u) ? 1u : 0u; mine = (j == x) ? c : mine; }
        if (sum == G) break;
        __builtin_amdgcn_s_sleep(1);
        if ((++sp & 255u) == 0u) { if (xb_ld(&bar[XB_TMO])) break; if (sp > XB_SPIN_CAP) { atomicAdd(&bar[XB_TMO], 1u); break; } }
    }
    nloc = mine > 0u ? mine : 1u; nx = cnt > 0u ? cnt : 1u;
}
__device__ __forceinline__ void xcd_barrier(const XcdBarrier& b) {
    asm volatile("s_waitcnt vmcnt(0)" ::: "memory");
    __syncthreads();
    if (threadIdx.x == 0) {
        unsigned* bar = b.bar;
        __builtin_amdgcn_s_waitcnt(0);
        unsigned nloc = b.st[0], nx = b.st[1];
        if (nloc == 0u) { xcd_barrier_complete(bar, b.x, nloc, nx); b.st[0] = nloc; b.st[1] = nx; }
        const unsigned old = xb_add(&bar[XB_XSUB(b.x)], 1u);
        const unsigned gen = old / nloc;
        if (old + 1u == (gen + 1u) * nloc) {
            __builtin_amdgcn_fence(__ATOMIC_RELEASE, "agent");
            asm volatile("s_waitcnt vmcnt(0)" ::: "memory");
            const unsigned og = xb_add(&bar[XB_TOP], 1u);
            const unsigned tg = og / nx;
            if (og + 1u == (tg + 1u) * nx) xb_add(&bar[XB_TOPGEN], 1u);
            else XB_SPIN(xb_ld(&bar[XB_TOPGEN]) == tg, bar);
            __builtin_amdgcn_fence(__ATOMIC_ACQUIRE, "agent");
            xb_add(&bar[XB_XGEN(b.x)], 1u);
            asm volatile("s_waitcnt vmcnt(0)" ::: "memory");
        } else {
            XB_SPIN(xb_ld(&bar[XB_XGEN(b.x)]) == gen, bar);
            __builtin_amdgcn_fence(__ATOMIC_ACQUIRE, "agent");
            asm volatile("s_waitcnt vmcnt(0)" ::: "memory");
        }
    }
    __syncthreads();
}

struct Frame {
    LAS unsigned char* lds;
    int tid, lane, wave, vcu, G;
    const float *x, *g_mix, *w_in, *a_sink, *g_out_a, *g_out_b, *w_out, *g_ffn, *w_router, *w_gate, *w_up, *w_down, *g_final;
    float* out; unsigned char* ws;
    unsigned long long tacc;
};

__device__ __forceinline__ void p0_transpose_item(const float* W, int K, int N, h16* WT, int k0, int n0, int drow0, float sc, LAS float* scr, int lane) {
#pragma unroll 8
    for (int i = 0; i < 32; ++i) { const int kk = 2 * i + (lane >> 5); scr[kk * 33 + (lane & 31)] = W[(size_t)(k0 + kk) * N + n0 + (lane & 31)]; }
    LDS_WAIT(); asm volatile("" ::: "memory");
    const int c = lane & 7;
#pragma unroll
    for (int j = 0; j < 4; ++j) { const int n = (lane >> 3) + 8 * j; const LAS float* s = scr + (8 * c) * 33 + n;
        u32x4 o; o.x = pk_h2(s[0 * 33] * sc, s[1 * 33] * sc); o.y = pk_h2(s[2 * 33] * sc, s[3 * 33] * sc); o.z = pk_h2(s[4 * 33] * sc, s[5 * 33] * sc); o.w = pk_h2(s[6 * 33] * sc, s[7 * 33] * sc);
        *(GAS u32x4*)(WT + (size_t)(drow0 + n) * K + k0 + 8 * c) = o; }
    LDS_WAIT(); asm volatile("" ::: "memory");
}
__device__ __forceinline__ void sincos_d(double a, float& s, float& c) {
    const double q = __builtin_rint(a * 0.63661977236758134308);
    double r = __builtin_fma(-q, 1.570796325802803, a); r = __builtin_fma(-q, 9.920935796805404e-10, r);
    const double r2 = r * r;
    double sp = -7.6471637318198164759e-13;
    sp = sp * r2 + 1.6059043836821614599e-10; sp = sp * r2 - 2.5052108385441718775e-08; sp = sp * r2 + 2.7557319223985890653e-06;
    sp = sp * r2 - 1.9841269841269841270e-04; sp = sp * r2 + 8.3333333333333333333e-03; sp = sp * r2 - 1.6666666666666666667e-01;
    const double sn = r + r * r2 * sp;
    double cp = 4.7794773323873852974e-14;
    cp = cp * r2 - 1.1470745597729724714e-11; cp = cp * r2 + 2.0876756987868098979e-09; cp = cp * r2 - 2.7557319223985890653e-07;
    cp = cp * r2 + 2.4801587301587301587e-05; cp = cp * r2 - 1.3888888888888888889e-03; cp = cp * r2 + 4.1666666666666666667e-02; cp = cp * r2 - 0.5;
    const double cs = 1.0 + r2 * cp;
    const int qi = (int)q & 3;
    const double ss = (qi & 1) ? cs : sn, cc = (qi & 1) ? sn : cs;
    s = (float)((qi & 2) ? -ss : ss); c = (float)(((qi + 1) & 2) ? -cc : cc);
}

__device__ __forceinline__ void p0_prologue(Frame& F) {
    LAS float* scr = (LAS float*)(F.lds + F.wave * 16384);
    const int gw = F.vcu * NWAVES + F.wave, NGW = F.G * NWAVES;
    {
        const double invf[8] = {1.0, 0.19392274474868576, 0.03760603093086393, 0.007292664737217109, 0.001414213562373095, 0.0002742481756762073, 5.318295896944988e-05, 1.031338537721246e-05};
        float* rope = (float*)(F.ws + WS_ROPE);
        for (int idx = F.vcu * 512 + F.tid; idx < SEQ * 8; idx += F.G * 512) {
            const int pos = idx >> 3, i = idx & 7;
            double f = invf[0];
#pragma unroll
            for (int j = 1; j < 8; ++j) f = (i == j) ? invf[j] : f;
            float s, c; sincos_d((double)pos * f, s, c);
            rope[pos * 16 + i] = c; rope[pos * 16 + 8 + i] = s;
        }
    }
    {
        h16* H = (h16*)(F.ws + WS_H);
        for (int m = gw; m < M; m += NGW) {
            const GAS f32x4* xr = (const GAS f32x4*)(F.x + (size_t)m * DM) + F.lane;
            f32x4 v[4]; float s = 0.f;
#pragma unroll
            for (int j = 0; j < 4; ++j) { v[j] = xr[64 * j]; s += (v[j].x * v[j].x + v[j].y * v[j].y) + (v[j].z * v[j].z + v[j].w * v[j].w); }
            const float rs = 1.0f / sqrtf(wave_sum(s) * (1.0f / DM) + NORM_EPS);
            GAS u32x2* o8 = (GAS u32x2*)(H + (size_t)m * DM) + F.lane;
#pragma unroll
            for (int j = 0; j < 4; ++j) { const f32x4 g = ((const GAS f32x4*)F.g_mix)[F.lane + 64 * j]; const f32x4 y = v[j] * rs * g;
                u32x2 w; w.x = pk_h2(y.x, y.y); w.y = pk_h2(y.z, y.w); o8[64 * j] = w; }
        }
    }
    {
        constexpr int I_IN = (DM / 64) * (NIN / 32), I_OUT = (DM / 64) * (DM / 32);
        constexpr int NITEMS = I_IN + I_OUT;
        for (int it = gw; it < NITEMS; it += NGW) {
            int r = it;
            if (r < I_IN) { const int nblk = NIN / 32, kb = r / nblk, nb = r % nblk, n0 = 32 * nb;
                const float sc = (n0 < OFF_KA || (n0 >= OFF_QB && n0 < OFF_KB)) ? QSCALE : 1.0f;
                p0_transpose_item(F.w_in, DM, NIN, (h16*)(F.ws + WS_WIN), 64 * kb, n0, n0, sc, scr, F.lane); continue; }
            r -= I_IN;
            { const int nblk = DM / 32, kb = r / nblk, nb = r % nblk, n0 = 32 * nb;
              p0_transpose_item(F.w_out, DM, DM, (h16*)(F.ws + WS_WOUT), 64 * kb, n0, n0, 1.0f, scr, F.lane); }
        }
    }
}

#define TSEC_BEGIN(code) unsigned long long tsec_##code = 0; if (TIME_PHASE == (code)) tsec_##code = __builtin_amdgcn_s_memrealtime()
#define TSEC_END(code) do { if (TIME_PHASE == (code)) F.tacc += __builtin_amdgcn_s_memrealtime() - tsec_##code; } while (0)
namespace att {
__device__ __forceinline__ int crow(int r, int hi) { return (r & 3) + 8 * (r >> 2) + 4 * hi; }
constexpr float THR = 8.0f;
constexpr int ATT_SIDE = 0;
constexpr int TILE_BYTES = 16384;
constexpr int WSF_OFF = 98304, STG_OFF = 100352;

__device__ __forceinline__ float max3f(float a, float b, float c) { float r; asm("v_max3_f32 %0, %1, %2, %3" : "=v"(r) : "v"(a), "v"(b), "v"(c)); return r; }
__device__ __forceinline__ float max16(const f32x16& p) {
    float a = max3f(p[0], p[1], p[2]), b = max3f(p[3], p[4], p[5]); a = max3f(a, p[6], p[7]); b = max3f(b, p[8], p[9]); a = max3f(a, p[10], p[11]); b = max3f(b, p[12], p[13]);
    return max3f(a, b, max3f(p[14], p[15], p[15])); }
__device__ __forceinline__ void tile_step(f32x16& o0, f32x16& o1, float& m, float& l, f32x16& negm, bool first, const half8 (&qr)[4],
                                          LAS const unsigned char* kt, LAS const unsigned char* vt, LAS float* wsf, int lane, int r32, int hi,
                                          int mode0, int mode1, int rel0, int lo, unsigned span) {
    f32x16 p0 = negm, p1 = negm;
    LAS const unsigned char* kb = kt + hi * 1024 + r32 * 16;
    const float NINF = -__builtin_inff();
    float rm = NINF;
    if (mode0) {
#pragma unroll
        for (int d0 = 0; d0 < 4; ++d0) p0 = __builtin_amdgcn_mfma_f32_32x32x16_f16(*(LAS const half8*)(kb + d0 * 2048), qr[d0], p0, 0, 0, 0);
        asm volatile("s_nop 15\n\ts_nop 7" : "+v"(p0));
        if (mode0 == 2) {
#pragma unroll
            for (int r = 0; r < 16; ++r) { const int rel = rel0 + (r & 3) + 8 * (r >> 2); if ((unsigned)(rel - lo) > span) p0[r] = NINF; }
        }
        rm = max16(p0);
    }
    if (mode1) {
#pragma unroll
        for (int d0 = 0; d0 < 4; ++d0) p1 = __builtin_amdgcn_mfma_f32_32x32x16_f16(*(LAS const half8*)(kb + d0 * 2048 + 512), qr[d0], p1, 0, 0, 0);
        asm volatile("s_nop 15\n\ts_nop 7" : "+v"(p1));
        if (mode1 == 2) {
#pragma unroll
            for (int r = 0; r < 16; ++r) { const int rel = rel0 + 32 + (r & 3) + 8 * (r >> 2); if ((unsigned)(rel - lo) > span) p1[r] = NINF; }
        }
        rm = fmaxf(rm, max16(p1));
    }
    { auto rr = __builtin_amdgcn_permlane32_swap(__float_as_uint(rm), __float_as_uint(rm), false, false); rm = fmaxf(__uint_as_float(rr[0]), __uint_as_float(rr[1])); }
    if (first || __any(rm > THR)) {
        const float dl = first ? fmaxf(rm, -100.f) : fmaxf(rm, 0.f); m += dl;
#pragma unroll
        for (int r = 0; r < 16; ++r) { p0[r] -= dl; p1[r] -= dl; negm[r] = -m; }
        if (!first) {
            const float f = __builtin_amdgcn_exp2f(-dl); l *= f;
            if (hi == 0) wsf[r32] = f;
            LDS_WAIT();
#pragma unroll
            for (int r = 0; r < 16; ++r) { const float fr_ = wsf[crow(r, hi)]; o0[r] *= fr_; o1[r] *= fr_; }
        }
    }
    LAS const unsigned char* vb = vt + (4 * hi + ((lane & 15) >> 2)) * 64 + ((lane >> 4) & 1) * 32 + (lane & 3) * 8;
    typedef short s16x8 __attribute__((ext_vector_type(8)));
    float s = 0.f;
#define ATT_HALF(P, KS0) do { \
        _Pragma("unroll") for (int r = 0; r < 16; ++r) { P[r] = __builtin_amdgcn_exp2f(P[r]); s += P[r]; } \
        u32x4 pwa, pwb; \
        _Pragma("unroll") for (int j = 0; j < 4; ++j) { pwa[j] = pk_h2_rtz(P[2 * j], P[2 * j + 1]); pwb[j] = pk_h2_rtz(P[8 + 2 * j], P[9 + 2 * j]); } \
        _Pragma("unroll") for (int kk = 0; kk < 2; ++kk) { const half8 pa = __builtin_bit_cast(half8, kk ? pwb : pwa); \
            _Pragma("unroll") for (int d0 = 0; d0 < 2; ++d0) { \
                const s16x4 vlo = __builtin_amdgcn_ds_read_tr16_b64_v4i16((LAS s16x4*)(vb + d0 * 4096 + ((KS0) + kk) * 1024)); \
                const s16x4 vhi = __builtin_amdgcn_ds_read_tr16_b64_v4i16((LAS s16x4*)(vb + d0 * 4096 + ((KS0) + kk) * 1024 + 512)); \
                const s16x8 vv = {vlo[0], vlo[1], vlo[2], vlo[3], vhi[0], vhi[1], vhi[2], vhi[3]}; \
                const half8 vf = __builtin_bit_cast(half8, vv); \
                if (d0 == 0) o0 = __builtin_amdgcn_mfma_f32_32x32x16_f16(pa, vf, o0, 0, 0, 0); \
                else         o1 = __builtin_amdgcn_mfma_f32_32x32x16_f16(pa, vf, o1, 0, 0, 0); } } } while (0)
    if (mode0) ATT_HALF(p0, 0);
    if (mode1) ATT_HALF(p1, 2);
#undef ATT_HALF
    l += s;
}

__device__ __forceinline__ void load_tile_regs(u32x4& kreg, u32x4& vreg, const h16* proj, int tokb, int dil, int LF, int tt0, int kcol, int vcol, int wid, int lane) {
    int tk = tt0 + lane; tk = tk < 0 ? 0 : (tk >= LF ? LF - 1 : tk);
    kreg = *(const u32x4*)(proj + (size_t)(tokb + tk * dil) * NIN + kcol + wid * 8);
    int tv = tt0 + (wid & 3) * 16 + (lane >> 2); tv = tv < 0 ? 0 : (tv >= LF ? LF - 1 : tv);
    vreg = *(const u32x4*)(proj + (size_t)(tokb + tv * dil) * NIN + vcol + (wid >> 2) * 32 + (lane & 3) * 8);
}

__device__ __forceinline__ void store_out(const f32x16& o0, const f32x16& o1, float l_tot, LAS float* wsf, LAS h16* stg, h16* dst, size_t pitch, int tok0, int dil, int lane, int r32, int hi) {
    if (hi == 0) wsf[32 + r32] = l_tot;
    LDS_WAIT();
#pragma unroll
    for (int r = 0; r < 16; ++r) { const int orow = crow(r, hi); const float rl = __builtin_amdgcn_rcpf(wsf[32 + orow]);
        stg[orow * 64 + r32] = __builtin_bit_cast(h16, (_Float16)(o0[r] * rl)); stg[orow * 64 + 32 + r32] = __builtin_bit_cast(h16, (_Float16)(o1[r] * rl)); }
    LDS_WAIT();
#pragma unroll
    for (int i = 0; i < 4; ++i) { const int row = i * 8 + (lane >> 3), ch = lane & 7; const u32x4 v = *(LAS const u32x4*)(stg + row * 64 + ch * 8);
        *(u32x4*)(dst + (size_t)(tok0 + row * dil) * pitch + ch * 8) = v; }
    LDS_WAIT();
}

struct UnitP { int isA, ntile, tt_first, dil, LF, tokb, kcol, vcol, hw, q0, g, h, p; };
__device__ __forceinline__ UnitP decode_unit(int u) {
    UnitP P;
    if (u < 512) { const int qb = u & 63, g = (u >> 6) & 1, b = u >> 7;
        P.isA = 1; P.ntile = 5; P.q0 = qb * 64; P.tt_first = P.q0 - 128; P.dil = 1; P.LF = SEQ; P.tokb = b * SEQ; P.kcol = OFF_KA + g * 64; P.vcol = OFF_VA + g * 64; P.hw = 128; P.g = g; P.h = 0; P.p = 0; }
    else { const int v = u - 512, u16 = v & 15, p = (v >> 4) % 3, bh = v / 48, h = bh & 7, b = bh >> 3, sh = 2 * p, dil = 1 << sh, res = u16 & (dil - 1), qb = u16 >> sh;
        P.isA = 0; P.ntile = 6; P.q0 = 256 * qb; P.tt_first = P.q0 - 64; P.dil = dil; P.LF = SEQ >> sh; P.tokb = b * SEQ + res; P.kcol = OFF_KB + h * 64; P.vcol = OFF_VB + h * 64; P.hw = 64; P.g = 0; P.h = h; P.p = p; }
    return P;
}
__device__ __forceinline__ void issue_tiles(u32x4 (&kr)[6], u32x4 (&vr)[6], const UnitP& P, const h16* proj, int wid, int lane) {
#pragma unroll
    for (int j = 0; j < 6; ++j) { const int tt0 = P.tt_first + 64 * j; if (j < P.ntile && tt0 >= 0 && tt0 < P.LF) load_tile_regs(kr[j], vr[j], proj, P.tokb, P.dil, P.LF, tt0, P.kcol, P.vcol, wid, lane); }
}
__device__ __forceinline__ void write_tiles(LAS unsigned char* L, const u32x4 (&kr)[6], const u32x4 (&vr)[6], const UnitP& P, int wid, int lane) {
#pragma unroll
    for (int j = 0; j < 6; ++j) { const int tt0 = P.tt_first + 64 * j; if (j < P.ntile && tt0 >= 0 && tt0 < P.LF) {
        *(LAS u32x4*)(L + j * TILE_BYTES + wid * 1024 + lane * 16) = kr[j];
        *(LAS u32x4*)(L + j * TILE_BYTES + 8192 + wid * 1024 + lane * 16) = vr[j]; } }
}

__device__ __forceinline__ void attn_phase(Frame& F) {
    const int lane = F.lane, wid = F.wave, r32 = lane & 31, hi = lane >> 5;
    LAS unsigned char* L = F.lds;
    LAS float* wsf = (LAS float*)(L + WSF_OFF) + wid * 64;
    LAS h16* stg = (LAS h16*)(L + STG_OFF + wid * 4096);
    const h16* proj = (const h16*)(F.ws + WS_PROJ);
    int u = F.vcu;
    if (u >= 2048) return;
    UnitP P = decode_unit(u);
    u32x4 kr[6], vr[6];
    issue_tiles(kr, vr, P, proj, wid, lane);
#pragma unroll 1
    for (; u < 2048; u += F.G) {
        TSEC_BEGIN(20);
        write_tiles(L, kr, vr, P, wid, lane);
        int head, tq, qcol, jb, je, qw0;
        if (P.isA) { head = 4 * P.g + (wid & 3); qw0 = P.q0 + 32 * (wid >> 2); qcol = OFF_QA + head * 64; jb = 0; je = 5; }
        else       { head = P.h; qw0 = P.q0 + 32 * wid; qcol = OFF_QB + head * 64; jb = wid >> 1; je = jb + 3; }
        tq = qw0 + r32;
        half8 qr[4];
        { const h16* qp = proj + (size_t)(P.tokb + tq * P.dil) * NIN + qcol + hi * 8;
#pragma unroll
          for (int d0 = 0; d0 < 4; ++d0) qr[d0] = *(const half8*)(qp + d0 * 16); }
        float m = P.isA ? F.a_sink[head] * LOG2E : 0.f, l = (P.isA && hi == 0) ? 1.0f : 0.0f;
        bool first = !P.isA;
        asm volatile("" ::: "memory");
        __syncthreads();
        asm volatile("s_waitcnt vmcnt(0)" ::: "memory");
#pragma unroll
        for (int d0 = 0; d0 < 4; ++d0) asm volatile("" : "+v"(qr[d0]));
        TSEC_END(20);
        TSEC_BEGIN(21);
        const UnitP Pc = P;
        if (u + F.G < 2048) { P = decode_unit(u + F.G); issue_tiles(kr, vr, P, proj, wid, lane); }
        asm volatile("" ::: "memory");
        f32x16 o0, o1, negm;
#pragma unroll
        for (int r = 0; r < 16; ++r) { o0[r] = 0.f; o1[r] = 0.f; negm[r] = -m; }
        const int lo = (-Pc.hw > -tq) ? -Pc.hw : -tq, hi_ = (Pc.hw < Pc.LF - 1 - tq) ? Pc.hw : (Pc.LF - 1 - tq); const unsigned span = (unsigned)(hi_ - lo);
#pragma unroll 1
        for (int j = jb; j < je; ++j) {
            const int tt0 = Pc.tt_first + 64 * j; if (tt0 < 0 || tt0 >= Pc.LF) continue;
            int md[2];
#pragma unroll
            for (int h = 0; h < 2; ++h) { const int mn = tt0 + 32 * h - (qw0 + 31), mx = tt0 + 32 * h + 31 - qw0;
                md[h] = (mn > Pc.hw || mx < -Pc.hw) ? 0 : ((mn >= -Pc.hw && mx <= Pc.hw) ? 1 : 2); }
            if ((md[0] | md[1]) == 0) continue;
            tile_step(o0, o1, m, l, negm, first, qr, L + j * TILE_BYTES, L + j * TILE_BYTES + 8192, wsf, lane, r32, hi, md[0], md[1], tt0 + 4 * hi - tq, lo, span);
            first = false;
        }
        { auto rr = __builtin_amdgcn_permlane32_swap(__float_as_uint(l), __float_as_uint(l), false, false); l = __uint_as_float(rr[0]) + __uint_as_float(rr[1]); }
        TSEC_END(21);
        TSEC_BEGIN(22);
        if (Pc.isA) store_out(o0, o1, l, wsf, stg, (h16*)(F.ws + WS_OA) + head * 64, 512, Pc.tokb + qw0, 1, lane, r32, hi);
        else {
            if (hi == 0) ((float*)(F.ws + WS_LSE))[((size_t)Pc.p * M + Pc.tokb + tq * Pc.dil) * 8 + head] = (m + __builtin_amdgcn_logf(l)) * LN2;
            store_out(o0, o1, l, wsf, stg, (h16*)(F.ws + WS_OB) + (size_t)Pc.p * M * 512 + head * 64, 512, Pc.tokb + qw0 * Pc.dil, Pc.dil, lane, r32, hi);
        }
        __syncthreads();
        TSEC_END(22);
    }
}
}

__device__ __forceinline__ void p3_combine(Frame& F) {
    const int gw = F.vcu * NWAVES + F.wave, NGW = F.G * NWAVES, lane = F.lane;
    const h16* OA = (const h16*)(F.ws + WS_OA); const h16* OB = (const h16*)(F.ws + WS_OB); const float* LSE = (const float*)(F.ws + WS_LSE);
    h16* MX = (h16*)(F.ws + WS_MIXED);
    f32x4 ga[2], gb[2];
#pragma unroll
    for (int i = 0; i < 2; ++i) { ga[i] = *(const f32x4*)(F.g_out_a + 8 * lane + 4 * i); gb[i] = *(const f32x4*)(F.g_out_b + 8 * lane + 4 * i); }
    for (int t = gw; t < M; t += NGW) {
        const u32x4 ra = *(const u32x4*)(OA + (size_t)t * 512 + 8 * lane);
        u32x4 rb[3]; float ls[3];
#pragma unroll
        for (int p = 0; p < 3; ++p) { rb[p] = *(const u32x4*)(OB + ((size_t)p * M + t) * 512 + 8 * lane); ls[p] = LSE[((size_t)p * M + t) * 8 + (lane >> 3)]; }
        float a[8], bsum[8];
#pragma unroll
        for (int i = 0; i < 4; ++i) { a[2 * i] = h2f((unsigned short)(ra[i] & 0xffffu)); a[2 * i + 1] = h2f((unsigned short)(ra[i] >> 16)); }
        const float mx = fmaxf(ls[0], fmaxf(ls[1], ls[2]));
        float w[3]; float ws_ = 0.f;
#pragma unroll
        for (int p = 0; p < 3; ++p) { w[p] = __expf(ls[p] - mx); ws_ += w[p]; }
        const float inv = 1.0f / ws_;
#pragma unroll
        for (int i = 0; i < 8; ++i) bsum[i] = 0.f;
#pragma unroll
        for (int p = 0; p < 3; ++p) { const float wp = w[p] * inv;
#pragma unroll
            for (int i = 0; i < 4; ++i) { bsum[2 * i] += wp * h2f((unsigned short)(rb[p][i] & 0xffffu)); bsum[2 * i + 1] += wp * h2f((unsigned short)(rb[p][i] >> 16)); } }
        float sa = 0.f, sb = 0.f;
#pragma unroll
        for (int i = 0; i < 8; ++i) { sa += a[i] * a[i]; sb += bsum[i] * bsum[i]; }
        const float rsa = 1.0f / sqrtf(wave_sum(sa) * (1.0f / 512.0f) + NORM_EPS), rsb = 1.0f / sqrtf(wave_sum(sb) * (1.0f / 512.0f) + NORM_EPS);
        u32x4 wa, wb;
#pragma unroll
        for (int i = 0; i < 4; ++i) { wa[i] = pk_h2(a[2 * i] * rsa * ga[i >> 1][(2 * i) & 3], a[2 * i + 1] * rsa * ga[i >> 1][(2 * i + 1) & 3]);
                                      wb[i] = pk_h2(bsum[2 * i] * rsb * gb[i >> 1][(2 * i) & 3], bsum[2 * i + 1] * rsb * gb[i >> 1][(2 * i + 1) & 3]); }
        *(u32x4*)(MX + (size_t)t * DM + 8 * lane) = wa;
        *(u32x4*)(MX + (size_t)t * DM + 512 + 8 * lane) = wb;
    }
}

__device__ __forceinline__ void p5_router(Frame& F) {
    const int gw = F.vcu * NWAVES + F.wave, NGW = F.G * NWAVES, lane = F.lane;
    LAS unsigned char* L = F.lds;
    for (int i = F.tid; i < DM * 4; i += NWAVES * 64) { const int k = i >> 2, c = i & 3; *(LAS f32x4*)(L + k * 64 + (k >> 2) * 16 + c * 16) = *(const f32x4*)(F.w_router + k * 16 + c * 4); }
    __syncthreads();
    const h16* X1 = (const h16*)(F.ws + WS_X1); unsigned char* H2 = F.ws + WS_H2; float* AFF = (float*)(F.ws + WS_AFF);
    f32x4 g[4];
#pragma unroll
    for (int j = 0; j < 4; ++j) g[j] = ((const f32x4*)F.g_ffn)[lane + 64 * j];
    u32x2 vn[4];
    if (gw < M) {
#pragma unroll
        for (int j = 0; j < 4; ++j) vn[j] = ((const u32x2*)(X1 + (size_t)gw * DM) + lane)[64 * j];
    }
    for (int t = gw; t < M; t += NGW) {
        f32x4 v[4]; float s = 0.f;
#pragma unroll
        for (int j = 0; j < 4; ++j) { v[j].x = h2f((unsigned short)(vn[j].x & 0xffffu)); v[j].y = h2f((unsigned short)(vn[j].x >> 16)); v[j].z = h2f((unsigned short)(vn[j].y & 0xffffu)); v[j].w = h2f((unsigned short)(vn[j].y >> 16)); }
        if (t + NGW < M) {
#pragma unroll
            for (int j = 0; j < 4; ++j) vn[j] = ((const u32x2*)(X1 + (size_t)(t + NGW) * DM) + lane)[64 * j];
        }
#pragma unroll
        for (int j = 0; j < 4; ++j) s += (v[j].x * v[j].x + v[j].y * v[j].y) + (v[j].z * v[j].z + v[j].w * v[j].w);
        const float rs = 1.0f / sqrtf(wave_sum(s) * (1.0f / DM) + NORM_EPS);
        unsigned* o4 = (unsigned*)(H2 + (size_t)t * DM) + lane;
        float acc[16];
#pragma unroll
        for (int e = 0; e < 16; ++e) acc[e] = 0.f;
#pragma unroll
        for (int j = 0; j < 4; ++j) {
            const f32x4 y = v[j] * rs * g[j];
            o4[64 * j] = pk_fp8x4(clamp8(y.x * S_H2), clamp8(y.y * S_H2), clamp8(y.z * S_H2), clamp8(y.w * S_H2));
#pragma unroll
            for (int c = 0; c < 4; ++c) {
                const int k = 256 * j + 4 * lane + c; LAS const f32x4* wr = (LAS const f32x4*)(L + k * 64 + (k >> 2) * 16);
#pragma unroll
                for (int q = 0; q < 4; ++q) { const f32x4 wv = wr[q];
#pragma unroll
                    for (int z = 0; z < 4; ++z) acc[4 * q + z] += y[c] * wv[z]; }
                if (c & 1) asm volatile("" ::: "memory");
            }
        }
        { const bool up = (lane & 32) != 0;
#pragma unroll
          for (int i = 0; i < 8; ++i) { const float send = up ? acc[i] : acc[i + 8], keep = up ? acc[i + 8] : acc[i]; acc[i] = keep + __shfl_xor(send, 32); } }
        { const bool up = (lane & 16) != 0;
#pragma unroll
          for (int i = 0; i < 4; ++i) { const float send = up ? acc[i] : acc[i + 4], keep = up ? acc[i + 4] : acc[i]; acc[i] = keep + __shfl_xor(send, 16); } }
        { const bool up = (lane & 8) != 0;
#pragma unroll
          for (int i = 0; i < 2; ++i) { const float send = up ? acc[i] : acc[i + 2], keep = up ? acc[i + 2] : acc[i]; acc[i] = keep + __shfl_xor(send, 8); } }
        float lg;
        { const bool up = (lane & 4) != 0; const float send = up ? acc[0] : acc[1], keep = up ? acc[1] : acc[0]; lg = keep + __shfl_xor(send, 4); }
        lg += __shfl_xor(lg, 2); lg += __shfl_xor(lg, 1);
        float mx = lg;
#pragma unroll
        for (int o = 4; o < 64; o <<= 1) mx = fmaxf(mx, __shfl_xor(mx, o));
        const float ex = __expf(lg - mx); float sm = ex;
#pragma unroll
        for (int o = 4; o < 64; o <<= 1) sm += __shfl_xor(sm, o);
        if ((lane & 3) == 0) { const int e = lane >> 2, b = t >> 12, sidx = t & (SEQ - 1); AFF[((size_t)(b * NE + e)) * SEQ + sidx] = ex / sm; }
    }
}

__device__ __forceinline__ void p6_topk(Frame& F) {
    LAS unsigned* cnt = (LAS unsigned*)F.lds;
    const int tid = F.tid, lane = F.lane, wid = F.wave;
    const float* AFF = (const float*)(F.ws + WS_AFF);
    int* TOK = (int*)(F.ws + WS_TOK); float* GATE = (float*)(F.ws + WS_GATE); int* SLOT = (int*)(F.ws + WS_SLOT);
    for (int pair = F.vcu; pair < BATCH * NE; pair += F.G) {
        const int b = pair >> 4, e = pair & 15;
        const float* a = AFF + (size_t)pair * SEQ + 8 * tid;
        const f32x4 a0 = *(const f32x4*)a, a1 = *(const f32x4*)(a + 4);
        unsigned key[8];
#pragma unroll
        for (int j = 0; j < 4; ++j) { key[j] = __float_as_uint(a0[j]); key[4 + j] = __float_as_uint(a1[j]); }
        unsigned prefix = 0u;
        __syncthreads();
#pragma unroll 1
        for (int bit = 31; bit >= 0; --bit) {
            const unsigned cand = prefix | (1u << bit);
            unsigned c = 0;
#pragma unroll
            for (int j = 0; j < 8; ++j) c += (unsigned)__popcll(__ballot(key[j] >= cand));
            LAS unsigned* cc = cnt + ((bit & 1) ? 8 : 0);
            if (lane == 0) cc[wid] = c;
            __syncthreads();
            unsigned tot = 0;
#pragma unroll
            for (int w = 0; w < 8; ++w) tot += cc[w];
            if (tot >= (unsigned)CAP) prefix = cand;
        }
        unsigned cg = 0, ce = 0;
#pragma unroll
        for (int j = 0; j < 8; ++j) { cg += key[j] > prefix; ce += key[j] == prefix; }
        unsigned pk = (ce << 16) | cg, inc = pk;
#pragma unroll
        for (int o = 1; o < 64; o <<= 1) { const unsigned n = __shfl_up(inc, o); if (lane >= o) inc += n; }
        __syncthreads();
        LAS unsigned* ws_ = cnt + 16;
        if (lane == 63) ws_[wid] = inc;
        __syncthreads();
        unsigned base = 0, total = 0;
#pragma unroll
        for (int w = 0; w < 8; ++w) { const unsigned x = ws_[w]; if (w < wid) base += x; total += x; }
        const unsigned exc = base + inc - pk;
        unsigned gtb = exc & 0xffffu, eqb = exc >> 16;
        const unsigned need = (unsigned)CAP - (total & 0xffffu);
#pragma unroll
        for (int j = 0; j < 8; ++j) {
            const int sidx = 8 * tid + j; int slot = -1;
            if (key[j] > prefix) { slot = (int)(gtb + (eqb < need ? eqb : need)); ++gtb; }
            else if (key[j] == prefix) { if (eqb < need) slot = (int)(gtb + eqb); ++eqb; }
            SLOT[((size_t)(b * SEQ + sidx)) * NE + e] = slot;
            if (slot >= 0) { TOK[e * EROWS + b * CAP + slot] = b * SEQ + sidx; GATE[e * EROWS + b * CAP + slot] = __uint_as_float(key[j]); }
        }
        __syncthreads();
    }
}

__device__ __forceinline__ void p9_final(Frame& F) {
    const int gw = F.vcu * NWAVES + F.wave, NGW = F.G * NWAVES, lane = F.lane;
    const int* SLOT = (const int*)(F.ws + WS_SLOT); const unsigned char* YE = F.ws + WS_YE;
    f32x4 g[4];
#pragma unroll
    for (int j = 0; j < 4; ++j) g[j] = ((const f32x4*)F.g_final)[lane + 64 * j];
    int myslot = (gw < M) ? SLOT[(size_t)gw * NE + (lane & 15)] : -1;
    for (int t = gw; t < M; t += NGW) {
        f32x4* xr = (f32x4*)(F.out + (size_t)t * DM) + lane;
        const u32x2* xi = (const u32x2*)((const h16*)(F.ws + WS_X1) + (size_t)t * DM) + lane;
        f32x4 v[4];
#pragma unroll
        for (int j = 0; j < 4; ++j) { const u32x2 w = xi[64 * j]; v[j].x = h2f((unsigned short)(w.x & 0xffffu)); v[j].y = h2f((unsigned short)(w.x >> 16)); v[j].z = h2f((unsigned short)(w.y & 0xffffu)); v[j].w = h2f((unsigned short)(w.y >> 16)); }
        const int slot_cur = myslot;
        const int tn = t + NGW;
        myslot = (tn < M) ? SLOT[(size_t)tn * NE + (lane & 15)] : -1;
        unsigned mask = (unsigned)(__ballot(slot_cur >= 0) & 0xffffull);
        const size_t ebase = (size_t)(t >> 12) * CAP;
        while (mask) {
            int e[4]; float w[4];
#pragma unroll
            for (int q = 0; q < 4; ++q) { const bool has = mask != 0u; e[q] = has ? (int)__builtin_ctz(mask) : e[0]; w[q] = has ? 1.f : 0.f; mask = has ? (mask & (mask - 1u)) : 0u; }
            unsigned y[4][4];
#pragma unroll
            for (int q = 0; q < 4; ++q) { const int sl = __builtin_amdgcn_readlane(slot_cur, e[q]);
                const unsigned* yr = (const unsigned*)(YE + ((size_t)e[q] * EROWS + ebase + sl) * DM) + lane;
#pragma unroll
                for (int j = 0; j < 4; ++j) y[q][j] = yr[64 * j]; }
#pragma unroll
            for (int q = 0; q < 4; ++q) { const float wq = w[q] * (1.0f / S_YE);
#pragma unroll
                for (int j = 0; j < 4; ++j) { const auto lo2 = __builtin_amdgcn_cvt_pk_f32_fp8((int)y[q][j], false), hi2 = __builtin_amdgcn_cvt_pk_f32_fp8((int)y[q][j], true);
                    v[j].x += wq * lo2[0]; v[j].y += wq * lo2[1]; v[j].z += wq * hi2[0]; v[j].w += wq * hi2[1]; } }
        }
        float s = 0.f;
#pragma unroll
        for (int j = 0; j < 4; ++j) s += (v[j].x * v[j].x + v[j].y * v[j].y) + (v[j].z * v[j].z + v[j].w * v[j].w);
        const float rs = 1.0f / sqrtf(wave_sum(s) * (1.0f / DM) + NORM_EPS);
#pragma unroll
        for (int j = 0; j < 4; ++j) xr[64 * j] = v[j] * rs * g[j];
    }
}

constexpr int NPHASE = 10;
struct Args { const float* in[13]; float* out; unsigned char* ws; int ph_lo, ph_hi, li, pad; };

__global__ void __launch_bounds__(NWAVES * 64, 2) mk_fwd(Args args) {
    extern __shared__ __attribute__((aligned(16))) unsigned char lds[];
    Frame F;
    F.lds = (LAS unsigned char*)lds;
    F.tid = threadIdx.x; F.lane = F.tid & 63; F.wave = __builtin_amdgcn_readfirstlane(F.tid >> 6);
    F.G = gridDim.x; { const int bx = blockIdx.x; F.vcu = (F.G % 8 == 0) ? (bx % 8) * (F.G / 8) + bx / 8 : bx; }
    F.x = args.in[0]; F.g_mix = args.in[1]; F.w_in = args.in[2]; F.a_sink = args.in[3]; F.g_out_a = args.in[4]; F.g_out_b = args.in[5]; F.w_out = args.in[6];
    F.g_ffn = args.in[7]; F.w_router = args.in[8]; F.w_gate = args.in[9]; F.w_up = args.in[10]; F.w_down = args.in[11]; F.g_final = args.in[12];
    F.out = args.out; F.ws = args.ws; F.tacc = 0;
    volatile LAS unsigned* MISC = (volatile LAS unsigned*)(F.lds + MISC_OFF);
    for (int u = F.tid; u < (LDS_BYTES - LDSCTL_OFF) / 4; u += NWAVES * 64) ((LAS unsigned*)(F.lds + LDSCTL_OFF))[u] = 0u;
    __syncthreads();
    const int lo = args.ph_lo, hi = args.ph_hi;
    const bool multi = (hi - lo) > 1;
    unsigned* barw = (unsigned*)(F.ws + WS_CTL) + CW_BAR + args.li * XCD_BAR_WORDS;
    XcdBarrier bar; bar.bar = barw; bar.x = 0; bar.st = nullptr;
    if (multi) bar = xcd_barrier_post(barw, MISC + 8);
#define IN(k) (((PH_MASK >> (k)) & 1) && lo <= (k) && (k) < hi)
#define SEAM(k) do { if (IN(k) && IN((k) + 1)) xcd_barrier(bar); } while (0)
#define TS0(k) do { if (TIME_PHASE == (k)) ts0_ = __builtin_amdgcn_s_memrealtime(); } while (0)
#define TS1(k) do { if (TIME_PHASE == (k)) ts1_ = __builtin_amdgcn_s_memrealtime(); } while (0)
    unsigned long long ts0_ = 0, ts1_ = 0;
#define REPS(k) for (int rep_ = 0; rep_ < 1 + ((REP_MASK >> (k)) & 1); ++rep_)

    TS0(0);
    if (IN(0)) REPS(0) { p0_prologue(F); SEAM(0); }
    TS1(0);
    TS0(1);
    if (IN(1)) {
        pg8::DenseProb P{(const char*)(F.ws + WS_H), (const char*)(F.ws + WS_WIN), DM * 2};
        pg8::DenseOrder S; S.init(M, NIN, F.G, (int)blockIdx.x, 1 + ((REP_MASK >> 1) & 1));
        pg8::EpiInProj E{(h16*)(F.ws + WS_PROJ), (const float*)(F.ws + WS_ROPE)};
        pg8::gemm_phase<pg8::DenseProb, pg8::EpiInProj, pg8::DenseOrder, true>(F.lds, P, S, E);
        SEAM(1);
    }
    TS1(1);
    TS0(2);
    if (IN(2)) REPS(2) { att::attn_phase(F); SEAM(2); }
    TS1(2);
    TS0(3);
    if (IN(3)) REPS(3) { p3_combine(F); SEAM(3); }
    TS1(3);
    TS0(4);
    if (IN(4)) {
        pg8::DenseProb P{(const char*)(F.ws + WS_MIXED), (const char*)(F.ws + WS_WOUT), DM * 2};
        pg8::DenseOrder S; S.init(M, DM, F.G, (int)blockIdx.x, 1 + ((REP_MASK >> 4) & 1));
        pg8::EpiResidual E{F.x, (h16*)(F.ws + WS_X1)};
        pg8::gemm_phase<pg8::DenseProb, pg8::EpiResidual, pg8::DenseOrder, true>(F.lds, P, S, E);
        SEAM(4);
    }
    TS1(4);
    TS0(5);
    if (IN(5)) REPS(5) { p5_router(F); SEAM(5); }
    TS1(5);
    TS0(6);
    if (IN(6)) REPS(6) { p6_topk(F); conv8_dynamic(F.w_gate, F.w_up, F.w_down, F.ws, (unsigned*)(F.ws + WS_CTL) + CW_CONV, nullptr, 0u, (LAS float*)(F.lds + F.wave * 16384), MISC + 16, F.tid, F.wave, F.lane); SEAM(6); }
    TS1(6);
    TS0(7);
    if (IN(7)) {
        pg8::Moe1Prob P{(const char*)(F.ws + WS_H2), (const char*)(F.ws + WS_WGU), DM, (const int*)(F.ws + WS_TOK)};
        pg8::GroupOrder S; S.init(EROWS / 256, 4096 / 256, NE, F.G, F.vcu, 1 + ((REP_MASK >> 7) & 1));
        pg8::EpiSwiGLU E{F.ws + WS_HMID};
        pg8::gemm_phase<pg8::Moe1Prob, pg8::EpiSwiGLU, pg8::GroupOrder, true>(F.lds, P, S, E);
        SEAM(7);
    }
    TS1(7);
    TS0(8);
    if (IN(8)) {
        pg8::Moe2Prob P{(const char*)(F.ws + WS_HMID), (const char*)(F.ws + WS_WD), FF};
        pg8::GroupOrder S; S.init(EROWS / 256, DM / 256, NE, F.G, F.vcu, 1 + ((REP_MASK >> 8) & 1));
        pg8::EpiDown E{F.ws + WS_YE, (const float*)(F.ws + WS_GATE)};
        pg8::gemm_phase<pg8::Moe2Prob, pg8::EpiDown, pg8::GroupOrder, true>(F.lds, P, S, E);
        SEAM(8);
    }
    TS1(8);
    TS0(9);
    if (IN(9)) REPS(9) { p9_final(F); if (rep_ == 0 && ((REP_MASK >> 9) & 1)) xcd_barrier(bar); }
    TS1(9);
    if (TIME_PHASE >= 0 && blockIdx.x == 0 && F.tid == 0) { asm volatile("s_waitcnt vmcnt(0)" ::: "memory"); F.out[0] += (float)(TIME_PHASE >= 20 ? F.tacc : (ts1_ - ts0_)) * 0.01f * TIME_SCALE; }
#undef IN
#undef SEAM
}

extern "C" void kernel_launch(void* const* d_in, const int* in_sizes, int n_in, void* d_out, int out_size, void* d_ws, size_t ws_size, hipStream_t stream) {
    static int grid = 0;
    if (grid == 0) {
        if (n_in != 13 || in_sizes[0] != M * DM || out_size != M * DM || ws_size < WS_END) { fprintf(stderr, "kernel_launch: unexpected problem (n_in %d, ws %zu)\n", n_in, ws_size); grid = -1; return; }
        int dev = 0, cus = 0, per_cu = 0;
        if (hipGetDevice(&dev) != hipSuccess || hipDeviceGetAttribute(&cus, hipDeviceAttributeMultiprocessorCount, dev) != hipSuccess) { grid = -1; return; }
        if (hipFuncSetAttribute((const void*)mk_fwd, hipFuncAttributeMaxDynamicSharedMemorySize, LDS_BYTES) != hipSuccess) { fprintf(stderr, "kernel_launch: hipFuncSetAttribute failed\n"); grid = -1; return; }
        if (hipOccupancyMaxActiveBlocksPerMultiprocessor(&per_cu, (const void*)mk_fwd, NWAVES * 64, LDS_BYTES) != hipSuccess || per_cu < 1)
            fprintf(stderr, "kernel_launch: occupancy query reports %d blocks per CU\n", per_cu);
        (void)hipGetLastError();
        grid = cus;
    }
    if (grid < 0) return;
    (void)hipMemsetAsync((char*)d_ws + WS_CTL, 0, CTL_ZERO_BYTES, stream);
    Args a{};
    for (int i = 0; i < 13; ++i) a.in[i] = (const float*)d_in[i];
    a.out = (float*)d_out; a.ws = (unsigned char*)d_ws;
    if (MK_N_LAUNCHES == 1) {
        for (int pass = 0; pass < REP_ALL; ++pass) { a.ph_lo = 0; a.ph_hi = NPHASE; a.li = pass;
        hipLaunchKernelGGL(mk_fwd, dim3(grid), dim3(NWAVES * 64), LDS_BYTES, stream, a); }
    } else {
        for (int li = 0; li < NPHASE; ++li) { a.ph_lo = li; a.ph_hi = li + 1; a.li = 0;
            hipLaunchKernelGGL(mk_fwd, dim3(grid), dim3(NWAVES * 64), LDS_BYTES, stream, a); }
    }
}
```

```cpp
#include <hip/hip_runtime.h>
#include <cstdio>
#include <cstdint>

#ifndef MK_N_LAUNCHES
#define MK_N_LAUNCHES 1
#endif
#ifndef TIME_PHASE
#define TIME_PHASE -1
#endif
#ifndef TIME_SCALE
#define TIME_SCALE 1.0f
#endif
#ifndef PH_MASK
#define PH_MASK 0x3ff
#endif
#ifndef REP_ALL
#define REP_ALL 1
#endif
#ifndef REP_MASK
#define REP_MASK 0
#endif

#define LAS __attribute__((address_space(3)))
#define GAS __attribute__((address_space(1)))
typedef unsigned short h16;
typedef _Float16 half8 __attribute__((ext_vector_type(8)));
typedef _Float16 half2v __attribute__((ext_vector_type(2)));
typedef short s16x4 __attribute__((ext_vector_type(4)));
typedef float f32x4 __attribute__((ext_vector_type(4)));
typedef float f32x16 __attribute__((ext_vector_type(16)));
typedef unsigned u32x2 __attribute__((ext_vector_type(2)));
typedef unsigned u32x4 __attribute__((ext_vector_type(4)));
typedef GAS unsigned gu32;

constexpr int BATCH = 4, SEQ = 4096, DM = 1024, M = BATCH * SEQ;
constexpr int NIN = 2304;
constexpr int OFF_QA = 0, OFF_KA = 512, OFF_VA = 640, OFF_QB = 768, OFF_KB = 1280, OFF_VB = 1792;
constexpr int NE = 16, CAP = 512, FF = 2048, EROWS = BATCH * CAP;
constexpr float NORM_EPS = 1e-6f;
constexpr float LOG2E = 1.4426950408889634f, LN2 = 0.6931471805599453f;
constexpr float QSCALE = 0.18033688011112042f;
constexpr float S_H2 = 4.f, S_W = 32.f, S_HM = 2.f, S_YE = 16.f;

constexpr size_t MiB = 1u << 20;
constexpr size_t WS_CTL = 0, CTL_ZERO_BYTES = 64 * 1024;
constexpr size_t WS_ROPE = 1 * MiB;
constexpr size_t WS_AFF = 2 * MiB;
constexpr size_t WS_TOK = 3 * MiB;
constexpr size_t WS_GATE = 3 * MiB + 256 * 1024;
constexpr size_t WS_SLOT = 4 * MiB;
constexpr size_t WS_LSE = 5 * MiB;
constexpr size_t WS_WIN = 8 * MiB;
constexpr size_t WS_WOUT = 13 * MiB;
constexpr size_t WS_WGU = 16 * MiB;
constexpr size_t WS_WD = 144 * MiB;
constexpr size_t WS_H = 208 * MiB;
constexpr size_t WS_PROJ = 240 * MiB;
constexpr size_t WS_OA = 312 * MiB;
constexpr size_t WS_OB = 328 * MiB;
constexpr size_t WS_HMID = 208 * MiB;
constexpr size_t WS_MIXED = 376 * MiB;
constexpr size_t WS_H2 = 408 * MiB;
constexpr size_t WS_YE = 376 * MiB;
constexpr size_t WS_X1 = 440 * MiB;
constexpr size_t WS_END = 504 * MiB;
constexpr int CW_CONV = 64, CW_P1DONE = 128;
constexpr int CW_BAR = 1024;

constexpr int RING_BYTES = 131072;
constexpr int LDSCTL_OFF = 143360, MISC_OFF = LDSCTL_OFF + 320;
constexpr int LDS_BYTES = 147456;
constexpr int NWAVES = 8;

#define RLX_AGENT __ATOMIC_RELAXED, __HIP_MEMORY_SCOPE_AGENT
#define LDS_WAIT() asm volatile("s_waitcnt lgkmcnt(0)" ::: "memory")
#define VM_WAIT() asm volatile("s_waitcnt vmcnt(0)" ::: "memory")

__device__ __forceinline__ unsigned pk_h2(float lo, float hi) { half2v v = {(_Float16)lo, (_Float16)hi}; return __builtin_bit_cast(unsigned, v); }
__device__ __forceinline__ unsigned pk_h2_rtz(float lo, float hi) { return __builtin_bit_cast(unsigned, __builtin_amdgcn_cvt_pkrtz(lo, hi)); }
__device__ __forceinline__ unsigned pk_fp8x4(float a, float b, float c, float d) {
    int w = __builtin_amdgcn_cvt_pk_fp8_f32(a, b, 0, false); w = __builtin_amdgcn_cvt_pk_fp8_f32(c, d, w, true); return (unsigned)w; }
__device__ __forceinline__ float clamp8(float x) { return fminf(fmaxf(x, -448.f), 448.f); }
__device__ __forceinline__ float h2f(unsigned short b) { return (float)__builtin_bit_cast(_Float16, b); }
__device__ __forceinline__ float wave_sum(float v) {
#pragma unroll
    for (int o = 1; o < 64; o <<= 1) v += __shfl_xor(v, o);
    return v;
}


constexpr unsigned CV_PER = (DM / 64) * (FF / 32);
constexpr unsigned CV_TOTAL = (unsigned)NE * 3u * CV_PER;
struct ConvItem { const float* W; unsigned char* D; int N, K; };
__device__ __forceinline__ ConvItem conv8_decode(const float* wg, const float* wu, const float* wd, unsigned char* ws, unsigned it) {
    ConvItem c;
    if (it < (unsigned)NE * 2u * CV_PER) {
        const unsigned e = it / (2u * CV_PER); unsigned r = it - e * 2u * CV_PER; const unsigned which = r / CV_PER; r -= which * CV_PER;
        const int kb = (int)(r / (FF / 32)), n0 = 32 * (int)(r % (FF / 32));
        c.N = FF; c.K = DM; c.W = (which ? wu : wg) + (size_t)e * DM * FF + (size_t)(64 * kb) * FF + n0;
        c.D = ws + WS_WGU + ((size_t)e * 4096 + (size_t)((n0 >> 7) * 256 + (int)which * 128 + (n0 & 127))) * DM + 64 * kb;
    } else {
        const unsigned r0 = it - (unsigned)NE * 2u * CV_PER, e = r0 / CV_PER, r = r0 - e * CV_PER;
        const int kb = (int)(r / (DM / 32)), n0 = 32 * (int)(r % (DM / 32));
        c.N = DM; c.K = FF; c.W = wd + (size_t)e * FF * DM + (size_t)(64 * kb) * DM + n0;
        c.D = ws + WS_WD + ((size_t)e * DM + n0) * FF + 64 * kb;
    }
    return c;
}
__device__ __forceinline__ void conv8_issue(const ConvItem& c, float (&r)[32], int lane) {
#pragma unroll
    for (int i = 0; i < 32; ++i) r[i] = __builtin_nontemporal_load(c.W + (size_t)(2 * i + (lane >> 5)) * c.N + (lane & 31));
}
__device__ __forceinline__ void conv8_finish(const ConvItem& c, const float (&r)[32], LAS float* scr, int lane) {
#pragma unroll
    for (int i = 0; i < 32; ++i) scr[(2 * i + (lane >> 5)) * 33 + (lane & 31)] = r[i];
    LDS_WAIT(); asm volatile("" ::: "memory");
    const int n = lane >> 1, kh = (lane & 1) * 32; const LAS float* s = scr + kh * 33 + n;
    u32x4 o0, o1;
#pragma unroll
    for (int q = 0; q < 4; ++q) {
        o0[q] = pk_fp8x4(s[(4 * q) * 33] * S_W, s[(4 * q + 1) * 33] * S_W, s[(4 * q + 2) * 33] * S_W, s[(4 * q + 3) * 33] * S_W);
        o1[q] = pk_fp8x4(s[(16 + 4 * q) * 33] * S_W, s[(17 + 4 * q) * 33] * S_W, s[(18 + 4 * q) * 33] * S_W, s[(19 + 4 * q) * 33] * S_W); }
    unsigned char* d = c.D + (size_t)n * c.K + kh;
    *(GAS u32x4*)d = o0; *(GAS u32x4*)(d + 16) = o1;
    LDS_WAIT(); asm volatile("" ::: "memory");
}
__device__ __forceinline__ void conv8_one(const float* wg, const float* wu, const float* wd, unsigned char* ws, unsigned it, LAS float* scr, int lane) {
    const ConvItem c = conv8_decode(wg, wu, wd, ws, it); float r[32]; conv8_issue(c, r, lane); conv8_finish(c, r, scr, lane);
}
constexpr unsigned CV_BATCH = 64;
__device__ __forceinline__ void conv8_dynamic(const float* wg, const float* wu, const float* wd, unsigned char* ws, unsigned* ctr, unsigned* done_ctr, unsigned until_done,
                                              LAS float* scr, volatile LAS unsigned* sh, int tid, int wave, int lane) {
    for (;;) {
        if (tid == 0) { sh[0] = __hip_atomic_fetch_add(ctr, CV_BATCH, __ATOMIC_RELAXED, __HIP_MEMORY_SCOPE_AGENT);
                        sh[1] = until_done ? __hip_atomic_load(done_ctr, __ATOMIC_RELAXED, __HIP_MEMORY_SCOPE_AGENT) : 0u; }
        __syncthreads();
        const unsigned b0 = sh[0]; const bool stop = until_done && sh[1] >= until_done;
        __syncthreads();
        if (b0 >= CV_TOTAL) break;
#pragma unroll 1
        for (unsigned q = 0; q < CV_BATCH / 8; ++q) { const unsigned it = b0 + (unsigned)wave * (CV_BATCH / 8) + q; if (it < CV_TOTAL) conv8_one(wg, wu, wd, ws, it, scr, lane); }
        if (stop) break;
    }
}
struct NoSide { static constexpr bool ON = false; };

namespace pg8 {
constexpr int BM = 256, BK = 64, HALF = 128, HTB = HALF * BK * 2, STAGE_BYTES = 8 * HTB, NXCD = 8, WGM = 8;
__host__ __device__ __forceinline__ int lds_byte(int r, int c) { const int st = (r >> 4) * 2 + (c >> 5), rr = r & 15, cc = c & 31, ob = rr * 64 + cc * 2; return st * 1024 + (ob ^ (((ob >> 9) & 1) << 5)); }
__host__ __device__ __forceinline__ void stage_rc(int b, int& R, int& C) { const int st = b / 1024, sb = b % 1024, swz = sb ^ (((sb >> 9) & 1) << 5); R = (st >> 1) * 16 + swz / 64; C = (st & 1) * 32 + (swz % 64) / 2; }
__host__ __device__ __forceinline__ int perm32(int rho) { const int n = rho >> 4, i = rho & 15; return 8 * (i >> 2) + 4 * n + (i & 3); }

struct Unit { int pm, pn, g; };

struct DenseOrder {
    int nM, nN, nwg, G, c, reps;
    __device__ void init(int M_, int N_, int G_, int c_, int reps_ = 1) { nM = M_ / BM; nN = N_ / BM; nwg = nM * nN; G = G_; c = c_; reps = reps_; }
    __device__ bool next(int i, Unit& u) const {
        const int mine = (nwg - c + G - 1) / G; if (mine <= 0 || i >= mine * reps) return false; i %= mine;
        const long L = (long)i * G + c;
        int wgid = (int)L; { const int q = nwg / NXCD, r = nwg % NXCD, xcd = wgid % NXCD, off = wgid / NXCD; wgid = (xcd < r ? xcd * (q + 1) : r * (q + 1) + (xcd - r) * q) + off; }
        const int nig = WGM * nN, gid = wgid / nig, fm = gid * WGM, gsz = (nM - fm) < WGM ? (nM - fm) : WGM;
        u.pm = fm + ((wgid % nig) % gsz); u.pn = (wgid % nig) / gsz; u.g = 0; return true;
    }
};
struct GroupOrder {
    int nPM, nPN, total, G, c, reps;
    __device__ void init(int nPM_, int nPN_, int groups, int G_, int c_, int reps_ = 1) { nPM = nPM_; nPN = nPN_; total = nPM_ * nPN_ * groups; G = G_; c = c_; reps = reps_; }
    __device__ bool next(int i, Unit& u) const {
        const int mine = (total - c + G - 1) / G; if (mine <= 0 || i >= mine * reps) return false; i %= mine;
        const int L = i * G + c;
        const int per = nPM * nPN; u.g = L / per; const int rem = L % per; u.pn = rem / nPM; u.pm = rem % nPM; return true;
    }
};

struct DenseProb {
    static constexpr bool BKN = false, FP8 = false;
    const char* A; const char* Bt; int KB;
    __device__ __forceinline__ unsigned a_row(const Unit& u, int r) const { return (unsigned)(u.pm * BM + r); }
    __device__ __forceinline__ const char* b_base(const Unit& u, int half) const { return Bt + ((size_t)u.pn * BM + (size_t)half * HALF) * KB; }
    __device__ __forceinline__ size_t b_kstep() const { return (size_t)BK * 2; }
    __device__ __forceinline__ unsigned b_pitch() const { return (unsigned)KB; }
};
struct Moe1Prob {
    static constexpr bool BKN = false, FP8 = true;
    const char* A; const char* Bt; int KB; const int* tok;
    __device__ __forceinline__ unsigned a_row(const Unit& u, int r) const { return (unsigned)tok[u.g * EROWS + u.pm * BM + r]; }
    __device__ __forceinline__ const char* b_base(const Unit& u, int half) const { return Bt + ((size_t)u.g * 4096 + (size_t)u.pn * BM + (size_t)half * HALF) * KB; }
    __device__ __forceinline__ size_t b_kstep() const { return (size_t)BK * 2; }
    __device__ __forceinline__ unsigned b_pitch() const { return (unsigned)KB; }
};
struct Moe2Prob {
    static constexpr bool BKN = false, FP8 = true;
    const char* A; const char* Bt; int KB;
    __device__ __forceinline__ unsigned a_row(const Unit& u, int r) const { return (unsigned)(u.g * EROWS + u.pm * BM + r); }
    __device__ __forceinline__ const char* b_base(const Unit& u, int half) const { return Bt + ((size_t)u.g * DM + (size_t)u.pn * BM + (size_t)half * HALF) * KB; }
    __device__ __forceinline__ size_t b_kstep() const { return (size_t)BK * 2; }
    __device__ __forceinline__ unsigned b_pitch() const { return (unsigned)KB; }
};

struct EpiInProj {
    static constexpr bool PERM = true;
    h16* O; const float* rope;
    __device__ __forceinline__ void operator()(const f32x4 (&acc)[2][2][4][2], const Unit& u, int wr, int wc, int fr, int fq) const {
        const int row0 = u.pm * BM + wr * 64 + fr;
        const int ct0 = u.pn * BM;
        const bool rt0 = (ct0 < OFF_VA) || (ct0 >= OFF_QB && ct0 < OFF_VB), rt1 = (ct0 + HALF < OFF_VA) || (ct0 + HALF >= OFF_QB && ct0 + HALF < OFF_VB);
        const bool any_rope = (rt0 || rt1) && ((wc & 1) == 0);
        float c[8], s[8];
        if (any_rope) { const float* rp = rope + (size_t)(row0 & (SEQ - 1)) * 16;
            const f32x4 c0 = *(const f32x4*)(rp), c1 = *(const f32x4*)(rp + 4), s0 = *(const f32x4*)(rp + 8), s1 = *(const f32x4*)(rp + 12);
#pragma unroll
            for (int j = 0; j < 4; ++j) { c[j] = c0[j]; c[4 + j] = c1[j]; s[j] = s0[j]; s[4 + j] = s1[j]; } }
        else {
#pragma unroll
            for (int j = 0; j < 8; ++j) { c[j] = 1.f; s[j] = 0.f; } }
        const float cd16[8] = {-9.576594803e-01f, -9.992462593e-01f, 8.243765146e-01f, 9.932003012e-01f, 9.997440109e-01f, 9.999903729e-01f, 9.999996380e-01f, 9.999999864e-01f};
        const float sd16[8] = {-2.879033167e-01f, 3.881898152e-02f, 5.660418378e-01f, 1.164180468e-01f, 2.262548617e-02f, 4.387956730e-03f, 8.509272408e-04f, 1.650141653e-04f};
        const float cd80[8] = {-1.103872438e-01f, -9.812132344e-01f, -9.911539132e-01f, 8.345872775e-01f, 9.936068238e-01f, 9.997593311e-01f, 9.999909490e-01f, 9.999996596e-01f};
        const float sd80[8] = {-9.938886539e-01f, 1.929263812e-01f, 1.327174458e-01f, 5.508757358e-01f, 1.128958803e-01f, 2.193809395e-02f, 4.254623881e-03f, 8.250707366e-04f};
        const float sg = (fq == 0) ? -1.f : 1.f;
#pragma unroll
        for (int ai = 0; ai < 2; ++ai)
#pragma unroll
            for (int m = 0; m < 4; ++m) {
                const int row = row0 + ai * HALF + m * 16;
                if (any_rope && (ai | m) != 0) {
#pragma unroll
                    for (int j = 0; j < 8; ++j) { const float cdv = (m == 0) ? cd80[j] : cd16[j], sdv = (m == 0) ? sd80[j] : sd16[j];
                        const float cn = c[j] * cdv - s[j] * sdv, sn = s[j] * cdv + c[j] * sdv; c[j] = cn; s[j] = sn; }
                }
#pragma unroll
                for (int bj = 0; bj < 2; ++bj) {
                    const bool do_rope = (bj ? rt1 : rt0) && ((wc & 1) == 0);
                    const int col0 = ct0 + bj * HALF + wc * 32 + 8 * fq;
                    f32x4 v0 = acc[ai][bj][m][0], v1 = acc[ai][bj][m][1];
                    if (do_rope) {
                        f32x4 p0, p1;
#pragma unroll
                        for (int j = 0; j < 4; ++j) { p0[j] = __shfl_xor(v0[j], 16); p1[j] = __shfl_xor(v1[j], 16); }
                        if (fq < 2) {
#pragma unroll
                            for (int j = 0; j < 4; ++j) { v0[j] = v0[j] * c[j] + (p0[j] * s[j]) * sg; v1[j] = v1[j] * c[4 + j] + (p1[j] * s[4 + j]) * sg; } }
                    }
                    u32x4 w; w.x = pk_h2(v0[0], v0[1]); w.y = pk_h2(v0[2], v0[3]); w.z = pk_h2(v1[0], v1[1]); w.w = pk_h2(v1[2], v1[3]);
                    *(u32x4*)(O + (size_t)row * NIN + col0) = w;
                }
            }
    }
};
struct EpiResidual {
    static constexpr bool PERM = true;
    const float* base; h16* out;
    __device__ __forceinline__ void operator()(const f32x4 (&acc)[2][2][4][2], const Unit& u, int wr, int wc, int fr, int fq) const {
        const int row0 = u.pm * BM + wr * 64 + fr, col0 = u.pn * BM + wc * 32 + 8 * fq;
#pragma unroll
        for (int ai = 0; ai < 2; ++ai)
#pragma unroll
            for (int m = 0; m < 4; ++m) {
                const size_t off = (size_t)(row0 + ai * HALF + m * 16) * DM + col0;
#pragma unroll
                for (int bj = 0; bj < 2; ++bj) { const f32x4 b0 = __builtin_nontemporal_load((const f32x4*)(base + off + bj * HALF)), b1 = __builtin_nontemporal_load((const f32x4*)(base + off + bj * HALF + 4));
                    const f32x4 v0 = b0 + acc[ai][bj][m][0], v1 = b1 + acc[ai][bj][m][1];
                    u32x4 w; w.x = pk_h2(v0[0], v0[1]); w.y = pk_h2(v0[2], v0[3]); w.z = pk_h2(v1[0], v1[1]); w.w = pk_h2(v1[2], v1[3]);
                    *(u32x4*)(out + off + bj * HALF) = w; }
            }
    }
};
struct EpiSwiGLU {
    static constexpr bool PERM = true;
    unsigned char* O;
    __device__ __forceinline__ void operator()(const f32x4 (&acc)[2][2][4][2], const Unit& u, int wr, int wc, int fr, int fq) const {
        const int row0 = u.g * EROWS + u.pm * BM + wr * 64 + fr, col0 = u.pn * HALF + wc * 32 + 8 * fq;
        constexpr float IS = 1.0f / (S_H2 * S_W);
#pragma unroll
        for (int ai = 0; ai < 2; ++ai)
#pragma unroll
            for (int m = 0; m < 4; ++m) {
                float r[8];
#pragma unroll
                for (int n = 0; n < 2; ++n)
#pragma unroll
                    for (int j = 0; j < 4; ++j) { const float a = acc[ai][0][m][n][j] * IS, up = acc[ai][1][m][n][j] * (IS * S_HM);
                        r[n * 4 + j] = clamp8(a * __builtin_amdgcn_rcpf(1.0f + __builtin_amdgcn_exp2f(-a * LOG2E)) * up); }
                u32x2 w; w.x = pk_fp8x4(r[0], r[1], r[2], r[3]); w.y = pk_fp8x4(r[4], r[5], r[6], r[7]);
                *(u32x2*)(O + (size_t)(row0 + ai * HALF + m * 16) * FF + col0) = w;
            }
    }
};
struct EpiDown {
    static constexpr bool PERM = true;
    unsigned char* O; const float* gate;
    __device__ __forceinline__ void operator()(const f32x4 (&acc)[2][2][4][2], const Unit& u, int wr, int wc, int fr, int fq) const {
        const int row0 = u.g * EROWS + u.pm * BM + wr * 64 + fr, col0 = u.pn * BM + wc * 32 + 8 * fq;
#pragma unroll
        for (int ai = 0; ai < 2; ++ai)
#pragma unroll
            for (int m = 0; m < 4; ++m) {
                const int row = row0 + ai * HALF + m * 16; const float gt = gate[row] * (S_YE / (S_HM * S_W));
#pragma unroll
                for (int bj = 0; bj < 2; ++bj) { const f32x4 v0 = acc[ai][bj][m][0] * gt, v1 = acc[ai][bj][m][1] * gt;
                    u32x2 w; w.x = pk_fp8x4(clamp8(v0[0]), clamp8(v0[1]), clamp8(v0[2]), clamp8(v0[3])); w.y = pk_fp8x4(clamp8(v1[0]), clamp8(v1[1]), clamp8(v1[2]), clamp8(v1[3]));
                    *(u32x2*)(O + (size_t)row * DM + col0 + bj * HALF) = w; }
            }
    }
};

template <class Prob, class Epi, class Sched, bool ALIGN_EPI, class Side = NoSide>
__device__ __forceinline__ void gemm_phase(LAS unsigned char* lds, const Prob P, const Sched& S, const Epi& E, const Side SD = Side()) {
    const int tid = threadIdx.x, wid = __builtin_amdgcn_readfirstlane(tid >> 6), lane = tid & 63, wr = wid >> 2, wc = wid & 3, fr = lane & 15, fq = lane >> 4;
    const int KB = P.KB, nt = KB / 128;
    int RA[2]; unsigned CA2[2], voffB[2];
#pragma unroll
    for (int i = 0; i < 2; ++i) { int R, C; stage_rc(tid * 16 + i * 8192, R, C); const int Rb = Epi::PERM ? ((R & ~31) + perm32(R & 31)) : R;
        RA[i] = R; CA2[i] = (unsigned)C * 2u;
        if constexpr (Prob::BKN) {
            static_assert(Epi::PERM, "the [K][N] B path is written for PERM epilogues");
            const int r = 4 * wid + 32 * i + (lane >> 4), g = (r & 3) | (((r >> 3) & 1) << 2), c = (lane & 15) ^ (g << 1);
            voffB[i] = (unsigned)r * P.b_pitch() + (unsigned)c * 16u;
        } else voffB[i] = (unsigned)(Rb * KB) + (unsigned)C * 2u; }
    const unsigned kstep = (unsigned)(BK * 2);
    const size_t kstepB = P.b_kstep();
    int btr[2];
    { const int q = fr >> 2, p = fr & 3, X = ((q | ((fq & 1) << 2)) << 2) | (q & 1);
#pragma unroll
      for (int n = 0; n < 2; ++n) btr[n] = (8 * fq + q) * 256 + (((8 * wc + 2 * p + n) ^ X) * 8); }
    const unsigned lds_u32 = (unsigned)(__UINTPTR_TYPE__)lds;
    unsigned bta[2]; bta[0] = lds_u32 + (unsigned)btr[0]; bta[1] = lds_u32 + (unsigned)btr[1];
    const unsigned rowb = (unsigned)KB;
    const unsigned ldsw = (unsigned)wid * 1024u;
    const int aoff = lds_byte(wr * 64 + fr, fq * 8), boff = lds_byte(wc * 32 + fr, fq * 8);
#define PG8_SA(b, h) (((b) * 2 + (h)) * HTB)
#define PG8_SB(b, h) ((4 + (b) * 2 + (h)) * HTB)
#define PG8_STAGE_B(bufoff, gbase) do { _Pragma("unroll") for (int _i = 0; _i < 2; ++_i) \
        __builtin_amdgcn_global_load_lds((const unsigned*)((const char*)(gbase) + voffB[_i]), (LAS unsigned*)(lds + (bufoff) + ldsw + _i * 8192), 16, 0, 0); } while (0)
#define PG8_STAGE_A(bufoff, kb, offs) do { _Pragma("unroll") for (int _i = 0; _i < 2; ++_i) \
        __builtin_amdgcn_global_load_lds((const unsigned*)(P.A + (size_t)(kb) + (offs)[_i]), (LAS unsigned*)(lds + (bufoff) + ldsw + _i * 8192), 16, 0, 0); } while (0)
#define PG8_LDA(dst, b, h) do { if constexpr (Prob::FP8) { _Pragma("unroll") for (int m = 0; m < 4; ++m) { dst##8[m].lo = *(const LAS v4i_*)(lds + PG8_SA(b, h) + aoff + m * 2048); dst##8[m].hi = *(const LAS v4i_*)(lds + PG8_SA(b, h) + aoff + m * 2048 + 1024); } } \
        else { _Pragma("unroll") for (int m = 0; m < 4; ++m) _Pragma("unroll") for (int k = 0; k < 2; ++k) dst[m][k] = *(const LAS half8*)(lds + PG8_SA(b, h) + aoff + m * 2048 + k * 1024); } } while (0)
#define PG8_LDB(dst, b, h) do { if constexpr (Prob::BKN) { _Pragma("unroll") for (int n = 0; n < 2; ++n) { const unsigned ad_ = bta[n] + (unsigned)PG8_SB(b, h); _Pragma("unroll") for (int k = 0; k < 2; ++k) { \
            asm volatile("ds_read_b64_tr_b16 %0, %1 offset:%c2" : "=&v"(dst##lo[n][k]) : "v"(ad_), "i"(k * 8192) : "memory"); \
            asm volatile("ds_read_b64_tr_b16 %0, %1 offset:%c2" : "=&v"(dst##hi[n][k]) : "v"(ad_), "i"(k * 8192 + 1024) : "memory"); } } } \
        else if constexpr (Prob::FP8) { _Pragma("unroll") for (int n = 0; n < 2; ++n) { dst##8[n].lo = *(const LAS v4i_*)(lds + PG8_SB(b, h) + boff + n * 2048); dst##8[n].hi = *(const LAS v4i_*)(lds + PG8_SB(b, h) + boff + n * 2048 + 1024); } } \
        else { _Pragma("unroll") for (int n = 0; n < 2; ++n) _Pragma("unroll") for (int k = 0; k < 2; ++k) dst[n][k] = *(const LAS half8*)(lds + PG8_SB(b, h) + boff + n * 2048 + k * 1024); } } while (0)
#define PG8_BFIX(dst) do { if constexpr (Prob::BKN) { typedef short s16x8_ __attribute__((ext_vector_type(8))); _Pragma("unroll") for (int n = 0; n < 2; ++n) _Pragma("unroll") for (int k = 0; k < 2; ++k) { \
            const s16x8_ v_ = __builtin_shufflevector(dst##lo[n][k], dst##hi[n][k], 0, 1, 2, 3, 4, 5, 6, 7); dst[n][k] = __builtin_bit_cast(half8, v_); } } } while (0)
#define PG8_MMA(ai, bj, At, Bt) do { __builtin_amdgcn_s_setprio(1); _Pragma("unroll") for (int m = 0; m < 4; ++m) _Pragma("unroll") for (int n = 0; n < 2; ++n) { \
        if constexpr (Prob::FP8) asm volatile("v_mfma_f32_16x16x128_f8f6f4 %0, %1, %2, %0" : "+v"(acc[ai][bj][m][n]) : "v"(Bt##8[n]), "v"(At##8[m])); \
        else { _Pragma("unroll") for (int k = 0; k < 2; ++k) acc[ai][bj][m][n] = __builtin_amdgcn_mfma_f32_16x16x32_f16(Bt[n][k], At[m][k], acc[ai][bj][m][n], 0, 0, 0); } } \
        __builtin_amdgcn_s_setprio(0); } while (0)
#define PG8_WAIT_V(n) asm volatile("s_waitcnt vmcnt(" #n ")" ::: "memory")
#define PG8_WAIT_L(n) asm volatile("s_waitcnt lgkmcnt(" #n ")" ::: "memory")
#define PG8_BAR __builtin_amdgcn_s_barrier()
#define PG8_SCHED __builtin_amdgcn_sched_barrier(0)
#define PG8_SIDE_ISSUE(slot) do { if constexpr (Side::ON) { sfly = SD.L->pending() && (((slot) % SD.every) == 0); \
        if (sfly) { scc = SD.L->chunk(SD.L->done); const float* sp_ = SD.L->src_of(SD.L->wa, SD.L->wb, scc); \
            asm volatile("global_load_dwordx4 %0, %2, off\n\tglobal_load_dwordx4 %1, %2, off offset:16" : "=&v"(sr0), "=&v"(sr1) : "v"(sp_) : "memory"); } } } while (0)
#define PG8_SIDE_FINISH() do { if constexpr (Side::ON) { if (sfly) { asm volatile("" : "+v"(sr0), "+v"(sr1)); SD.L->store(SD.L->da, scc, sr0, sr1); SD.L->done += 1; } PG8_SCHED; } } while (0)
#define PG8_WAIT_VS(extra) do { if constexpr (Side::ON) { if (sfly) { if ((extra) == 2) PG8_WAIT_V(10); else PG8_WAIT_V(9); } else PG8_WAIT_V(8); } else PG8_WAIT_V(8); } while (0)
#define PG8_AOFF(dst, un) do { _Pragma("unroll") for (int _h = 0; _h < 2; ++_h) _Pragma("unroll") for (int _i = 0; _i < 2; ++_i) dst[_h][_i] = P.a_row(un, _h * HALF + RA[_i]) * rowb + CA2[_i]; } while (0)
    Unit cur, nxt; int ui = 0;
    if (!S.next(0, cur)) return;
    bool sfly = false; f32x4 sr0, sr1; unsigned scc = 0;
    f32x4 acc[2][2][4][2];
#pragma unroll
    for (int a = 0; a < 2; ++a)
#pragma unroll
        for (int b = 0; b < 2; ++b)
#pragma unroll
            for (int m = 0; m < 4; ++m)
#pragma unroll
                for (int n = 0; n < 2; ++n) acc[a][b][m][n] = (f32x4){0.f, 0.f, 0.f, 0.f};
    typedef int v4i_ __attribute__((ext_vector_type(4))); typedef int v8i_ __attribute__((ext_vector_type(8)));
    half8 At[4][2], B0[2][2], B1[2][2];
    s16x4 B0lo[2][2], B0hi[2][2], B1lo[2][2], B1hi[2][2];
    v8i_ At8[4], B08[2], B18[2];
    unsigned cuo[2][2], nxo[2][2];
    PG8_AOFF(cuo, cur);
    const char* cB0 = P.b_base(cur, 0); const char* cB1 = P.b_base(cur, 1);
    PG8_STAGE_B(PG8_SB(0, 0), cB0); PG8_STAGE_B(PG8_SB(0, 1), cB1); PG8_STAGE_A(PG8_SA(0, 0), 0, cuo[0]); PG8_STAGE_A(PG8_SA(0, 1), 0, cuo[1]);
    if (wr == 1) PG8_BAR;
    PG8_WAIT_V(2); PG8_BAR;
    PG8_STAGE_B(PG8_SB(1, 0), cB0 + kstepB); PG8_STAGE_A(PG8_SA(1, 0), kstep, cuo[0]); PG8_STAGE_B(PG8_SB(1, 1), cB1 + kstepB);
    PG8_WAIT_V(6); PG8_BAR;
    for (;;) {
        const bool has_next = S.next(ui + 1, nxt);
        if (!has_next) nxt = cur;
        PG8_AOFF(nxo, nxt);
        const char* nB0 = P.b_base(nxt, 0); const char* nB1 = P.b_base(nxt, 1);
        for (int t = 0; t < nt; t += 2) {
            const bool last = (t == nt - 2);
            const unsigned k1 = (unsigned)(t + 1) * kstep;
            const unsigned k2 = last ? 0u : (unsigned)(t + 2) * kstep, k3 = k2 + kstep;
            const char* b20 = last ? nB0 : cB0 + (size_t)(t + 2) * kstepB; const char* b21 = last ? nB1 : cB1 + (size_t)(t + 2) * kstepB;
            const char* b30 = b20 + kstepB; const char* b31 = b21 + kstepB;
            unsigned o20[2], o21[2];
#pragma unroll
            for (int i = 0; i < 2; ++i) { o20[i] = last ? nxo[0][i] : cuo[0][i]; o21[i] = last ? nxo[1][i] : cuo[1][i]; }
            PG8_LDB(B0, 0, 0); PG8_LDB(B1, 0, 1); PG8_SCHED; PG8_LDA(At, 0, 0); PG8_STAGE_A(PG8_SA(1, 1), k1, cuo[1]); PG8_SIDE_ISSUE((ui * nt + t) >> 1);
            PG8_WAIT_VS(2);
            PG8_WAIT_L(0); PG8_SCHED; PG8_BFIX(B0); PG8_BFIX(B1); PG8_BAR; PG8_MMA(0, 0, At, B0); PG8_MMA(0, 1, At, B1); PG8_BAR; PG8_SCHED;
            PG8_LDA(At, 0, 1); PG8_STAGE_B(PG8_SB(0, 0), b20); PG8_STAGE_B(PG8_SB(0, 1), b21); PG8_STAGE_A(PG8_SA(0, 0), k2, o20);
            PG8_WAIT_VS(2); PG8_WAIT_L(0); PG8_BAR; PG8_MMA(1, 0, At, B0); PG8_MMA(1, 1, At, B1); PG8_BAR; PG8_SCHED;
            PG8_LDB(B0, 1, 0); PG8_LDB(B1, 1, 1); PG8_SCHED; PG8_LDA(At, 1, 0); PG8_STAGE_A(PG8_SA(0, 1), k2, o21);
            PG8_WAIT_V(8);
            PG8_WAIT_L(0); PG8_SCHED; PG8_BFIX(B0); PG8_BFIX(B1); PG8_BAR; PG8_MMA(0, 0, At, B0); PG8_MMA(0, 1, At, B1); PG8_BAR; PG8_SCHED;
            PG8_SIDE_FINISH();
            PG8_LDA(At, 1, 1); PG8_STAGE_B(PG8_SB(1, 0), b30); PG8_STAGE_B(PG8_SB(1, 1), b31); PG8_STAGE_A(PG8_SA(1, 0), k3, o20);
            PG8_WAIT_VS(1); PG8_WAIT_L(0); PG8_BAR; PG8_MMA(1, 0, At, B0); PG8_MMA(1, 1, At, B1); PG8_BAR; PG8_SCHED;
            if constexpr (Side::ON) sfly = false;
        }
        if constexpr (ALIGN_EPI) { if (wr == 0) PG8_BAR; }
        if constexpr (Prob::FP8) asm volatile("s_nop 15\n\ts_nop 15" ::: "memory");
        E(acc, cur, wr, wc, fr, fq);
        if (!has_next) break;
#pragma unroll
        for (int a = 0; a < 2; ++a)
#pragma unroll
            for (int b = 0; b < 2; ++b)
#pragma unroll
                for (int m = 0; m < 4; ++m)
#pragma unroll
                    for (int n = 0; n < 2; ++n) acc[a][b][m][n] = (f32x4){0.f, 0.f, 0.f, 0.f};
        cur = nxt; cB0 = nB0; cB1 = nB1; ++ui;
#pragma unroll
        for (int h = 0; h < 2; ++h)
#pragma unroll
            for (int i = 0; i < 2; ++i) cuo[h][i] = nxo[h][i];
        if constexpr (ALIGN_EPI) { if (wr == 1) PG8_BAR; }
    }
    PG8_WAIT_V(0);
    if constexpr (!ALIGN_EPI) { if (wr == 0) PG8_BAR; }
    PG8_BAR;
#undef PG8_SA
#undef PG8_SB
#undef PG8_STAGE_A
#undef PG8_STAGE_B
#undef PG8_LDA
#undef PG8_LDB
#undef PG8_BFIX
#undef PG8_MMA
#undef PG8_WAIT_V
#undef PG8_WAIT_L
#undef PG8_BAR
#undef PG8_SCHED
#undef PG8_AOFF
#undef PG8_SIDE_ISSUE
#undef PG8_SIDE_FINISH
#undef PG8_WAIT_VS
}
}

#define XB_TMO      128
#define XB_XCNT(j)  (256  + 64 * (j))
#define XB_XSUB(j)  (1280 + 64 * (j))
#define XB_XGEN(j)  (2304 + 64 * (j))
#define XB_TOP      3328
#define XB_TOPGEN   3392
#define XCD_BAR_WORDS 3456
#define XB_SPIN_CAP (1u << 18)
__device__ __forceinline__ unsigned xb_ld(unsigned* p)              { return __hip_atomic_load(p, __ATOMIC_RELAXED, __HIP_MEMORY_SCOPE_AGENT); }
__device__ __forceinline__ unsigned xb_add(unsigned* p, unsigned v) { return __hip_atomic_fetch_add(p, v, __ATOMIC_RELAXED, __HIP_MEMORY_SCOPE_AGENT); }
__device__ __forceinline__ unsigned xb_xcc_id() { return (unsigned)__builtin_amdgcn_s_getreg((3 << 11) | 20) & 0xFu; }
#define XB_SPIN(cond, bar) do { unsigned _sp = 0; while (cond) { __builtin_amdgcn_s_sleep(1); \
    if ((++_sp & 255u) == 0u) { if (xb_ld(&(bar)[XB_TMO])) break; if (_sp > XB_SPIN_CAP) { atomicAdd(&(bar)[XB_TMO], 1u); break; } } } } while (0)
struct XcdBarrier { unsigned* bar; unsigned x; volatile LAS unsigned* st; };
__device__ __forceinline__ XcdBarrier xcd_barrier_post(unsigned* bar, volatile LAS unsigned* st) {
    XcdBarrier b; b.bar = bar; b.x = xb_xcc_id(); b.st = st;
    if (threadIdx.x == 0) (void)xb_add(&bar[XB_XCNT(b.x)], 1u);
    return b;
}
__device__ __forceinline__ void xcd_barrier_complete(unsigned* bar, unsigned x, unsigned& nloc, unsigned& nx) {
    const unsigned G = gridDim.x * gridDim.y * gridDim.z;
    unsigned sum, cnt, mine, sp = 0u;
    for (;;) {
        sum = 0u; cnt = 0u; mine = 0u;
#pragma unroll
        for (unsigned j = 0; j < 16; ++j) { const unsigned c = xb_ld(&bar[XB_XCNT(j)]); sum += c; cnt += (c > 0u) ? 1u : 0u; mine = (j == x) ? c : mine; }
        if (sum == G) break;
        __builtin_amdgcn_s_sleep(1);
        if ((++sp & 255u) == 0u) { if (xb_ld(&bar[XB_TMO])) break; if (sp > XB_SPIN_CAP) { atomicAdd(&bar[XB_TMO], 1u); break; } }
    }
    nloc = mine > 0u ? mine : 1u; nx = cnt > 0u ? cnt : 1u;
}
__device__ __forceinline__ void xcd_barrier(const XcdBarrier& b) {
    asm volatile("s_waitcnt vmcnt(0)" ::: "memory");
    __syncthreads();
    if (threadIdx.x == 0) {
        unsigned* bar = b.bar;
        __builtin_amdgcn_s_waitcnt(0);
        unsigned nloc = b.st[0], nx = b.st[1];
        if (nloc == 0u) { xcd_barrier_complete(bar, b.x, nloc, nx); b.st[0] = nloc; b.st[1] = nx; }
        const unsigned old = xb_add(&bar[XB_XSUB(b.x)], 1u);
        const unsigned gen = old / nloc;
        if (old + 1u == (gen + 1u) * nloc) {
            __builtin_amdgcn_fence(__ATOMIC_RELEASE, "agent");
            asm volatile("s_waitcnt vmcnt(0)" ::: "memory");
            const unsigned og = xb_add(&bar[XB_TOP], 1u);
            const unsigned tg = og / nx;
            if (og + 1u == (tg + 1u) * nx) xb_add(&bar[XB_TOPGEN], 1u);
            else XB_SPIN(xb_ld(&bar[XB_TOPGEN]) == tg, bar);
            __builtin_amdgcn_fence(__ATOMIC_ACQUIRE, "agent");
            xb_add(&bar[XB_XGEN(b.x)], 1u);
            asm volatile("s_waitcnt vmcnt(0)" ::: "memory");
        } else {
            XB_SPIN(xb_ld(&bar[XB_XGEN(b.x)]) == gen, bar);
            __builtin_amdgcn_fence(__ATOMIC_ACQUIRE, "agent");
            asm volatile("s_waitcnt vmcnt(0)" ::: "memory");
        }
    }
    __syncthreads();
}

struct Frame {
    LAS unsigned char* lds;
    int tid, lane, wave, vcu, G;
    const float *x, *g_mix, *w_in, *a_sink, *g_out_a, *g_out_b, *w_out, *g_ffn, *w_router, *w_gate, *w_up, *w_down, *g_final;
    float* out; unsigned char* ws;
    unsigned long long tacc;
};

__device__ __forceinline__ void p0_transpose_item(const float* W, int K, int N, h16* WT, int k0, int n0, int drow0, float sc, LAS float* scr, int lane) {
#pragma unroll 8
    for (int i = 0; i < 32; ++i) { const int kk = 2 * i + (lane >> 5); scr[kk * 33 + (lane & 31)] = W[(size_t)(k0 + kk) * N + n0 + (lane & 31)]; }
    LDS_WAIT(); asm volatile("" ::: "memory");
    const int c = lane & 7;
#pragma unroll
    for (int j = 0; j < 4; ++j) { const int n = (lane >> 3) + 8 * j; const LAS float* s = scr + (8 * c) * 33 + n;
        u32x4 o; o.x = pk_h2(s[0 * 33] * sc, s[1 * 33] * sc); o.y = pk_h2(s[2 * 33] * sc, s[3 * 33] * sc); o.z = pk_h2(s[4 * 33] * sc, s[5 * 33] * sc); o.w = pk_h2(s[6 * 33] * sc, s[7 * 33] * sc);
        *(GAS u32x4*)(WT + (size_t)(drow0 + n) * K + k0 + 8 * c) = o; }
    LDS_WAIT(); asm volatile("" ::: "memory");
}
__device__ __forceinline__ void sincos_d(double a, float& s, float& c) {
    const double q = __builtin_rint(a * 0.63661977236758134308);
    double r = __builtin_fma(-q, 1.570796325802803, a); r = __builtin_fma(-q, 9.920935796805404e-10, r);
    const double r2 = r * r;
    double sp = -7.6471637318198164759e-13;
    sp = sp * r2 + 1.6059043836821614599e-10; sp = sp * r2 - 2.5052108385441718775e-08; sp = sp * r2 + 2.7557319223985890653e-06;
    sp = sp * r2 - 1.9841269841269841270e-04; sp = sp * r2 + 8.3333333333333333333e-03; sp = sp * r2 - 1.6666666666666666667e-01;
    const double sn = r + r * r2 * sp;
    double cp = 4.7794773323873852974e-14;
    cp = cp * r2 - 1.1470745597729724714e-11; cp = cp * r2 + 2.0876756987868098979e-09; cp = cp * r2 - 2.7557319223985890653e-07;
    cp = cp * r2 + 2.4801587301587301587e-05; cp = cp * r2 - 1.3888888888888888889e-03; cp = cp * r2 + 4.1666666666666666667e-02; cp = cp * r2 - 0.5;
    const double cs = 1.0 + r2 * cp;
    const int qi = (int)q & 3;
    const double ss = (qi & 1) ? cs : sn, cc = (qi & 1) ? sn : cs;
    s = (float)((qi & 2) ? -ss : ss); c = (float)(((qi + 1) & 2) ? -cc : cc);
}

__device__ __forceinline__ void p0_prologue(Frame& F) {
    LAS float* scr = (LAS float*)(F.lds + F.wave * 16384);
    const int gw = F.vcu * NWAVES + F.wave, NGW = F.G * NWAVES;
    {
        const double invf[8] = {1.0, 0.19392274474868576, 0.03760603093086393, 0.007292664737217109, 0.001414213562373095, 0.0002742481756762073, 5.318295896944988e-05, 1.031338537721246e-05};
        float* rope = (float*)(F.ws + WS_ROPE);
        for (int idx = F.vcu * 512 + F.tid; idx < SEQ * 8; idx += F.G * 512) {
            const int pos = idx >> 3, i = idx & 7;
            double f = invf[0];
#pragma unroll
            for (int j = 1; j < 8; ++j) f = (i == j) ? invf[j] : f;
            float s, c; sincos_d((double)pos * f, s, c);
            rope[pos * 16 + i] = c; rope[pos * 16 + 8 + i] = s;
        }
    }
    {
        h16* H = (h16*)(F.ws + WS_H);
        for (int m = gw; m < M; m += NGW) {
            const GAS f32x4* xr = (const GAS f32x4*)(F.x + (size_t)m * DM) + F.lane;
            f32x4 v[4]; float s = 0.f;
#pragma unroll
            for (int j = 0; j < 4; ++j) { v[j] = __builtin_nontemporal_load(xr + 64 * j); s += (v[j].x * v[j].x + v[j].y * v[j].y) + (v[j].z * v[j].z + v[j].w * v[j].w); }
            const float rs = 1.0f / sqrtf(wave_sum(s) * (1.0f / DM) + NORM_EPS);
            GAS u32x2* o8 = (GAS u32x2*)(H + (size_t)m * DM) + F.lane;
#pragma unroll
            for (int j = 0; j < 4; ++j) { const f32x4 g = ((const GAS f32x4*)F.g_mix)[F.lane + 64 * j]; const f32x4 y = v[j] * rs * g;
                u32x2 w; w.x = pk_h2(y.x, y.y); w.y = pk_h2(y.z, y.w); o8[64 * j] = w; }
        }
    }
    {
        constexpr int I_IN = (DM / 64) * (NIN / 32), I_OUT = (DM / 64) * (DM / 32);
        constexpr int NITEMS = I_IN + I_OUT;
        for (int it = gw; it < NITEMS; it += NGW) {
            int r = it;
            if (r < I_IN) { const int nblk = NIN / 32, kb = r / nblk, nb = r % nblk, n0 = 32 * nb;
                const float sc = (n0 < OFF_KA || (n0 >= OFF_QB && n0 < OFF_KB)) ? QSCALE : 1.0f;
                p0_transpose_item(F.w_in, DM, NIN, (h16*)(F.ws + WS_WIN), 64 * kb, n0, n0, sc, scr, F.lane); continue; }
            r -= I_IN;
            { const int nblk = DM / 32, kb = r / nblk, nb = r % nblk, n0 = 32 * nb;
              p0_transpose_item(F.w_out, DM, DM, (h16*)(F.ws + WS_WOUT), 64 * kb, n0, n0, 1.0f, scr, F.lane); }
        }
    }
}

#define TSEC_BEGIN(code) unsigned long long tsec_##code = 0; if (TIME_PHASE == (code)) tsec_##code = __builtin_amdgcn_s_memrealtime()
#define TSEC_END(code) do { if (TIME_PHASE == (code)) F.tacc += __builtin_amdgcn_s_memrealtime() - tsec_##code; } while (0)
namespace att {
__device__ __forceinline__ int crow(int r, int hi) { return (r & 3) + 8 * (r >> 2) + 4 * hi; }
constexpr float THR = 8.0f;
constexpr int ATT_SIDE = 0;
constexpr int TILE_BYTES = 16384;
constexpr int WSF_OFF = 98304, STG_OFF = 100352;

__device__ __forceinline__ float max3f(float a, float b, float c) { float r; asm("v_max3_f32 %0, %1, %2, %3" : "=v"(r) : "v"(a), "v"(b), "v"(c)); return r; }
__device__ __forceinline__ float max16(const f32x16& p) {
    float a = max3f(p[0], p[1], p[2]), b = max3f(p[3], p[4], p[5]); a = max3f(a, p[6], p[7]); b = max3f(b, p[8], p[9]); a = max3f(a, p[10], p[11]); b = max3f(b, p[12], p[13]);
    return max3f(a, b, max3f(p[14], p[15], p[15])); }
__device__ __forceinline__ void tile_step(f32x16& o0, f32x16& o1, float& m, float& l, f32x16& negm, bool first, const half8 (&qr)[4],
                                          LAS const unsigned char* kt, LAS const unsigned char* vt, LAS float* wsf, int lane, int r32, int hi,
                                          int mode0, int mode1, int rel0, int lo, unsigned span) {
    f32x16 p0 = negm, p1 = negm;
    LAS const unsigned char* kb = kt + hi * 1024 + r32 * 16;
    const float NINF = -__builtin_inff();
    float rm = NINF;
    if (mode0) {
#pragma unroll
        for (int d0 = 0; d0 < 4; ++d0) p0 = __builtin_amdgcn_mfma_f32_32x32x16_f16(*(LAS const half8*)(kb + d0 * 2048), qr[d0], p0, 0, 0, 0);
        asm volatile("s_nop 15\n\ts_nop 7" : "+v"(p0));
        if (mode0 == 2) {
#pragma unroll
            for (int r = 0; r < 16; ++r) { const int rel = rel0 + (r & 3) + 8 * (r >> 2); if ((unsigned)(rel - lo) > span) p0[r] = NINF; }
        }
        rm = max16(p0);
    }
    if (mode1) {
#pragma unroll
        for (int d0 = 0; d0 < 4; ++d0) p1 = __builtin_amdgcn_mfma_f32_32x32x16_f16(*(LAS const half8*)(kb + d0 * 2048 + 512), qr[d0], p1, 0, 0, 0);
        asm volatile("s_nop 15\n\ts_nop 7" : "+v"(p1));
        if (mode1 == 2) {
#pragma unroll
            for (int r = 0; r < 16; ++r) { const int rel = rel0 + 32 + (r & 3) + 8 * (r >> 2); if ((unsigned)(rel - lo) > span) p1[r] = NINF; }
        }
        rm = fmaxf(rm, max16(p1));
    }
    { auto rr = __builtin_amdgcn_permlane32_swap(__float_as_uint(rm), __float_as_uint(rm), false, false); rm = fmaxf(__uint_as_float(rr[0]), __uint_as_float(rr[1])); }
    if (first || __any(rm > THR)) {
        const float dl = first ? fmaxf(rm, -100.f) : fmaxf(rm, 0.f); m += dl;
#pragma unroll
        for (int r = 0; r < 16; ++r) { p0[r] -= dl; p1[r] -= dl; negm[r] = -m; }
        if (!first) {
            const float f = __builtin_amdgcn_exp2f(-dl); l *= f;
            if (hi == 0) wsf[r32] = f;
            LDS_WAIT();
#pragma unroll
            for (int r = 0; r < 16; ++r) { const float fr_ = wsf[crow(r, hi)]; o0[r] *= fr_; o1[r] *= fr_; }
        }
    }
    LAS const unsigned char* vb = vt + (4 * hi + ((lane & 15) >> 2)) * 64 + ((lane >> 4) & 1) * 32 + (lane & 3) * 8;
    typedef short s16x8 __attribute__((ext_vector_type(8)));
    float s = 0.f;
#define ATT_HALF(P, KS0) do { \
        _Pragma("unroll") for (int r = 0; r < 16; ++r) { P[r] = __builtin_amdgcn_exp2f(P[r]); s += P[r]; } \
        u32x4 pwa, pwb; \
        _Pragma("unroll") for (int j = 0; j < 4; ++j) { pwa[j] = pk_h2_rtz(P[2 * j], P[2 * j + 1]); pwb[j] = pk_h2_rtz(P[8 + 2 * j], P[9 + 2 * j]); } \
        _Pragma("unroll") for (int kk = 0; kk < 2; ++kk) { const half8 pa = __builtin_bit_cast(half8, kk ? pwb : pwa); \
            _Pragma("unroll") for (int d0 = 0; d0 < 2; ++d0) { \
                const s16x4 vlo = __builtin_amdgcn_ds_read_tr16_b64_v4i16((LAS s16x4*)(vb + d0 * 4096 + ((KS0) + kk) * 1024)); \
                const s16x4 vhi = __builtin_amdgcn_ds_read_tr16_b64_v4i16((LAS s16x4*)(vb + d0 * 4096 + ((KS0) + kk) * 1024 + 512)); \
                const s16x8 vv = {vlo[0], vlo[1], vlo[2], vlo[3], vhi[0], vhi[1], vhi[2], vhi[3]}; \
                const half8 vf = __builtin_bit_cast(half8, vv); \
                if (d0 == 0) o0 = __builtin_amdgcn_mfma_f32_32x32x16_f16(pa, vf, o0, 0, 0, 0); \
                else         o1 = __builtin_amdgcn_mfma_f32_32x32x16_f16(pa, vf, o1, 0, 0, 0); } } } while (0)
    if (mode0) ATT_HALF(p0, 0);
    if (mode1) ATT_HALF(p1, 2);
#undef ATT_HALF
    l += s;
}

__device__ __forceinline__ void load_tile_regs(u32x4& kreg, u32x4& vreg, const h16* proj, int tokb, int dil, int LF, int tt0, int kcol, int vcol, int wid, int lane) {
    int tk = tt0 + lane; tk = tk < 0 ? 0 : (tk >= LF ? LF - 1 : tk);
    kreg = *(const u32x4*)(proj + (size_t)(tokb + tk * dil) * NIN + kcol + wid * 8);
    int tv = tt0 + (wid & 3) * 16 + (lane >> 2); tv = tv < 0 ? 0 : (tv >= LF ? LF - 1 : tv);
    vreg = *(const u32x4*)(proj + (size_t)(tokb + tv * dil) * NIN + vcol + (wid >> 2) * 32 + (lane & 3) * 8);
}

__device__ __forceinline__ void store_out(const f32x16& o0, const f32x16& o1, float l_tot, LAS float* wsf, LAS h16* stg, h16* dst, size_t pitch, int tok0, int dil, int lane, int r32, int hi) {
    if (hi == 0) wsf[32 + r32] = l_tot;
    LDS_WAIT();
#pragma unroll
    for (int r = 0; r < 16; ++r) { const int orow = crow(r, hi); const float rl = __builtin_amdgcn_rcpf(wsf[32 + orow]);
        stg[orow * 64 + r32] = __builtin_bit_cast(h16, (_Float16)(o0[r] * rl)); stg[orow * 64 + 32 + r32] = __builtin_bit_cast(h16, (_Float16)(o1[r] * rl)); }
    LDS_WAIT();
#pragma unroll
    for (int i = 0; i < 4; ++i) { const int row = i * 8 + (lane >> 3), ch = lane & 7; const u32x4 v = *(LAS const u32x4*)(stg + row * 64 + ch * 8);
        *(u32x4*)(dst + (size_t)(tok0 + row * dil) * pitch + ch * 8) = v; }
    LDS_WAIT();
}

struct UnitP { int isA, ntile, tt_first, dil, LF, tokb, kcol, vcol, hw, q0, g, h, p; };
__device__ __forceinline__ UnitP decode_unit(int u) {
    UnitP P;
    if (u < 512) { const int qb = u & 63, g = (u >> 6) & 1, b = u >> 7;
        P.isA = 1; P.ntile = 5; P.q0 = qb * 64; P.tt_first = P.q0 - 128; P.dil = 1; P.LF = SEQ; P.tokb = b * SEQ; P.kcol = OFF_KA + g * 64; P.vcol = OFF_VA + g * 64; P.hw = 128; P.g = g; P.h = 0; P.p = 0; }
    else { const int v = u - 512, u16 = v & 15, p = (v >> 4) % 3, bh = v / 48, h = bh & 7, b = bh >> 3, sh = 2 * p, dil = 1 << sh, res = u16 & (dil - 1), qb = u16 >> sh;
        P.isA = 0; P.ntile = 6; P.q0 = 256 * qb; P.tt_first = P.q0 - 64; P.dil = dil; P.LF = SEQ >> sh; P.tokb = b * SEQ + res; P.kcol = OFF_KB + h * 64; P.vcol = OFF_VB + h * 64; P.hw = 64; P.g = 0; P.h = h; P.p = p; }
    return P;
}
__device__ __forceinline__ void issue_tiles(u32x4 (&kr)[6], u32x4 (&vr)[6], const UnitP& P, const h16* proj, int wid, int lane) {
#pragma unroll
    for (int j = 0; j < 6; ++j) { const int tt0 = P.tt_first + 64 * j; if (j < P.ntile && tt0 >= 0 && tt0 < P.LF) load_tile_regs(kr[j], vr[j], proj, P.tokb, P.dil, P.LF, tt0, P.kcol, P.vcol, wid, lane); }
}
__device__ __forceinline__ void write_tiles(LAS unsigned char* L, const u32x4 (&kr)[6], const u32x4 (&vr)[6], const UnitP& P, int wid, int lane) {
#pragma unroll
    for (int j = 0; j < 6; ++j) { const int tt0 = P.tt_first + 64 * j; if (j < P.ntile && tt0 >= 0 && tt0 < P.LF) {
        *(LAS u32x4*)(L + j * TILE_BYTES + wid * 1024 + lane * 16) = kr[j];
        *(LAS u32x4*)(L + j * TILE_BYTES + 8192 + wid * 1024 + lane * 16) = vr[j]; } }
}

__device__ __forceinline__ void attn_phase(Frame& F) {
    const int lane = F.lane, wid = F.wave, r32 = lane & 31, hi = lane >> 5;
    LAS unsigned char* L = F.lds;
    LAS float* wsf = (LAS float*)(L + WSF_OFF) + wid * 64;
    LAS h16* stg = (LAS h16*)(L + STG_OFF + wid * 4096);
    const h16* proj = (const h16*)(F.ws + WS_PROJ);
    int u = F.vcu;
    if (u >= 2048) return;
    UnitP P = decode_unit(u);
    u32x4 kr[6], vr[6];
    issue_tiles(kr, vr, P, proj, wid, lane);
#pragma unroll 1
    for (; u < 2048; u += F.G) {
        TSEC_BEGIN(20);
        write_tiles(L, kr, vr, P, wid, lane);
        int head, tq, qcol, jb, je, qw0;
        if (P.isA) { head = 4 * P.g + (wid & 3); qw0 = P.q0 + 32 * (wid >> 2); qcol = OFF_QA + head * 64; jb = 0; je = 5; }
        else       { head = P.h; qw0 = P.q0 + 32 * wid; qcol = OFF_QB + head * 64; jb = wid >> 1; je = jb + 3; }
        tq = qw0 + r32;
        half8 qr[4];
        { const h16* qp = proj + (size_t)(P.tokb + tq * P.dil) * NIN + qcol + hi * 8;
#pragma unroll
          for (int d0 = 0; d0 < 4; ++d0) qr[d0] = *(const half8*)(qp + d0 * 16); }
        float m = P.isA ? F.a_sink[head] * LOG2E : 0.f, l = (P.isA && hi == 0) ? 1.0f : 0.0f;
        bool first = !P.isA;
        asm volatile("" ::: "memory");
        __syncthreads();
        asm volatile("s_waitcnt vmcnt(0)" ::: "memory");
#pragma unroll
        for (int d0 = 0; d0 < 4; ++d0) asm volatile("" : "+v"(qr[d0]));
        TSEC_END(20);
        TSEC_BEGIN(21);
        const UnitP Pc = P;
        if (u + F.G < 2048) { P = decode_unit(u + F.G); issue_tiles(kr, vr, P, proj, wid, lane); }
        asm volatile("" ::: "memory");
        f32x16 o0, o1, negm;
#pragma unroll
        for (int r = 0; r < 16; ++r) { o0[r] = 0.f; o1[r] = 0.f; negm[r] = -m; }
        const int lo = (-Pc.hw > -tq) ? -Pc.hw : -tq, hi_ = (Pc.hw < Pc.LF - 1 - tq) ? Pc.hw : (Pc.LF - 1 - tq); const unsigned span = (unsigned)(hi_ - lo);
#pragma unroll 1
        for (int j = jb; j < je; ++j) {
            const int tt0 = Pc.tt_first + 64 * j; if (tt0 < 0 || tt0 >= Pc.LF) continue;
            int md[2];
#pragma unroll
            for (int h = 0; h < 2; ++h) { const int mn = tt0 + 32 * h - (qw0 + 31), mx = tt0 + 32 * h + 31 - qw0;
                md[h] = (mn > Pc.hw || mx < -Pc.hw) ? 0 : ((mn >= -Pc.hw && mx <= Pc.hw) ? 1 : 2); }
            if ((md[0] | md[1]) == 0) continue;
            tile_step(o0, o1, m, l, negm, first, qr, L + j * TILE_BYTES, L + j * TILE_BYTES + 8192, wsf, lane, r32, hi, md[0], md[1], tt0 + 4 * hi - tq, lo, span);
            first = false;
        }
        { auto rr = __builtin_amdgcn_permlane32_swap(__float_as_uint(l), __float_as_uint(l), false, false); l = __uint_as_float(rr[0]) + __uint_as_float(rr[1]); }
        TSEC_END(21);
        TSEC_BEGIN(22);
        if (Pc.isA) store_out(o0, o1, l, wsf, stg, (h16*)(F.ws + WS_OA) + head * 64, 512, Pc.tokb + qw0, 1, lane, r32, hi);
        else {
            if (hi == 0) ((float*)(F.ws + WS_LSE))[((size_t)Pc.p * M + Pc.tokb + tq * Pc.dil) * 8 + head] = (m + __builtin_amdgcn_logf(l)) * LN2;
            store_out(o0, o1, l, wsf, stg, (h16*)(F.ws + WS_OB) + (size_t)Pc.p * M * 512 + head * 64, 512, Pc.tokb + qw0 * Pc.dil, Pc.dil, lane, r32, hi);
        }
        __syncthreads();
        TSEC_END(22);
    }
}
}

__device__ __forceinline__ void p3_combine(Frame& F) {
    const int gw = F.vcu * NWAVES + F.wave, NGW = F.G * NWAVES, lane = F.lane;
    const h16* OA = (const h16*)(F.ws + WS_OA); const h16* OB = (const h16*)(F.ws + WS_OB); const float* LSE = (const float*)(F.ws + WS_LSE);
    h16* MX = (h16*)(F.ws + WS_MIXED);
    f32x4 ga[2], gb[2];
#pragma unroll
    for (int i = 0; i < 2; ++i) { ga[i] = *(const f32x4*)(F.g_out_a + 8 * lane + 4 * i); gb[i] = *(const f32x4*)(F.g_out_b + 8 * lane + 4 * i); }
    for (int t = gw; t < M; t += NGW) {
        const u32x4 ra = __builtin_nontemporal_load((const u32x4*)(OA + (size_t)t * 512 + 8 * lane));
        u32x4 rb[3]; float ls[3];
#pragma unroll
        for (int p = 0; p < 3; ++p) { rb[p] = __builtin_nontemporal_load((const u32x4*)(OB + ((size_t)p * M + t) * 512 + 8 * lane)); ls[p] = LSE[((size_t)p * M + t) * 8 + (lane >> 3)]; }
        float a[8], bsum[8];
#pragma unroll
        for (int i = 0; i < 4; ++i) { a[2 * i] = h2f((unsigned short)(ra[i] & 0xffffu)); a[2 * i + 1] = h2f((unsigned short)(ra[i] >> 16)); }
        const float mx = fmaxf(ls[0], fmaxf(ls[1], ls[2]));
        float w[3]; float ws_ = 0.f;
#pragma unroll
        for (int p = 0; p < 3; ++p) { w[p] = __expf(ls[p] - mx); ws_ += w[p]; }
        const float inv = 1.0f / ws_;
#pragma unroll
        for (int i = 0; i < 8; ++i) bsum[i] = 0.f;
#pragma unroll
        for (int p = 0; p < 3; ++p) { const float wp = w[p] * inv;
#pragma unroll
            for (int i = 0; i < 4; ++i) { bsum[2 * i] += wp * h2f((unsigned short)(rb[p][i] & 0xffffu)); bsum[2 * i + 1] += wp * h2f((unsigned short)(rb[p][i] >> 16)); } }
        float sa = 0.f, sb = 0.f;
#pragma unroll
        for (int i = 0; i < 8; ++i) { sa += a[i] * a[i]; sb += bsum[i] * bsum[i]; }
        const float rsa = 1.0f / sqrtf(wave_sum(sa) * (1.0f / 512.0f) + NORM_EPS), rsb = 1.0f / sqrtf(wave_sum(sb) * (1.0f / 512.0f) + NORM_EPS);
        u32x4 wa, wb;
#pragma unroll
        for (int i = 0; i < 4; ++i) { wa[i] = pk_h2(a[2 * i] * rsa * ga[i >> 1][(2 * i) & 3], a[2 * i + 1] * rsa * ga[i >> 1][(2 * i + 1) & 3]);
                                      wb[i] = pk_h2(bsum[2 * i] * rsb * gb[i >> 1][(2 * i) & 3], bsum[2 * i + 1] * rsb * gb[i >> 1][(2 * i + 1) & 3]); }
        *(u32x4*)(MX + (size_t)t * DM + 8 * lane) = wa;
        *(u32x4*)(MX + (size_t)t * DM + 512 + 8 * lane) = wb;
    }
}

__device__ __forceinline__ void p5_router(Frame& F) {
    const int gw = F.vcu * NWAVES + F.wave, NGW = F.G * NWAVES, lane = F.lane;
    LAS unsigned char* L = F.lds;
    for (int i = F.tid; i < DM * 4; i += NWAVES * 64) { const int k = i >> 2, c = i & 3; *(LAS f32x4*)(L + k * 64 + (k >> 2) * 16 + c * 16) = *(const f32x4*)(F.w_router + k * 16 + c * 4); }
    __syncthreads();
    const h16* X1 = (const h16*)(F.ws + WS_X1); unsigned char* H2 = F.ws + WS_H2; float* AFF = (float*)(F.ws + WS_AFF);
    f32x4 g[4];
#pragma unroll
    for (int j = 0; j < 4; ++j) g[j] = ((const f32x4*)F.g_ffn)[lane + 64 * j];
    u32x2 vn[4];
    if (gw < M) {
#pragma unroll
        for (int j = 0; j < 4; ++j) vn[j] = __builtin_nontemporal_load((const u32x2*)(X1 + (size_t)gw * DM) + lane + 64 * j);
    }
    LAS float* cscr = (LAS float*)(L + 69632 + F.wave * 8448);
    const float* const wg_ = F.w_gate; const float* const wu_ = F.w_up; const float* const wd_ = F.w_down; unsigned char* const ws_ = F.ws;
    const int JT = (int)((CV_TOTAL + (unsigned)NGW - 1u) / (unsigned)NGW), J1 = (F.G > BATCH * NE) ? JT - JT / 8 : JT;
    int cj = 0; bool cpendA = false, cpendB = false;
    ConvItem citA = conv8_decode(wg_, wu_, wd_, ws_, (unsigned)gw < CV_TOTAL ? (unsigned)gw : 0u), citB = citA; float cregA[32], cregB[32];
#define P5_PUMP1(PEND, ITEM, REG) do { __builtin_amdgcn_sched_barrier(0); if (PEND) conv8_finish(ITEM, REG, cscr, lane); __builtin_amdgcn_sched_barrier(0); \
        { const unsigned it_ = (unsigned)cj * (unsigned)NGW + (unsigned)gw; PEND = (cj < J1) && (it_ < CV_TOTAL); if (PEND) ITEM = conv8_decode(wg_, wu_, wd_, ws_, it_); ++cj; conv8_issue(ITEM, REG, lane); } __builtin_amdgcn_sched_barrier(0); } while (0)
#define P5_PUMP() do { if (cj & 1) P5_PUMP1(cpendB, citB, cregB); else P5_PUMP1(cpendA, citA, cregA); } while (0)
    P5_PUMP();
    P5_PUMP();
    for (int t = gw; t < M; t += NGW) {
        f32x4 v[4]; float s = 0.f;
#pragma unroll
        for (int j = 0; j < 4; ++j) { v[j].x = h2f((unsigned short)(vn[j].x & 0xffffu)); v[j].y = h2f((unsigned short)(vn[j].x >> 16)); v[j].z = h2f((unsigned short)(vn[j].y & 0xffffu)); v[j].w = h2f((unsigned short)(vn[j].y >> 16)); }
        if (t + NGW < M) {
#pragma unroll
            for (int j = 0; j < 4; ++j) vn[j] = __builtin_nontemporal_load((const u32x2*)(X1 + (size_t)(t + NGW) * DM) + lane + 64 * j);
        }
        P5_PUMP();
#pragma unroll
        for (int j = 0; j < 4; ++j) s += (v[j].x * v[j].x + v[j].y * v[j].y) + (v[j].z * v[j].z + v[j].w * v[j].w);
        const float rs = 1.0f / sqrtf(wave_sum(s) * (1.0f / DM) + NORM_EPS);
        unsigned* o4 = (unsigned*)(H2 + (size_t)t * DM) + lane;
        float acc[16];
#pragma unroll
        for (int e = 0; e < 16; ++e) acc[e] = 0.f;
#pragma unroll
        for (int j = 0; j < 4; ++j) {
            const f32x4 y = v[j] * rs * g[j];
            o4[64 * j] = pk_fp8x4(clamp8(y.x * S_H2), clamp8(y.y * S_H2), clamp8(y.z * S_H2), clamp8(y.w * S_H2));
#pragma unroll
            for (int c = 0; c < 4; ++c) {
                const int k = 256 * j + 4 * lane + c; LAS const f32x4* wr = (LAS const f32x4*)(L + k * 64 + (k >> 2) * 16);
#pragma unroll
                for (int q = 0; q < 4; ++q) { const f32x4 wv = wr[q];
#pragma unroll
                    for (int z = 0; z < 4; ++z) acc[4 * q + z] += y[c] * wv[z]; }
                if (c & 1) asm volatile("" ::: "memory");
            }
        }
        { const bool up = (lane & 32) != 0;
#pragma unroll
          for (int i = 0; i < 8; ++i) { const float send = up ? acc[i] : acc[i + 8], keep = up ? acc[i + 8] : acc[i]; acc[i] = keep + __shfl_xor(send, 32); } }
        { const bool up = (lane & 16) != 0;
#pragma unroll
          for (int i = 0; i < 4; ++i) { const float send = up ? acc[i] : acc[i + 4], keep = up ? acc[i + 4] : acc[i]; acc[i] = keep + __shfl_xor(send, 16); } }
        { const bool up = (lane & 8) != 0;
#pragma unroll
          for (int i = 0; i < 2; ++i) { const float send = up ? acc[i] : acc[i + 2], keep = up ? acc[i + 2] : acc[i]; acc[i] = keep + __shfl_xor(send, 8); } }
        float lg;
        { const bool up = (lane & 4) != 0; const float send = up ? acc[0] : acc[1], keep = up ? acc[1] : acc[0]; lg = keep + __shfl_xor(send, 4); }
        lg += __shfl_xor(lg, 2); lg += __shfl_xor(lg, 1);
        float mx = lg;
#pragma unroll
        for (int o = 4; o < 64; o <<= 1) mx = fmaxf(mx, __shfl_xor(mx, o));
        const float ex = __expf(lg - mx); float sm = ex;
#pragma unroll
        for (int o = 4; o < 64; o <<= 1) sm += __shfl_xor(sm, o);
        if ((lane & 3) == 0) { const int e = lane >> 2, b = t >> 12, sidx = t & (SEQ - 1); AFF[((size_t)(b * NE + e)) * SEQ + sidx] = ex / sm; }
        P5_PUMP();
    }
#pragma unroll 1
    while (cpendA || cpendB || cj < J1) P5_PUMP();
#undef P5_PUMP
#undef P5_PUMP1
}

__device__ __forceinline__ void p6_topk(Frame& F) {
    LAS unsigned* cnt = (LAS unsigned*)F.lds;
    const int tid = F.tid, lane = F.lane, wid = F.wave;
    const float* AFF = (const float*)(F.ws + WS_AFF);
    int* TOK = (int*)(F.ws + WS_TOK); float* GATE = (float*)(F.ws + WS_GATE); int* SLOT = (int*)(F.ws + WS_SLOT);
    for (int pair = F.vcu; pair < BATCH * NE; pair += F.G) {
        const int b = pair >> 4, e = pair & 15;
        const float* a = AFF + (size_t)pair * SEQ + 8 * tid;
        const f32x4 a0 = *(const f32x4*)a, a1 = *(const f32x4*)(a + 4);
        unsigned key[8];
#pragma unroll
        for (int j = 0; j < 4; ++j) { key[j] = __float_as_uint(a0[j]); key[4 + j] = __float_as_uint(a1[j]); }
        unsigned prefix = 0u;
        __syncthreads();
#pragma unroll 1
        for (int bit = 31; bit >= 0; --bit) {
            const unsigned cand = prefix | (1u << bit);
            unsigned c = 0;
#pragma unroll
            for (int j = 0; j < 8; ++j) c += (unsigned)__popcll(__ballot(key[j] >= cand));
            LAS unsigned* cc = cnt + ((bit & 1) ? 8 : 0);
            if (lane == 0) cc[wid] = c;
            __syncthreads();
            unsigned tot = 0;
#pragma unroll
            for (int w = 0; w < 8; ++w) tot += cc[w];
            if (tot >= (unsigned)CAP) prefix = cand;
        }
        unsigned cg = 0, ce = 0;
#pragma unroll
        for (int j = 0; j < 8; ++j) { cg += key[j] > prefix; ce += key[j] == prefix; }
        unsigned pk = (ce << 16) | cg, inc = pk;
#pragma unroll
        for (int o = 1; o < 64; o <<= 1) { const unsigned n = __shfl_up(inc, o); if (lane >= o) inc += n; }
        __syncthreads();
        LAS unsigned* ws_ = cnt + 16;
        if (lane == 63) ws_[wid] = inc;
        __syncthreads();
        unsigned base = 0, total = 0;
#pragma unroll
        for (int w = 0; w < 8; ++w) { const unsigned x = ws_[w]; if (w < wid) base += x; total += x; }
        const unsigned exc = base + inc - pk;
        unsigned gtb = exc & 0xffffu, eqb = exc >> 16;
        const unsigned need = (unsigned)CAP - (total & 0xffffu);
#pragma unroll
        for (int j = 0; j < 8; ++j) {
            const int sidx = 8 * tid + j; int slot = -1;
            if (key[j] > prefix) { slot = (int)(gtb + (eqb < need ? eqb : need)); ++gtb; }
            else if (key[j] == prefix) { if (eqb < need) slot = (int)(gtb + eqb); ++eqb; }
            SLOT[((size_t)(b * SEQ + sidx)) * NE + e] = slot;
            if (slot >= 0) { TOK[e * EROWS + b * CAP + slot] = b * SEQ + sidx; GATE[e * EROWS + b * CAP + slot] = __uint_as_float(key[j]); }
        }
        __syncthreads();
    }
}

__device__ __forceinline__ void p9_final(Frame& F) {
    const int gw = F.vcu * NWAVES + F.wave, NGW = F.G * NWAVES, lane = F.lane;
    const int* SLOT = (const int*)(F.ws + WS_SLOT); const unsigned char* YE = F.ws + WS_YE;
    f32x4 g[4];
#pragma unroll
    for (int j = 0; j < 4; ++j) g[j] = ((const f32x4*)F.g_final)[lane + 64 * j];
    int myslot = (gw < M) ? SLOT[(size_t)gw * NE + (lane & 15)] : -1;
    for (int t = gw; t < M; t += NGW) {
        f32x4* xr = (f32x4*)(F.out + (size_t)t * DM) + lane;
        const u32x2* xi = (const u32x2*)((const h16*)(F.ws + WS_X1) + (size_t)t * DM) + lane;
        f32x4 v[4];
#pragma unroll
        for (int j = 0; j < 4; ++j) { const u32x2 w = __builtin_nontemporal_load(xi + 64 * j); v[j].x = h2f((unsigned short)(w.x & 0xffffu)); v[j].y = h2f((unsigned short)(w.x >> 16)); v[j].z = h2f((unsigned short)(w.y & 0xffffu)); v[j].w = h2f((unsigned short)(w.y >> 16)); }
        const int slot_cur = myslot;
        const int tn = t + NGW;
        myslot = (tn < M) ? SLOT[(size_t)tn * NE + (lane & 15)] : -1;
        unsigned mask = (unsigned)(__ballot(slot_cur >= 0) & 0xffffull);
        const size_t ebase = (size_t)(t >> 12) * CAP;
        while (mask) {
            int e[4]; float w[4];
#pragma unroll
            for (int q = 0; q < 4; ++q) { const bool has = mask != 0u; e[q] = has ? (int)__builtin_ctz(mask) : e[0]; w[q] = has ? 1.f : 0.f; mask = has ? (mask & (mask - 1u)) : 0u; }
            unsigned y[4][4];
#pragma unroll
            for (int q = 0; q < 4; ++q) { const int sl = __builtin_amdgcn_readlane(slot_cur, e[q]);
                const unsigned* yr = (const unsigned*)(YE + ((size_t)e[q] * EROWS + ebase + sl) * DM) + lane;
#pragma unroll
                for (int j = 0; j < 4; ++j) y[q][j] = __builtin_nontemporal_load(yr + 64 * j); }
#pragma unroll
            for (int q = 0; q < 4; ++q) { const float wq = w[q] * (1.0f / S_YE);
#pragma unroll
                for (int j = 0; j < 4; ++j) { const auto lo2 = __builtin_amdgcn_cvt_pk_f32_fp8((int)y[q][j], false), hi2 = __builtin_amdgcn_cvt_pk_f32_fp8((int)y[q][j], true);
                    v[j].x += wq * lo2[0]; v[j].y += wq * lo2[1]; v[j].z += wq * hi2[0]; v[j].w += wq * hi2[1]; } }
        }
        float s = 0.f;
#pragma unroll
        for (int j = 0; j < 4; ++j) s += (v[j].x * v[j].x + v[j].y * v[j].y) + (v[j].z * v[j].z + v[j].w * v[j].w);
        const float rs = 1.0f / sqrtf(wave_sum(s) * (1.0f / DM) + NORM_EPS);
#pragma unroll
        for (int j = 0; j < 4; ++j) __builtin_nontemporal_store(v[j] * rs * g[j], xr + 64 * j);
    }
}

constexpr int NPHASE = 10;
struct Args { const float* in[13]; float* out; unsigned char* ws; int ph_lo, ph_hi, li, pad; };

__global__ void __launch_bounds__(NWAVES * 64, 2) mk_fwd(Args args) {
    extern __shared__ __attribute__((aligned(16))) unsigned char lds[];
    Frame F;
    F.lds = (LAS unsigned char*)lds;
    F.tid = threadIdx.x; F.lane = F.tid & 63; F.wave = __builtin_amdgcn_readfirstlane(F.tid >> 6);
    F.G = gridDim.x; { const int bx = blockIdx.x; F.vcu = (F.G % 8 == 0) ? (bx % 8) * (F.G / 8) + bx / 8 : bx; }
    F.x = args.in[0]; F.g_mix = args.in[1]; F.w_in = args.in[2]; F.a_sink = args.in[3]; F.g_out_a = args.in[4]; F.g_out_b = args.in[5]; F.w_out = args.in[6];
    F.g_ffn = args.in[7]; F.w_router = args.in[8]; F.w_gate = args.in[9]; F.w_up = args.in[10]; F.w_down = args.in[11]; F.g_final = args.in[12];
    F.out = args.out; F.ws = args.ws; F.tacc = 0;
    volatile LAS unsigned* MISC = (volatile LAS unsigned*)(F.lds + MISC_OFF);
    for (int u = F.tid; u < (LDS_BYTES - LDSCTL_OFF) / 4; u += NWAVES * 64) ((LAS unsigned*)(F.lds + LDSCTL_OFF))[u] = 0u;
    __syncthreads();
    const int lo = args.ph_lo, hi = args.ph_hi;
    const bool multi = (hi - lo) > 1;
    unsigned* barw = (unsigned*)(F.ws + WS_CTL) + CW_BAR + args.li * XCD_BAR_WORDS;
    XcdBarrier bar; bar.bar = barw; bar.x = 0; bar.st = nullptr;
    if (multi) bar = xcd_barrier_post(barw, MISC + 8);
#define IN(k) (((PH_MASK >> (k)) & 1) && lo <= (k) && (k) < hi)
#define SEAM(k) do { if (IN(k) && IN((k) + 1)) xcd_barrier(bar); } while (0)
#define TS0(k) do { if (TIME_PHASE == (k)) ts0_ = __builtin_amdgcn_s_memrealtime(); } while (0)
#define TS1(k) do { if (TIME_PHASE == (k)) ts1_ = __builtin_amdgcn_s_memrealtime(); } while (0)
    unsigned long long ts0_ = 0, ts1_ = 0;
#define REPS(k) for (int rep_ = 0; rep_ < 1 + ((REP_MASK >> (k)) & 1); ++rep_)

    TS0(0);
    if (IN(0)) REPS(0) { p0_prologue(F); SEAM(0); }
    TS1(0);
    TS0(1);
    if (IN(1)) {
        pg8::DenseProb P{(const char*)(F.ws + WS_H), (const char*)(F.ws + WS_WIN), DM * 2};
        pg8::DenseOrder S; S.init(M, NIN, F.G, (int)blockIdx.x, 1 + ((REP_MASK >> 1) & 1));
        pg8::EpiInProj E{(h16*)(F.ws + WS_PROJ), (const float*)(F.ws + WS_ROPE)};
        pg8::gemm_phase<pg8::DenseProb, pg8::EpiInProj, pg8::DenseOrder, true>(F.lds, P, S, E);
        SEAM(1);
    }
    TS1(1);
    TS0(2);
    if (IN(2)) REPS(2) { att::attn_phase(F); SEAM(2); }
    TS1(2);
    TS0(3);
    if (IN(3)) REPS(3) { p3_combine(F); SEAM(3); }
    TS1(3);
    TS0(4);
    if (IN(4)) {
        pg8::DenseProb P{(const char*)(F.ws + WS_MIXED), (const char*)(F.ws + WS_WOUT), DM * 2};
        pg8::DenseOrder S; S.init(M, DM, F.G, (int)blockIdx.x, 1 + ((REP_MASK >> 4) & 1));
        pg8::EpiResidual E{F.x, (h16*)(F.ws + WS_X1)};
        pg8::gemm_phase<pg8::DenseProb, pg8::EpiResidual, pg8::DenseOrder, true>(F.lds, P, S, E);
        SEAM(4);
    }
    TS1(4);
    TS0(5);
    if (IN(5)) REPS(5) { p5_router(F); SEAM(5); }
    TS1(5);
    TS0(6);
    if (IN(6)) REPS(6) {
        p6_topk(F);
        if (F.G > BATCH * NE && F.vcu >= BATCH * NE) {
            const int NGW_ = F.G * NWAVES, JT = (int)((CV_TOTAL + (unsigned)NGW_ - 1u) / (unsigned)NGW_), J1 = JT - JT / 8;
            const unsigned R0 = (unsigned)J1 * (unsigned)NGW_, NCW = (unsigned)(F.G - BATCH * NE) * NWAVES;
            for (unsigned it = R0 + (unsigned)(F.vcu - BATCH * NE) * NWAVES + (unsigned)F.wave; it < CV_TOTAL; it += NCW) conv8_one(F.w_gate, F.w_up, F.w_down, F.ws, it, (LAS float*)(F.lds + F.wave * 16384), F.lane);
        }
        SEAM(6); }
    TS1(6);
    TS0(7);
    if (IN(7)) {
        pg8::Moe1Prob P{(const char*)(F.ws + WS_H2), (const char*)(F.ws + WS_WGU), DM, (const int*)(F.ws + WS_TOK)};
        pg8::GroupOrder S; S.init(EROWS / 256, 4096 / 256, NE, F.G, F.vcu, 1 + ((REP_MASK >> 7) & 1));
        pg8::EpiSwiGLU E{F.ws + WS_HMID};
        pg8::gemm_phase<pg8::Moe1Prob, pg8::EpiSwiGLU, pg8::GroupOrder, true>(F.lds, P, S, E);
        SEAM(7);
    }
    TS1(7);
    TS0(8);
    if (IN(8)) {
        pg8::Moe2Prob P{(const char*)(F.ws + WS_HMID), (const char*)(F.ws + WS_WD), FF};
        pg8::GroupOrder S; S.init(EROWS / 256, DM / 256, NE, F.G, F.vcu, 1 + ((REP_MASK >> 8) & 1));
        pg8::EpiDown E{F.ws + WS_YE, (const float*)(F.ws + WS_GATE)};
        pg8::gemm_phase<pg8::Moe2Prob, pg8::EpiDown, pg8::GroupOrder, true>(F.lds, P, S, E);
        SEAM(8);
    }
    TS1(8);
    TS0(9);
    if (IN(9)) REPS(9) { p9_final(F); if (rep_ == 0 && ((REP_MASK >> 9) & 1)) xcd_barrier(bar); }
    TS1(9);
    if (TIME_PHASE >= 0 && blockIdx.x == 0 && F.tid == 0) { asm volatile("s_waitcnt vmcnt(0)" ::: "memory"); F.out[0] += (float)(TIME_PHASE >= 20 ? F.tacc : (ts1_ - ts0_)) * 0.01f * TIME_SCALE; }
#undef IN
#undef SEAM
}

extern "C" void kernel_launch(void* const* d_in, const int* in_sizes, int n_in, void* d_out, int out_size, void* d_ws, size_t ws_size, hipStream_t stream) {
    static int grid = 0;
    if (grid == 0) {
        if (n_in != 13 || in_sizes[0] != M * DM || out_size != M * DM || ws_size < WS_END) { fprintf(stderr, "kernel_launch: unexpected problem (n_in %d, ws %zu)\n", n_in, ws_size); grid = -1; return; }
        int dev = 0, cus = 0, per_cu = 0;
        if (hipGetDevice(&dev) != hipSuccess || hipDeviceGetAttribute(&cus, hipDeviceAttributeMultiprocessorCount, dev) != hipSuccess) { grid = -1; return; }
        if (hipFuncSetAttribute((const void*)mk_fwd, hipFuncAttributeMaxDynamicSharedMemorySize, LDS_BYTES) != hipSuccess) { fprintf(stderr, "kernel_launch: hipFuncSetAttribute failed\n"); grid = -1; return; }
        if (hipOccupancyMaxActiveBlocksPerMultiprocessor(&per_cu, (const void*)mk_fwd, NWAVES * 64, LDS_BYTES) != hipSuccess || per_cu < 1)
            fprintf(stderr, "kernel_launch: occupancy query reports %d blocks per CU\n", per_cu);
        (void)hipGetLastError();
        grid = cus;
    }
    if (grid < 0) return;
    (void)hipMemsetAsync((char*)d_ws + WS_CTL, 0, CTL_ZERO_BYTES, stream);
    Args a{};
    for (int i = 0; i < 13; ++i) a.in[i] = (const float*)d_in[i];
    a.out = (float*)d_out; a.ws = (unsigned char*)d_ws;
    if (MK_N_LAUNCHES == 1) {
        for (int pass = 0; pass < REP_ALL; ++pass) { a.ph_lo = 0; a.ph_hi = NPHASE; a.li = pass;
        hipLaunchKernelGGL(mk_fwd, dim3(grid), dim3(NWAVES * 64), LDS_BYTES, stream, a); }
    } else {
        for (int li = 0; li < NPHASE; ++li) { a.ph_lo = li; a.ph_hi = li + 1; a.li = 0;
            hipLaunchKernelGGL(mk_fwd, dim3(grid), dim3(NWAVES * 64), LDS_BYTES, stream, a); }
    }
}
```

```cpp
#include <hip/hip_runtime.h>
#include <cstdio>
#include <cstdint>

#ifndef MK_N_LAUNCHES
#define MK_N_LAUNCHES 1
#endif
#ifndef TIME_PHASE
#define TIME_PHASE -1
#endif
#ifndef TIME_SCALE
#define TIME_SCALE 1.0f
#endif
#ifndef PH_MASK
#define PH_MASK 0x3ff
#endif
#ifndef REP_ALL
#define REP_ALL 1
#endif
#ifndef REP_MASK
#define REP_MASK 0
#endif

#define LAS __attribute__((address_space(3)))
#define GAS __attribute__((address_space(1)))
typedef unsigned short h16;
typedef _Float16 half8 __attribute__((ext_vector_type(8)));
typedef _Float16 half2v __attribute__((ext_vector_type(2)));
typedef short s16x4 __attribute__((ext_vector_type(4)));
typedef float f32x4 __attribute__((ext_vector_type(4)));
typedef float f32x16 __attribute__((ext_vector_type(16)));
typedef unsigned u32x2 __attribute__((ext_vector_type(2)));
typedef unsigned u32x4 __attribute__((ext_vector_type(4)));
typedef GAS unsigned gu32;

constexpr int BATCH = 4, SEQ = 4096, DM = 1024, M = BATCH * SEQ;
constexpr int NIN = 2304;
constexpr int OFF_QA = 0, OFF_KA = 512, OFF_VA = 640, OFF_QB = 768, OFF_KB = 1280, OFF_VB = 1792;
constexpr int NE = 16, CAP = 512, FF = 2048, EROWS = BATCH * CAP;
constexpr float NORM_EPS = 1e-6f;
constexpr float LOG2E = 1.4426950408889634f, LN2 = 0.6931471805599453f;
constexpr float QSCALE = 0.18033688011112042f;
constexpr float S_H2 = 4.f, S_W = 32.f, S_HM = 2.f, S_YE = 16.f;

constexpr size_t MiB = 1u << 20;
constexpr size_t WS_CTL = 0, CTL_ZERO_BYTES = 64 * 1024;
constexpr size_t WS_ROPE = 1 * MiB;
constexpr size_t WS_AFF = 2 * MiB;
constexpr size_t WS_TOK = 3 * MiB;
constexpr size_t WS_GATE = 3 * MiB + 256 * 1024;
constexpr size_t WS_SLOT = 4 * MiB;
constexpr size_t WS_LSE = 5 * MiB;
constexpr size_t WS_WIN = 8 * MiB;
constexpr size_t WS_WOUT = 13 * MiB;
constexpr size_t WS_WGU = 16 * MiB;
constexpr size_t WS_WD = 144 * MiB;
constexpr size_t WS_H = 208 * MiB;
constexpr size_t WS_PROJ = 240 * MiB;
constexpr size_t WS_OA = 312 * MiB;
constexpr size_t WS_OB = 328 * MiB;
constexpr size_t WS_HMID = 208 * MiB;
constexpr size_t WS_MIXED = 376 * MiB;
constexpr size_t WS_H2 = 408 * MiB;
constexpr size_t WS_YE = 376 * MiB;
constexpr size_t WS_X1 = 440 * MiB;
constexpr size_t WS_END = 504 * MiB;
constexpr int CW_CONV = 64, CW_P1DONE = 128;
constexpr int CW_BAR = 1024;

constexpr int RING_BYTES = 131072;
constexpr int LDSCTL_OFF = 143360, MISC_OFF = LDSCTL_OFF + 320;
constexpr int LDS_BYTES = 147456;
constexpr int NWAVES = 8;

#define RLX_AGENT __ATOMIC_RELAXED, __HIP_MEMORY_SCOPE_AGENT
#define LDS_WAIT() asm volatile("s_waitcnt lgkmcnt(0)" ::: "memory")
#define VM_WAIT() asm volatile("s_waitcnt vmcnt(0)" ::: "memory")

__device__ __forceinline__ unsigned pk_h2(float lo, float hi) { half2v v = {(_Float16)lo, (_Float16)hi}; return __builtin_bit_cast(unsigned, v); }
__device__ __forceinline__ unsigned pk_h2_rtz(float lo, float hi) { return __builtin_bit_cast(unsigned, __builtin_amdgcn_cvt_pkrtz(lo, hi)); }
__device__ __forceinline__ unsigned pk_fp8x4(float a, float b, float c, float d) {
    int w = __builtin_amdgcn_cvt_pk_fp8_f32(a, b, 0, false); w = __builtin_amdgcn_cvt_pk_fp8_f32(c, d, w, true); return (unsigned)w; }
__device__ __forceinline__ float clamp8(float x) { return fminf(fmaxf(x, -448.f), 448.f); }
__device__ __forceinline__ float h2f(unsigned short b) { return (float)__builtin_bit_cast(_Float16, b); }
__device__ __forceinline__ float wave_sum(float v) {
#pragma unroll
    for (int o = 1; o < 64; o <<= 1) v += __shfl_xor(v, o);
    return v;
}


constexpr unsigned CV_PER = (DM / 64) * (FF / 32);
constexpr unsigned CV_TOTAL = (unsigned)NE * 3u * CV_PER;
struct ConvItem { const float* W; unsigned char* D; int N, K; };
__device__ __forceinline__ ConvItem conv8_decode(const float* wg, const float* wu, const float* wd, unsigned char* ws, unsigned it) {
    ConvItem c;
    if (it < (unsigned)NE * 2u * CV_PER) {
        const unsigned e = it / (2u * CV_PER); unsigned r = it - e * 2u * CV_PER; const unsigned which = r / CV_PER; r -= which * CV_PER;
        const int kb = (int)(r / (FF / 32)), n0 = 32 * (int)(r % (FF / 32));
        c.N = FF; c.K = DM; c.W = (which ? wu : wg) + (size_t)e * DM * FF + (size_t)(64 * kb) * FF + n0;
        c.D = ws + WS_WGU + ((size_t)e * 4096 + (size_t)((n0 >> 7) * 256 + (int)which * 128 + (n0 & 127))) * DM + 64 * kb;
    } else {
        const unsigned r0 = it - (unsigned)NE * 2u * CV_PER, e = r0 / CV_PER, r = r0 - e * CV_PER;
        const int kb = (int)(r / (DM / 32)), n0 = 32 * (int)(r % (DM / 32));
        c.N = DM; c.K = FF; c.W = wd + (size_t)e * FF * DM + (size_t)(64 * kb) * DM + n0;
        c.D = ws + WS_WD + ((size_t)e * DM + n0) * FF + 64 * kb;
    }
    return c;
}
__device__ __forceinline__ void conv8_issue(const ConvItem& c, float (&r)[32], int lane) {
#pragma unroll
    for (int i = 0; i < 32; ++i) r[i] = __builtin_nontemporal_load(c.W + (size_t)(2 * i + (lane >> 5)) * c.N + (lane & 31));
}
__device__ __forceinline__ void conv8_finish(const ConvItem& c, const float (&r)[32], LAS float* scr, int lane) {
#pragma unroll
    for (int i = 0; i < 32; ++i) scr[(2 * i + (lane >> 5)) * 33 + (lane & 31)] = r[i];
    LDS_WAIT(); asm volatile("" ::: "memory");
    const int n = lane >> 1, kh = (lane & 1) * 32; const LAS float* s = scr + kh * 33 + n;
    u32x4 o0, o1;
#pragma unroll
    for (int q = 0; q < 4; ++q) {
        o0[q] = pk_fp8x4(s[(4 * q) * 33] * S_W, s[(4 * q + 1) * 33] * S_W, s[(4 * q + 2) * 33] * S_W, s[(4 * q + 3) * 33] * S_W);
        o1[q] = pk_fp8x4(s[(16 + 4 * q) * 33] * S_W, s[(17 + 4 * q) * 33] * S_W, s[(18 + 4 * q) * 33] * S_W, s[(19 + 4 * q) * 33] * S_W); }
    unsigned char* d = c.D + (size_t)n * c.K + kh;
    *(GAS u32x4*)d = o0; *(GAS u32x4*)(d + 16) = o1;
    LDS_WAIT(); asm volatile("" ::: "memory");
}
__device__ __forceinline__ void conv8_one(const float* wg, const float* wu, const float* wd, unsigned char* ws, unsigned it, LAS float* scr, int lane) {
    const ConvItem c = conv8_decode(wg, wu, wd, ws, it); float r[32]; conv8_issue(c, r, lane); conv8_finish(c, r, scr, lane);
}
constexpr unsigned CV_BATCH = 64;
__device__ __forceinline__ void conv8_dynamic(const float* wg, const float* wu, const float* wd, unsigned char* ws, unsigned* ctr, unsigned* done_ctr, unsigned until_done,
                                              LAS float* scr, volatile LAS unsigned* sh, int tid, int wave, int lane) {
    for (;;) {
        if (tid == 0) { sh[0] = __hip_atomic_fetch_add(ctr, CV_BATCH, __ATOMIC_RELAXED, __HIP_MEMORY_SCOPE_AGENT);
                        sh[1] = until_done ? __hip_atomic_load(done_ctr, __ATOMIC_RELAXED, __HIP_MEMORY_SCOPE_AGENT) : 0u; }
        __syncthreads();
        const unsigned b0 = sh[0]; const bool stop = until_done && sh[1] >= until_done;
        __syncthreads();
        if (b0 >= CV_TOTAL) break;
#pragma unroll 1
        for (unsigned q = 0; q < CV_BATCH / 8; ++q) { const unsigned it = b0 + (unsigned)wave * (CV_BATCH / 8) + q; if (it < CV_TOTAL) conv8_one(wg, wu, wd, ws, it, scr, lane); }
        if (stop) break;
    }
}
struct NoSide { static constexpr bool ON = false; };

namespace pg8 {
constexpr int BM = 256, BK = 64, HALF = 128, HTB = HALF * BK * 2, STAGE_BYTES = 8 * HTB, NXCD = 8, WGM = 8;
__host__ __device__ __forceinline__ int lds_byte(int r, int c) { const int st = (r >> 4) * 2 + (c >> 5), rr = r & 15, cc = c & 31, ob = rr * 64 + cc * 2; return st * 1024 + (ob ^ (((ob >> 9) & 1) << 5)); }
__host__ __device__ __forceinline__ void stage_rc(int b, int& R, int& C) { const int st = b / 1024, sb = b % 1024, swz = sb ^ (((sb >> 9) & 1) << 5); R = (st >> 1) * 16 + swz / 64; C = (st & 1) * 32 + (swz % 64) / 2; }
__host__ __device__ __forceinline__ int perm32(int rho) { const int n = rho >> 4, i = rho & 15; return 8 * (i >> 2) + 4 * n + (i & 3); }

struct Unit { int pm, pn, g; };

struct DenseOrder {
    int nM, nN, nwg, G, c, reps;
    __device__ void init(int M_, int N_, int G_, int c_, int reps_ = 1) { nM = M_ / BM; nN = N_ / BM; nwg = nM * nN; G = G_; c = c_; reps = reps_; }
    __device__ bool next(int i, Unit& u) const {
        const int mine = (nwg - c + G - 1) / G; if (mine <= 0 || i >= mine * reps) return false; i %= mine;
        const long L = (long)i * G + c;
        int wgid = (int)L; { const int q = nwg / NXCD, r = nwg % NXCD, xcd = wgid % NXCD, off = wgid / NXCD; wgid = (xcd < r ? xcd * (q + 1) : r * (q + 1) + (xcd - r) * q) + off; }
        const int nig = WGM * nN, gid = wgid / nig, fm = gid * WGM, gsz = (nM - fm) < WGM ? (nM - fm) : WGM;
        u.pm = fm + ((wgid % nig) % gsz); u.pn = (wgid % nig) / gsz; u.g = 0; return true;
    }
};
struct GroupOrder {
    int nPM, nPN, total, G, c, reps;
    __device__ void init(int nPM_, int nPN_, int groups, int G_, int c_, int reps_ = 1) { nPM = nPM_; nPN = nPN_; total = nPM_ * nPN_ * groups; G = G_; c = c_; reps = reps_; }
    __device__ bool next(int i, Unit& u) const {
        const int mine = (total - c + G - 1) / G; if (mine <= 0 || i >= mine * reps) return false; i %= mine;
        const int L = i * G + c;
        const int per = nPM * nPN; u.g = L / per; const int rem = L % per; u.pn = rem / nPM; u.pm = rem % nPM; return true;
    }
};

struct DenseProb {
    static constexpr bool BKN = false, FP8 = false;
    const char* A; const char* Bt; int KB;
    __device__ __forceinline__ unsigned a_row(const Unit& u, int r) const { return (unsigned)(u.pm * BM + r); }
    __device__ __forceinline__ const char* b_base(const Unit& u, int half) const { return Bt + ((size_t)u.pn * BM + (size_t)half * HALF) * KB; }
    __device__ __forceinline__ size_t b_kstep() const { return (size_t)BK * 2; }
    __device__ __forceinline__ unsigned b_pitch() const { return (unsigned)KB; }
};
struct Moe1Prob {
    static constexpr bool BKN = false, FP8 = true;
    const char* A; const char* Bt; int KB; const int* tok;
    __device__ __forceinline__ unsigned a_row(const Unit& u, int r) const { return (unsigned)tok[u.g * EROWS + u.pm * BM + r]; }
    __device__ __forceinline__ const char* b_base(const Unit& u, int half) const { return Bt + ((size_t)u.g * 4096 + (size_t)u.pn * BM + (size_t)half * HALF) * KB; }
    __device__ __forceinline__ size_t b_kstep() const { return (size_t)BK * 2; }
    __device__ __forceinline__ unsigned b_pitch() const { return (unsigned)KB; }
};
struct Moe2Prob {
    static constexpr bool BKN = false, FP8 = true;
    const char* A; const char* Bt; int KB;
    __device__ __forceinline__ unsigned a_row(const Unit& u, int r) const { return (unsigned)(u.g * EROWS + u.pm * BM + r); }
    __device__ __forceinline__ const char* b_base(const Unit& u, int half) const { return Bt + ((size_t)u.g * DM + (size_t)u.pn * BM + (size_t)half * HALF) * KB; }
    __device__ __forceinline__ size_t b_kstep() const { return (size_t)BK * 2; }
    __device__ __forceinline__ unsigned b_pitch() const { return (unsigned)KB; }
};

struct EpiInProj {
    static constexpr bool PERM = true;
    h16* O; const float* rope;
    __device__ __forceinline__ void operator()(const f32x4 (&acc)[2][2][4][2], const Unit& u, int wr, int wc, int fr, int fq) const {
        const int row0 = u.pm * BM + wr * 64 + fr;
        const int ct0 = u.pn * BM;
        const bool rt0 = (ct0 < OFF_VA) || (ct0 >= OFF_QB && ct0 < OFF_VB), rt1 = (ct0 + HALF < OFF_VA) || (ct0 + HALF >= OFF_QB && ct0 + HALF < OFF_VB);
        const bool any_rope = (rt0 || rt1) && ((wc & 1) == 0);
        float c[8], s[8];
        if (any_rope) { const float* rp = rope + (size_t)(row0 & (SEQ - 1)) * 16;
            const f32x4 c0 = *(const f32x4*)(rp), c1 = *(const f32x4*)(rp + 4), s0 = *(const f32x4*)(rp + 8), s1 = *(const f32x4*)(rp + 12);
#pragma unroll
            for (int j = 0; j < 4; ++j) { c[j] = c0[j]; c[4 + j] = c1[j]; s[j] = s0[j]; s[4 + j] = s1[j]; } }
        else {
#pragma unroll
            for (int j = 0; j < 8; ++j) { c[j] = 1.f; s[j] = 0.f; } }
        const float cd16[8] = {-9.576594803e-01f, -9.992462593e-01f, 8.243765146e-01f, 9.932003012e-01f, 9.997440109e-01f, 9.999903729e-01f, 9.999996380e-01f, 9.999999864e-01f};
        const float sd16[8] = {-2.879033167e-01f, 3.881898152e-02f, 5.660418378e-01f, 1.164180468e-01f, 2.262548617e-02f, 4.387956730e-03f, 8.509272408e-04f, 1.650141653e-04f};
        const float cd80[8] = {-1.103872438e-01f, -9.812132344e-01f, -9.911539132e-01f, 8.345872775e-01f, 9.936068238e-01f, 9.997593311e-01f, 9.999909490e-01f, 9.999996596e-01f};
        const float sd80[8] = {-9.938886539e-01f, 1.929263812e-01f, 1.327174458e-01f, 5.508757358e-01f, 1.128958803e-01f, 2.193809395e-02f, 4.254623881e-03f, 8.250707366e-04f};
        const float sg = (fq == 0) ? -1.f : 1.f;
#pragma unroll
        for (int ai = 0; ai < 2; ++ai)
#pragma unroll
            for (int m = 0; m < 4; ++m) {
                const int row = row0 + ai * HALF + m * 16;
                if (any_rope && (ai | m) != 0) {
#pragma unroll
                    for (int j = 0; j < 8; ++j) { const float cdv = (m == 0) ? cd80[j] : cd16[j], sdv = (m == 0) ? sd80[j] : sd16[j];
                        const float cn = c[j] * cdv - s[j] * sdv, sn = s[j] * cdv + c[j] * sdv; c[j] = cn; s[j] = sn; }
                }
#pragma unroll
                for (int bj = 0; bj < 2; ++bj) {
                    const bool do_rope = (bj ? rt1 : rt0) && ((wc & 1) == 0);
                    const int col0 = ct0 + bj * HALF + wc * 32 + 8 * fq;
                    f32x4 v0 = acc[ai][bj][m][0], v1 = acc[ai][bj][m][1];
                    if (do_rope) {
                        f32x4 p0, p1;
#pragma unroll
                        for (int j = 0; j < 4; ++j) { p0[j] = __shfl_xor(v0[j], 16); p1[j] = __shfl_xor(v1[j], 16); }
                        if (fq < 2) {
#pragma unroll
                            for (int j = 0; j < 4; ++j) { v0[j] = v0[j] * c[j] + (p0[j] * s[j]) * sg; v1[j] = v1[j] * c[4 + j] + (p1[j] * s[4 + j]) * sg; } }
                    }
                    u32x4 w; w.x = pk_h2(v0[0], v0[1]); w.y = pk_h2(v0[2], v0[3]); w.z = pk_h2(v1[0], v1[1]); w.w = pk_h2(v1[2], v1[3]);
                    *(u32x4*)(O + (size_t)row * NIN + col0) = w;
                }
            }
    }
};
struct EpiResidual {
    static constexpr bool PERM = true;
    const float* base; h16* out;
    __device__ __forceinline__ void operator()(const f32x4 (&acc)[2][2][4][2], const Unit& u, int wr, int wc, int fr, int fq) const {
        const int row0 = u.pm * BM + wr * 64 + fr, col0 = u.pn * BM + wc * 32 + 8 * fq;
#pragma unroll
        for (int ai = 0; ai < 2; ++ai)
#pragma unroll
            for (int m = 0; m < 4; ++m) {
                const size_t off = (size_t)(row0 + ai * HALF + m * 16) * DM + col0;
#pragma unroll
                for (int bj = 0; bj < 2; ++bj) { const f32x4 b0 = __builtin_nontemporal_load((const f32x4*)(base + off + bj * HALF)), b1 = __builtin_nontemporal_load((const f32x4*)(base + off + bj * HALF + 4));
                    const f32x4 v0 = b0 + acc[ai][bj][m][0], v1 = b1 + acc[ai][bj][m][1];
                    u32x4 w; w.x = pk_h2(v0[0], v0[1]); w.y = pk_h2(v0[2], v0[3]); w.z = pk_h2(v1[0], v1[1]); w.w = pk_h2(v1[2], v1[3]);
                    *(u32x4*)(out + off + bj * HALF) = w; }
            }
    }
};
struct EpiSwiGLU {
    static constexpr bool PERM = true;
    unsigned char* O;
    __device__ __forceinline__ void operator()(const f32x4 (&acc)[2][2][4][2], const Unit& u, int wr, int wc, int fr, int fq) const {
        const int row0 = u.g * EROWS + u.pm * BM + wr * 64 + fr, col0 = u.pn * HALF + wc * 32 + 8 * fq;
        constexpr float IS = 1.0f / (S_H2 * S_W);
#pragma unroll
        for (int ai = 0; ai < 2; ++ai)
#pragma unroll
            for (int m = 0; m < 4; ++m) {
                float r[8];
#pragma unroll
                for (int n = 0; n < 2; ++n)
#pragma unroll
                    for (int j = 0; j < 4; ++j) { const float a = acc[ai][0][m][n][j] * IS, up = acc[ai][1][m][n][j] * (IS * S_HM);
                        r[n * 4 + j] = clamp8(a * __builtin_amdgcn_rcpf(1.0f + __builtin_amdgcn_exp2f(-a * LOG2E)) * up); }
                u32x2 w; w.x = pk_fp8x4(r[0], r[1], r[2], r[3]); w.y = pk_fp8x4(r[4], r[5], r[6], r[7]);
                *(u32x2*)(O + (size_t)(row0 + ai * HALF + m * 16) * FF + col0) = w;
            }
    }
};
struct EpiDown {
    static constexpr bool PERM = true;
    unsigned char* O; const float* gate;
    __device__ __forceinline__ void operator()(const f32x4 (&acc)[2][2][4][2], const Unit& u, int wr, int wc, int fr, int fq) const {
        const int row0 = u.g * EROWS + u.pm * BM + wr * 64 + fr, col0 = u.pn * BM + wc * 32 + 8 * fq;
#pragma unroll
        for (int ai = 0; ai < 2; ++ai)
#pragma unroll
            for (int m = 0; m < 4; ++m) {
                const int row = row0 + ai * HALF + m * 16; const float gt = gate[row] * (S_YE / (S_HM * S_W));
#pragma unroll
                for (int bj = 0; bj < 2; ++bj) { const f32x4 v0 = acc[ai][bj][m][0] * gt, v1 = acc[ai][bj][m][1] * gt;
                    u32x2 w; w.x = pk_fp8x4(clamp8(v0[0]), clamp8(v0[1]), clamp8(v0[2]), clamp8(v0[3])); w.y = pk_fp8x4(clamp8(v1[0]), clamp8(v1[1]), clamp8(v1[2]), clamp8(v1[3]));
                    *(u32x2*)(O + (size_t)row * DM + col0 + bj * HALF) = w; }
            }
    }
};

template <class Prob, class Epi, class Sched, bool ALIGN_EPI, class Side = NoSide>
__device__ __forceinline__ void gemm_phase(LAS unsigned char* lds, const Prob P, const Sched& S, const Epi& E, const Side SD = Side()) {
    const int tid = threadIdx.x, wid = __builtin_amdgcn_readfirstlane(tid >> 6), lane = tid & 63, wr = wid >> 2, wc = wid & 3, fr = lane & 15, fq = lane >> 4;
    const int KB = P.KB, nt = KB / 128;
    int RA[2]; unsigned CA2[2], voffB[2];
#pragma unroll
    for (int i = 0; i < 2; ++i) { int R, C; stage_rc(tid * 16 + i * 8192, R, C); const int Rb = Epi::PERM ? ((R & ~31) + perm32(R & 31)) : R;
        RA[i] = R; CA2[i] = (unsigned)C * 2u;
        if constexpr (Prob::BKN) {
            static_assert(Epi::PERM, "the [K][N] B path is written for PERM epilogues");
            const int r = 4 * wid + 32 * i + (lane >> 4), g = (r & 3) | (((r >> 3) & 1) << 2), c = (lane & 15) ^ (g << 1);
            voffB[i] = (unsigned)r * P.b_pitch() + (unsigned)c * 16u;
        } else voffB[i] = (unsigned)(Rb * KB) + (unsigned)C * 2u; }
    const unsigned kstep = (unsigned)(BK * 2);
    const size_t kstepB = P.b_kstep();
    int btr[2];
    { const int q = fr >> 2, p = fr & 3, X = ((q | ((fq & 1) << 2)) << 2) | (q & 1);
#pragma unroll
      for (int n = 0; n < 2; ++n) btr[n] = (8 * fq + q) * 256 + (((8 * wc + 2 * p + n) ^ X) * 8); }
    const unsigned lds_u32 = (unsigned)(__UINTPTR_TYPE__)lds;
    unsigned bta[2]; bta[0] = lds_u32 + (unsigned)btr[0]; bta[1] = lds_u32 + (unsigned)btr[1];
    const unsigned rowb = (unsigned)KB;
    const unsigned ldsw = (unsigned)wid * 1024u;
    const int aoff = lds_byte(wr * 64 + fr, fq * 8), boff = lds_byte(wc * 32 + fr, fq * 8);
#define PG8_SA(b, h) (((b) * 2 + (h)) * HTB)
#define PG8_SB(b, h) ((4 + (b) * 2 + (h)) * HTB)
#define PG8_STAGE_B(bufoff, gbase) do { _Pragma("unroll") for (int _i = 0; _i < 2; ++_i) \
        __builtin_amdgcn_global_load_lds((const unsigned*)((const char*)(gbase) + voffB[_i]), (LAS unsigned*)(lds + (bufoff) + ldsw + _i * 8192), 16, 0, 0); } while (0)
#define PG8_STAGE_A(bufoff, kb, offs) do { _Pragma("unroll") for (int _i = 0; _i < 2; ++_i) \
        __builtin_amdgcn_global_load_lds((const unsigned*)(P.A + (size_t)(kb) + (offs)[_i]), (LAS unsigned*)(lds + (bufoff) + ldsw + _i * 8192), 16, 0, 0); } while (0)
#define PG8_LDA(dst, b, h) do { if constexpr (Prob::FP8) { _Pragma("unroll") for (int m = 0; m < 4; ++m) { dst##8[m].lo = *(const LAS v4i_*)(lds + PG8_SA(b, h) + aoff + m * 2048); dst##8[m].hi = *(const LAS v4i_*)(lds + PG8_SA(b, h) + aoff + m * 2048 + 1024); } } \
        else { _Pragma("unroll") for (int m = 0; m < 4; ++m) _Pragma("unroll") for (int k = 0; k < 2; ++k) dst[m][k] = *(const LAS half8*)(lds + PG8_SA(b, h) + aoff + m * 2048 + k * 1024); } } while (0)
#define PG8_LDB(dst, b, h) do { if constexpr (Prob::BKN) { _Pragma("unroll") for (int n = 0; n < 2; ++n) { const unsigned ad_ = bta[n] + (unsigned)PG8_SB(b, h); _Pragma("unroll") for (int k = 0; k < 2; ++k) { \
            asm volatile("ds_read_b64_tr_b16 %0, %1 offset:%c2" : "=&v"(dst##lo[n][k]) : "v"(ad_), "i"(k * 8192) : "memory"); \
            asm volatile("ds_read_b64_tr_b16 %0, %1 offset:%c2" : "=&v"(dst##hi[n][k]) : "v"(ad_), "i"(k * 8192 + 1024) : "memory"); } } } \
        else if constexpr (Prob::FP8) { _Pragma("unroll") for (int n = 0; n < 2; ++n) { dst##8[n].lo = *(const LAS v4i_*)(lds + PG8_SB(b, h) + boff + n * 2048); dst##8[n].hi = *(const LAS v4i_*)(lds + PG8_SB(b, h) + boff + n * 2048 + 1024); } } \
        else { _Pragma("unroll") for (int n = 0; n < 2; ++n) _Pragma("unroll") for (int k = 0; k < 2; ++k) dst[n][k] = *(const LAS half8*)(lds + PG8_SB(b, h) + boff + n * 2048 + k * 1024); } } while (0)
#define PG8_BFIX(dst) do { if constexpr (Prob::BKN) { typedef short s16x8_ __attribute__((ext_vector_type(8))); _Pragma("unroll") for (int n = 0; n < 2; ++n) _Pragma("unroll") for (int k = 0; k < 2; ++k) { \
            const s16x8_ v_ = __builtin_shufflevector(dst##lo[n][k], dst##hi[n][k], 0, 1, 2, 3, 4, 5, 6, 7); dst[n][k] = __builtin_bit_cast(half8, v_); } } } while (0)
#define PG8_MMA(ai, bj, At, Bt) do { __builtin_amdgcn_s_setprio(1); _Pragma("unroll") for (int m = 0; m < 4; ++m) _Pragma("unroll") for (int n = 0; n < 2; ++n) { \
        if constexpr (Prob::FP8) asm volatile("v_mfma_f32_16x16x128_f8f6f4 %0, %1, %2, %0" : "+v"(acc[ai][bj][m][n]) : "v"(Bt##8[n]), "v"(At##8[m])); \
        else { _Pragma("unroll") for (int k = 0; k < 2; ++k) acc[ai][bj][m][n] = __builtin_amdgcn_mfma_f32_16x16x32_f16(Bt[n][k], At[m][k], acc[ai][bj][m][n], 0, 0, 0); } } \
        __builtin_amdgcn_s_setprio(0); } while (0)
#define PG8_WAIT_V(n) asm volatile("s_waitcnt vmcnt(" #n ")" ::: "memory")
#define PG8_WAIT_L(n) asm volatile("s_waitcnt lgkmcnt(" #n ")" ::: "memory")
#define PG8_BAR __builtin_amdgcn_s_barrier()
#define PG8_SCHED __builtin_amdgcn_sched_barrier(0)
#define PG8_SIDE_ISSUE(slot) do { if constexpr (Side::ON) { sfly = SD.L->pending() && (((slot) % SD.every) == 0); \
        if (sfly) { scc = SD.L->chunk(SD.L->done); const float* sp_ = SD.L->src_of(SD.L->wa, SD.L->wb, scc); \
            asm volatile("global_load_dwordx4 %0, %2, off\n\tglobal_load_dwordx4 %1, %2, off offset:16" : "=&v"(sr0), "=&v"(sr1) : "v"(sp_) : "memory"); } } } while (0)
#define PG8_SIDE_FINISH() do { if constexpr (Side::ON) { if (sfly) { asm volatile("" : "+v"(sr0), "+v"(sr1)); SD.L->store(SD.L->da, scc, sr0, sr1); SD.L->done += 1; } PG8_SCHED; } } while (0)
#define PG8_WAIT_VS(extra) do { if constexpr (Side::ON) { if (sfly) { if ((extra) == 2) PG8_WAIT_V(10); else PG8_WAIT_V(9); } else PG8_WAIT_V(8); } else PG8_WAIT_V(8); } while (0)
#define PG8_AOFF(dst, un) do { _Pragma("unroll") for (int _h = 0; _h < 2; ++_h) _Pragma("unroll") for (int _i = 0; _i < 2; ++_i) dst[_h][_i] = P.a_row(un, _h * HALF + RA[_i]) * rowb + CA2[_i]; } while (0)
    Unit cur, nxt; int ui = 0;
    if (!S.next(0, cur)) return;
    bool sfly = false; f32x4 sr0, sr1; unsigned scc = 0;
    f32x4 acc[2][2][4][2];
#pragma unroll
    for (int a = 0; a < 2; ++a)
#pragma unroll
        for (int b = 0; b < 2; ++b)
#pragma unroll
            for (int m = 0; m < 4; ++m)
#pragma unroll
                for (int n = 0; n < 2; ++n) acc[a][b][m][n] = (f32x4){0.f, 0.f, 0.f, 0.f};
    typedef int v4i_ __attribute__((ext_vector_type(4))); typedef int v8i_ __attribute__((ext_vector_type(8)));
    half8 At[4][2], B0[2][2], B1[2][2];
    s16x4 B0lo[2][2], B0hi[2][2], B1lo[2][2], B1hi[2][2];
    v8i_ At8[4], B08[2], B18[2];
    unsigned cuo[2][2], nxo[2][2];
    PG8_AOFF(cuo, cur);
    const char* cB0 = P.b_base(cur, 0); const char* cB1 = P.b_base(cur, 1);
    PG8_STAGE_B(PG8_SB(0, 0), cB0); PG8_STAGE_B(PG8_SB(0, 1), cB1); PG8_STAGE_A(PG8_SA(0, 0), 0, cuo[0]); PG8_STAGE_A(PG8_SA(0, 1), 0, cuo[1]);
    if (wr == 1) PG8_BAR;
    PG8_WAIT_V(2); PG8_BAR;
    PG8_STAGE_B(PG8_SB(1, 0), cB0 + kstepB); PG8_STAGE_A(PG8_SA(1, 0), kstep, cuo[0]); PG8_STAGE_B(PG8_SB(1, 1), cB1 + kstepB);
    PG8_WAIT_V(6); PG8_BAR;
    for (;;) {
        const bool has_next = S.next(ui + 1, nxt);
        if (!has_next) nxt = cur;
        PG8_AOFF(nxo, nxt);
        const char* nB0 = P.b_base(nxt, 0); const char* nB1 = P.b_base(nxt, 1);
        for (int t = 0; t < nt; t += 2) {
            const bool last = (t == nt - 2);
            const unsigned k1 = (unsigned)(t + 1) * kstep;
            const unsigned k2 = last ? 0u : (unsigned)(t + 2) * kstep, k3 = k2 + kstep;
            const char* b20 = last ? nB0 : cB0 + (size_t)(t + 2) * kstepB; const char* b21 = last ? nB1 : cB1 + (size_t)(t + 2) * kstepB;
            const char* b30 = b20 + kstepB; const char* b31 = b21 + kstepB;
            unsigned o20[2], o21[2];
#pragma unroll
            for (int i = 0; i < 2; ++i) { o20[i] = last ? nxo[0][i] : cuo[0][i]; o21[i] = last ? nxo[1][i] : cuo[1][i]; }
            PG8_LDB(B0, 0, 0); PG8_LDB(B1, 0, 1); PG8_SCHED; PG8_LDA(At, 0, 0); PG8_STAGE_A(PG8_SA(1, 1), k1, cuo[1]); PG8_SIDE_ISSUE((ui * nt + t) >> 1);
            PG8_WAIT_VS(2);
            PG8_WAIT_L(0); PG8_SCHED; PG8_BFIX(B0); PG8_BFIX(B1); PG8_BAR; PG8_MMA(0, 0, At, B0); PG8_MMA(0, 1, At, B1); PG8_BAR; PG8_SCHED;
            PG8_LDA(At, 0, 1); PG8_STAGE_B(PG8_SB(0, 0), b20); PG8_STAGE_B(PG8_SB(0, 1), b21); PG8_STAGE_A(PG8_SA(0, 0), k2, o20);
            PG8_WAIT_VS(2); PG8_WAIT_L(0); PG8_BAR; PG8_MMA(1, 0, At, B0); PG8_MMA(1, 1, At, B1); PG8_BAR; PG8_SCHED;
            PG8_LDB(B0, 1, 0); PG8_LDB(B1, 1, 1); PG8_SCHED; PG8_LDA(At, 1, 0); PG8_STAGE_A(PG8_SA(0, 1), k2, o21);
            PG8_WAIT_V(8);
            PG8_WAIT_L(0); PG8_SCHED; PG8_BFIX(B0); PG8_BFIX(B1); PG8_BAR; PG8_MMA(0, 0, At, B0); PG8_MMA(0, 1, At, B1); PG8_BAR; PG8_SCHED;
            PG8_SIDE_FINISH();
            PG8_LDA(At, 1, 1); PG8_STAGE_B(PG8_SB(1, 0), b30); PG8_STAGE_B(PG8_SB(1, 1), b31); PG8_STAGE_A(PG8_SA(1, 0), k3, o20);
            PG8_WAIT_VS(1); PG8_WAIT_L(0); PG8_BAR; PG8_MMA(1, 0, At, B0); PG8_MMA(1, 1, At, B1); PG8_BAR; PG8_SCHED;
            if constexpr (Side::ON) sfly = false;
        }
        if constexpr (ALIGN_EPI) { if (wr == 0) PG8_BAR; }
        if constexpr (Prob::FP8) asm volatile("s_nop 15\n\ts_nop 15" ::: "memory");
        E(acc, cur, wr, wc, fr, fq);
        if (!has_next) break;
#pragma unroll
        for (int a = 0; a < 2; ++a)
#pragma unroll
            for (int b = 0; b < 2; ++b)
#pragma unroll
                for (int m = 0; m < 4; ++m)
#pragma unroll
                    for (int n = 0; n < 2; ++n) acc[a][b][m][n] = (f32x4){0.f, 0.f, 0.f, 0.f};
        cur = nxt; cB0 = nB0; cB1 = nB1; ++ui;
#pragma unroll
        for (int h = 0; h < 2; ++h)
#pragma unroll
            for (int i = 0; i < 2; ++i) cuo[h][i] = nxo[h][i];
        if constexpr (ALIGN_EPI) { if (wr == 1) PG8_BAR; }
    }
    PG8_WAIT_V(0);
    if constexpr (!ALIGN_EPI) { if (wr == 0) PG8_BAR; }
    PG8_BAR;
#undef PG8_SA
#undef PG8_SB
#undef PG8_STAGE_A
#undef PG8_STAGE_B
#undef PG8_LDA
#undef PG8_LDB
#undef PG8_BFIX
#undef PG8_MMA
#undef PG8_WAIT_V
#undef PG8_WAIT_L
#undef PG8_BAR
#undef PG8_SCHED
#undef PG8_AOFF
#undef PG8_SIDE_ISSUE
#undef PG8_SIDE_FINISH
#undef PG8_WAIT_VS
}
}

#define XB_TMO      128
#define XB_XCNT(j)  (256  + 64 * (j))
#define XB_XSUB(j)  (1280 + 64 * (j))
#define XB_XGEN(j)  (2304 + 64 * (j))
#define XB_TOP      3328
#define XB_TOPGEN   3392
#define XCD_BAR_WORDS 3456
#define XB_SPIN_CAP (1u << 18)
__device__ __forceinline__ unsigned xb_ld(unsigned* p)              { return __hip_atomic_load(p, __ATOMIC_RELAXED, __HIP_MEMORY_SCOPE_AGENT); }
__device__ __forceinline__ unsigned xb_add(unsigned* p, unsigned v) { return __hip_atomic_fetch_add(p, v, __ATOMIC_RELAXED, __HIP_MEMORY_SCOPE_AGENT); }
__device__ __forceinline__ unsigned xb_xcc_id() { return (unsigned)__builtin_amdgcn_s_getreg((3 << 11) | 20) & 0xFu; }
#define XB_SPIN(cond, bar) do { unsigned _sp = 0; while (cond) { __builtin_amdgcn_s_sleep(1); \
    if ((++_sp & 255u) == 0u) { if (xb_ld(&(bar)[XB_TMO])) break; if (_sp > XB_SPIN_CAP) { atomicAdd(&(bar)[XB_TMO], 1u); break; } } } } while (0)
struct XcdBarrier { unsigned* bar; unsigned x; volatile LAS unsigned* st; };
__device__ __forceinline__ XcdBarrier xcd_barrier_post(unsigned* bar, volatile LAS unsigned* st) {
    XcdBarrier b; b.bar = bar; b.x = xb_xcc_id(); b.st = st;
    if (threadIdx.x == 0) (void)xb_add(&bar[XB_XCNT(b.x)], 1u);
    return b;
}
__device__ __forceinline__ void xcd_barrier_complete(unsigned* bar, unsigned x, unsigned& nloc, unsigned& nx) {
    const unsigned G = gridDim.x * gridDim.y * gridDim.z;
    unsigned sum, cnt, mine, sp = 0u;
    for (;;) {
        sum = 0u; cnt = 0u; mine = 0u;
#pragma unroll
        for (unsigned j = 0; j < 16; ++j) { const unsigned c = xb_ld(&bar[XB_XCNT(j)]); sum += c; cnt += (c > 0u) ? 1u : 0u; mine = (j == x) ? c : mine; }
        if (sum == G) break;
        __builtin_amdgcn_s_sleep(1);
        if ((++sp & 255u) == 0u) { if (xb_ld(&bar[XB_TMO])) break; if (sp > XB_SPIN_CAP) { atomicAdd(&bar[XB_TMO], 1u); break; } }
    }
    nloc = mine > 0u ? mine : 1u; nx = cnt > 0u ? cnt : 1u;
}
__device__ __forceinline__ void xcd_barrier(const XcdBarrier& b) {
    asm volatile("s_waitcnt vmcnt(0)" ::: "memory");
    __syncthreads();
    if (threadIdx.x == 0) {
        unsigned* bar = b.bar;
        __builtin_amdgcn_s_waitcnt(0);
        unsigned nloc = b.st[0], nx = b.st[1];
        if (nloc == 0u) { xcd_barrier_complete(bar, b.x, nloc, nx); b.st[0] = nloc; b.st[1] = nx; }
        const unsigned old = xb_add(&bar[XB_XSUB(b.x)], 1u);
        const unsigned gen = old / nloc;
        if (old + 1u == (gen + 1u) * nloc) {
            __builtin_amdgcn_fence(__ATOMIC_RELEASE, "agent");
            asm volatile("s_waitcnt vmcnt(0)" ::: "memory");
            const unsigned og = xb_add(&bar[XB_TOP], 1u);
            const unsigned tg = og / nx;
            if (og + 1u == (tg + 1u) * nx) xb_add(&bar[XB_TOPGEN], 1u);
            else XB_SPIN(xb_ld(&bar[XB_TOPGEN]) == tg, bar);
            __builtin_amdgcn_fence(__ATOMIC_ACQUIRE, "agent");
            xb_add(&bar[XB_XGEN(b.x)], 1u);
            asm volatile("s_waitcnt vmcnt(0)" ::: "memory");
        } else {
            XB_SPIN(xb_ld(&bar[XB_XGEN(b.x)]) == gen, bar);
            __builtin_amdgcn_fence(__ATOMIC_ACQUIRE, "agent");
            asm volatile("s_waitcnt vmcnt(0)" ::: "memory");
        }
    }
    __syncthreads();
}

struct Frame {
    LAS unsigned char* lds;
    int tid, lane, wave, vcu, G;
    const float *x, *g_mix, *w_in, *a_sink, *g_out_a, *g_out_b, *w_out, *g_ffn, *w_router, *w_gate, *w_up, *w_down, *g_final;
    float* out; unsigned char* ws;
    unsigned long long tacc;
};

__device__ __forceinline__ void p0_transpose_item(const float* W, int K, int N, h16* WT, int k0, int n0, int drow0, float sc, LAS float* scr, int lane) {
#pragma unroll 8
    for (int i = 0; i < 32; ++i) { const int kk = 2 * i + (lane >> 5); scr[kk * 33 + (lane & 31)] = W[(size_t)(k0 + kk) * N + n0 + (lane & 31)]; }
    LDS_WAIT(); asm volatile("" ::: "memory");
    const int c = lane & 7;
#pragma unroll
    for (int j = 0; j < 4; ++j) { const int n = (lane >> 3) + 8 * j; const LAS float* s = scr + (8 * c) * 33 + n;
        u32x4 o; o.x = pk_h2(s[0 * 33] * sc, s[1 * 33] * sc); o.y = pk_h2(s[2 * 33] * sc, s[3 * 33] * sc); o.z = pk_h2(s[4 * 33] * sc, s[5 * 33] * sc); o.w = pk_h2(s[6 * 33] * sc, s[7 * 33] * sc);
        *(GAS u32x4*)(WT + (size_t)(drow0 + n) * K + k0 + 8 * c) = o; }
    LDS_WAIT(); asm volatile("" ::: "memory");
}
__device__ __forceinline__ void sincos_d(double a, float& s, float& c) {
    const double q = __builtin_rint(a * 0.63661977236758134308);
    double r = __builtin_fma(-q, 1.570796325802803, a); r = __builtin_fma(-q, 9.920935796805404e-10, r);
    const double r2 = r * r;
    double sp = -7.6471637318198164759e-13;
    sp = sp * r2 + 1.6059043836821614599e-10; sp = sp * r2 - 2.5052108385441718775e-08; sp = sp * r2 + 2.7557319223985890653e-06;
    sp = sp * r2 - 1.9841269841269841270e-04; sp = sp * r2 + 8.3333333333333333333e-03; sp = sp * r2 - 1.6666666666666666667e-01;
    const double sn = r + r * r2 * sp;
    double cp = 4.7794773323873852974e-14;
    cp = cp * r2 - 1.1470745597729724714e-11; cp = cp * r2 + 2.0876756987868098979e-09; cp = cp * r2 - 2.7557319223985890653e-07;
    cp = cp * r2 + 2.4801587301587301587e-05; cp = cp * r2 - 1.3888888888888888889e-03; cp = cp * r2 + 4.1666666666666666667e-02; cp = cp * r2 - 0.5;
    const double cs = 1.0 + r2 * cp;
    const int qi = (int)q & 3;
    const double ss = (qi & 1) ? cs : sn, cc = (qi & 1) ? sn : cs;
    s = (float)((qi & 2) ? -ss : ss); c = (float)(((qi + 1) & 2) ? -cc : cc);
}

__device__ __forceinline__ void p0_prologue(Frame& F) {
    LAS float* scr = (LAS float*)(F.lds + F.wave * 16384);
    const int gw = F.vcu * NWAVES + F.wave, NGW = F.G * NWAVES;
    {
        const double invf[8] = {1.0, 0.19392274474868576, 0.03760603093086393, 0.007292664737217109, 0.001414213562373095, 0.0002742481756762073, 5.318295896944988e-05, 1.031338537721246e-05};
        float* rope = (float*)(F.ws + WS_ROPE);
        for (int idx = F.vcu * 512 + F.tid; idx < SEQ * 8; idx += F.G * 512) {
            const int pos = idx >> 3, i = idx & 7;
            double f = invf[0];
#pragma unroll
            for (int j = 1; j < 8; ++j) f = (i == j) ? invf[j] : f;
            float s, c; sincos_d((double)pos * f, s, c);
            rope[pos * 16 + i] = c; rope[pos * 16 + 8 + i] = s;
        }
    }
    {
        h16* H = (h16*)(F.ws + WS_H);
        for (int m = gw; m < M; m += NGW) {
            const GAS f32x4* xr = (const GAS f32x4*)(F.x + (size_t)m * DM) + F.lane;
            f32x4 v[4]; float s = 0.f;
#pragma unroll
            for (int j = 0; j < 4; ++j) { v[j] = __builtin_nontemporal_load(xr + 64 * j); s += (v[j].x * v[j].x + v[j].y * v[j].y) + (v[j].z * v[j].z + v[j].w * v[j].w); }
            const float rs = 1.0f / sqrtf(wave_sum(s) * (1.0f / DM) + NORM_EPS);
            GAS u32x2* o8 = (GAS u32x2*)(H + (size_t)m * DM) + F.lane;
#pragma unroll
            for (int j = 0; j < 4; ++j) { const f32x4 g = ((const GAS f32x4*)F.g_mix)[F.lane + 64 * j]; const f32x4 y = v[j] * rs * g;
                u32x2 w; w.x = pk_h2(y.x, y.y); w.y = pk_h2(y.z, y.w); o8[64 * j] = w; }
        }
    }
    {
        constexpr int I_IN = (DM / 64) * (NIN / 32), I_OUT = (DM / 64) * (DM / 32);
        constexpr int NITEMS = I_IN + I_OUT;
        for (int it = gw; it < NITEMS; it += NGW) {
            int r = it;
            if (r < I_IN) { const int nblk = NIN / 32, kb = r / nblk, nb = r % nblk, n0 = 32 * nb;
                const float sc = (n0 < OFF_KA || (n0 >= OFF_QB && n0 < OFF_KB)) ? QSCALE : 1.0f;
                p0_transpose_item(F.w_in, DM, NIN, (h16*)(F.ws + WS_WIN), 64 * kb, n0, n0, sc, scr, F.lane); continue; }
            r -= I_IN;
            { const int nblk = DM / 32, kb = r / nblk, nb = r % nblk, n0 = 32 * nb;
              p0_transpose_item(F.w_out, DM, DM, (h16*)(F.ws + WS_WOUT), 64 * kb, n0, n0, 1.0f, scr, F.lane); }
        }
    }
}

#define TSEC_BEGIN(code) unsigned long long tsec_##code = 0; if (TIME_PHASE == (code)) tsec_##code = __builtin_amdgcn_s_memrealtime()
#define TSEC_END(code) do { if (TIME_PHASE == (code)) F.tacc += __builtin_amdgcn_s_memrealtime() - tsec_##code; } while (0)
namespace att {
__device__ __forceinline__ int crow(int r, int hi) { return (r & 3) + 8 * (r >> 2) + 4 * hi; }
constexpr float THR = 8.0f;
constexpr int ATT_SIDE = 0;
constexpr int TILE_BYTES = 16384;
constexpr int WSF_OFF = 98304, STG_OFF = 100352;

__device__ __forceinline__ float max3f(float a, float b, float c) { float r; asm("v_max3_f32 %0, %1, %2, %3" : "=v"(r) : "v"(a), "v"(b), "v"(c)); return r; }
__device__ __forceinline__ float max16(const f32x16& p) {
    float a = max3f(p[0], p[1], p[2]), b = max3f(p[3], p[4], p[5]); a = max3f(a, p[6], p[7]); b = max3f(b, p[8], p[9]); a = max3f(a, p[10], p[11]); b = max3f(b, p[12], p[13]);
    return max3f(a, b, max3f(p[14], p[15], p[15])); }
__device__ __forceinline__ void tile_step(f32x16& o0, f32x16& o1, float& m, float& l, f32x16& negm, bool first, const half8 (&qr)[4],
                                          LAS const unsigned char* kt, LAS const unsigned char* vt, LAS float* wsf, int lane, int r32, int hi,
                                          int mode0, int mode1, int rel0, int lo, unsigned span) {
    f32x16 p0 = negm, p1 = negm;
    LAS const unsigned char* kb = kt + hi * 1024 + r32 * 16;
    const float NINF = -__builtin_inff();
    float rm = NINF;
    if (mode0) {
#pragma unroll
        for (int d0 = 0; d0 < 4; ++d0) p0 = __builtin_amdgcn_mfma_f32_32x32x16_f16(*(LAS const half8*)(kb + d0 * 2048), qr[d0], p0, 0, 0, 0);
        asm volatile("s_nop 15\n\ts_nop 7" : "+v"(p0));
        if (mode0 == 2) {
#pragma unroll
            for (int r = 0; r < 16; ++r) { const int rel = rel0 + (r & 3) + 8 * (r >> 2); if ((unsigned)(rel - lo) > span) p0[r] = NINF; }
        }
        rm = max16(p0);
    }
    if (mode1) {
#pragma unroll
        for (int d0 = 0; d0 < 4; ++d0) p1 = __builtin_amdgcn_mfma_f32_32x32x16_f16(*(LAS const half8*)(kb + d0 * 2048 + 512), qr[d0], p1, 0, 0, 0);
        asm volatile("s_nop 15\n\ts_nop 7" : "+v"(p1));
        if (mode1 == 2) {
#pragma unroll
            for (int r = 0; r < 16; ++r) { const int rel = rel0 + 32 + (r & 3) + 8 * (r >> 2); if ((unsigned)(rel - lo) > span) p1[r] = NINF; }
        }
        rm = fmaxf(rm, max16(p1));
    }
    { auto rr = __builtin_amdgcn_permlane32_swap(__float_as_uint(rm), __float_as_uint(rm), false, false); rm = fmaxf(__uint_as_float(rr[0]), __uint_as_float(rr[1])); }
    if (first || __any(rm > THR)) {
        const float dl = first ? fmaxf(rm, -100.f) : fmaxf(rm, 0.f); m += dl;
#pragma unroll
        for (int r = 0; r < 16; ++r) { p0[r] -= dl; p1[r] -= dl; negm[r] = -m; }
        if (!first) {
            const float f = __builtin_amdgcn_exp2f(-dl); l *= f;
            if (hi == 0) wsf[r32] = f;
            LDS_WAIT();
#pragma unroll
            for (int r = 0; r < 16; ++r) { const float fr_ = wsf[crow(r, hi)]; o0[r] *= fr_; o1[r] *= fr_; }
        }
    }
    LAS const unsigned char* vb = vt + (4 * hi + ((lane & 15) >> 2)) * 64 + ((lane >> 4) & 1) * 32 + (lane & 3) * 8;
    typedef short s16x8 __attribute__((ext_vector_type(8)));
    float s = 0.f;
#define ATT_HALF(P, KS0) do { \
        _Pragma("unroll") for (int r = 0; r < 16; ++r) { P[r] = __builtin_amdgcn_exp2f(P[r]); s += P[r]; } \
        u32x4 pwa, pwb; \
        _Pragma("unroll") for (int j = 0; j < 4; ++j) { pwa[j] = pk_h2_rtz(P[2 * j], P[2 * j + 1]); pwb[j] = pk_h2_rtz(P[8 + 2 * j], P[9 + 2 * j]); } \
        _Pragma("unroll") for (int kk = 0; kk < 2; ++kk) { const half8 pa = __builtin_bit_cast(half8, kk ? pwb : pwa); \
            _Pragma("unroll") for (int d0 = 0; d0 < 2; ++d0) { \
                const s16x4 vlo = __builtin_amdgcn_ds_read_tr16_b64_v4i16((LAS s16x4*)(vb + d0 * 4096 + ((KS0) + kk) * 1024)); \
                const s16x4 vhi = __builtin_amdgcn_ds_read_tr16_b64_v4i16((LAS s16x4*)(vb + d0 * 4096 + ((KS0) + kk) * 1024 + 512)); \
                const s16x8 vv = {vlo[0], vlo[1], vlo[2], vlo[3], vhi[0], vhi[1], vhi[2], vhi[3]}; \
                const half8 vf = __builtin_bit_cast(half8, vv); \
                if (d0 == 0) o0 = __builtin_amdgcn_mfma_f32_32x32x16_f16(pa, vf, o0, 0, 0, 0); \
                else         o1 = __builtin_amdgcn_mfma_f32_32x32x16_f16(pa, vf, o1, 0, 0, 0); } } } while (0)
    if (mode0) ATT_HALF(p0, 0);
    if (mode1) ATT_HALF(p1, 2);
#undef ATT_HALF
    l += s;
}

__device__ __forceinline__ void load_tile_regs(u32x4& kreg, u32x4& vreg, const h16* proj, int tokb, int dil, int LF, int tt0, int kcol, int vcol, int wid, int lane) {
    int tk = tt0 + lane; tk = tk < 0 ? 0 : (tk >= LF ? LF - 1 : tk);
    kreg = *(const u32x4*)(proj + (size_t)(tokb + tk * dil) * NIN + kcol + wid * 8);
    int tv = tt0 + (wid & 3) * 16 + (lane >> 2); tv = tv < 0 ? 0 : (tv >= LF ? LF - 1 : tv);
    vreg = *(const u32x4*)(proj + (size_t)(tokb + tv * dil) * NIN + vcol + (wid >> 2) * 32 + (lane & 3) * 8);
}

__device__ __forceinline__ void store_out(const f32x16& o0, const f32x16& o1, float l_tot, LAS float* wsf, LAS h16* stg, h16* dst, size_t pitch, int tok0, int dil, int lane, int r32, int hi) {
    if (hi == 0) wsf[32 + r32] = l_tot;
    LDS_WAIT();
#pragma unroll
    for (int r = 0; r < 16; ++r) { const int orow = crow(r, hi); const float rl = __builtin_amdgcn_rcpf(wsf[32 + orow]);
        stg[orow * 64 + r32] = __builtin_bit_cast(h16, (_Float16)(o0[r] * rl)); stg[orow * 64 + 32 + r32] = __builtin_bit_cast(h16, (_Float16)(o1[r] * rl)); }
    LDS_WAIT();
#pragma unroll
    for (int i = 0; i < 4; ++i) { const int row = i * 8 + (lane >> 3), ch = lane & 7; const u32x4 v = *(LAS const u32x4*)(stg + row * 64 + ch * 8);
        *(u32x4*)(dst + (size_t)(tok0 + row * dil) * pitch + ch * 8) = v; }
    LDS_WAIT();
}

struct UnitP { int isA, ntile, tt_first, dil, LF, tokb, kcol, vcol, hw, q0, g, h, p; };
__device__ __forceinline__ UnitP decode_unit(int u) {
    UnitP P;
    if (u < 512) { const int qb = u & 63, g = (u >> 6) & 1, b = u >> 7;
        P.isA = 1; P.ntile = 5; P.q0 = qb * 64; P.tt_first = P.q0 - 128; P.dil = 1; P.LF = SEQ; P.tokb = b * SEQ; P.kcol = OFF_KA + g * 64; P.vcol = OFF_VA + g * 64; P.hw = 128; P.g = g; P.h = 0; P.p = 0; }
    else { const int v = u - 512, u16 = v & 15, p = (v >> 4) % 3, bh = v / 48, h = bh & 7, b = bh >> 3, sh = 2 * p, dil = 1 << sh, res = u16 & (dil - 1), qb = u16 >> sh;
        P.isA = 0; P.ntile = 6; P.q0 = 256 * qb; P.tt_first = P.q0 - 64; P.dil = dil; P.LF = SEQ >> sh; P.tokb = b * SEQ + res; P.kcol = OFF_KB + h * 64; P.vcol = OFF_VB + h * 64; P.hw = 64; P.g = 0; P.h = h; P.p = p; }
    return P;
}
__device__ __forceinline__ void issue_tiles(u32x4 (&kr)[6], u32x4 (&vr)[6], const UnitP& P, const h16* proj, int wid, int lane) {
#pragma unroll
    for (int j = 0; j < 6; ++j) { const int tt0 = P.tt_first + 64 * j; if (j < P.ntile && tt0 >= 0 && tt0 < P.LF) load_tile_regs(kr[j], vr[j], proj, P.tokb, P.dil, P.LF, tt0, P.kcol, P.vcol, wid, lane); }
}
__device__ __forceinline__ void write_tiles(LAS unsigned char* L, const u32x4 (&kr)[6], const u32x4 (&vr)[6], const UnitP& P, int wid, int lane) {
#pragma unroll
    for (int j = 0; j < 6; ++j) { const int tt0 = P.tt_first + 64 * j; if (j < P.ntile && tt0 >= 0 && tt0 < P.LF) {
        *(LAS u32x4*)(L + j * TILE_BYTES + wid * 1024 + lane * 16) = kr[j];
        *(LAS u32x4*)(L + j * TILE_BYTES + 8192 + wid * 1024 + lane * 16) = vr[j]; } }
}

__device__ __forceinline__ void attn_phase(Frame& F) {
    const int lane = F.lane, wid = F.wave, r32 = lane & 31, hi = lane >> 5;
    LAS unsigned char* L = F.lds;
    LAS float* wsf = (LAS float*)(L + WSF_OFF) + wid * 64;
    LAS h16* stg = (LAS h16*)(L + STG_OFF + wid * 4096);
    const h16* proj = (const h16*)(F.ws + WS_PROJ);
    int u = F.vcu;
    if (u >= 2048) return;
    UnitP P = decode_unit(u);
    u32x4 kr[6], vr[6];
    issue_tiles(kr, vr, P, proj, wid, lane);
    half8 qn[4];
#define ATT_QLOAD(PP) do { const int qw_ = (PP).isA ? (PP).q0 + 32 * (wid >> 2) : (PP).q0 + 32 * wid, qc_ = (PP).isA ? OFF_QA + (4 * (PP).g + (wid & 3)) * 64 : OFF_QB + (PP).h * 64; \
        const h16* qp_ = proj + (size_t)((PP).tokb + (qw_ + r32) * (PP).dil) * NIN + qc_ + hi * 8; _Pragma("unroll") for (int d0 = 0; d0 < 4; ++d0) qn[d0] = *(const half8*)(qp_ + d0 * 16); } while (0)
    ATT_QLOAD(P);
#pragma unroll 1
    for (; u < 2048; u += F.G) {
        TSEC_BEGIN(20);
        write_tiles(L, kr, vr, P, wid, lane);
        int head, tq, qcol, jb, je, qw0;
        if (P.isA) { head = 4 * P.g + (wid & 3); qw0 = P.q0 + 32 * (wid >> 2); qcol = OFF_QA + head * 64; jb = 0; je = 5; }
        else       { head = P.h; qw0 = P.q0 + 32 * wid; qcol = OFF_QB + head * 64; jb = wid >> 1; je = jb + 3; }
        tq = qw0 + r32; (void)qcol;
        half8 qr[4];
#pragma unroll
        for (int d0 = 0; d0 < 4; ++d0) qr[d0] = qn[d0];
        float m = P.isA ? F.a_sink[head] * LOG2E : 0.f, l = (P.isA && hi == 0) ? 1.0f : 0.0f;
        bool first = !P.isA;
        asm volatile("" ::: "memory");
        __syncthreads();
#pragma unroll
        for (int d0 = 0; d0 < 4; ++d0) asm volatile("" : "+v"(qr[d0]));
        TSEC_END(20);
        TSEC_BEGIN(21);
        const UnitP Pc = P;
        if (u + F.G < 2048) { P = decode_unit(u + F.G); issue_tiles(kr, vr, P, proj, wid, lane); ATT_QLOAD(P); }
        asm volatile("" ::: "memory");
        f32x16 o0, o1, negm;
#pragma unroll
        for (int r = 0; r < 16; ++r) { o0[r] = 0.f; o1[r] = 0.f; negm[r] = -m; }
        const int lo = (-Pc.hw > -tq) ? -Pc.hw : -tq, hi_ = (Pc.hw < Pc.LF - 1 - tq) ? Pc.hw : (Pc.LF - 1 - tq); const unsigned span = (unsigned)(hi_ - lo);
#pragma unroll 1
        for (int j = jb; j < je; ++j) {
            const int tt0 = Pc.tt_first + 64 * j; if (tt0 < 0 || tt0 >= Pc.LF) continue;
            int md[2];
#pragma unroll
            for (int h = 0; h < 2; ++h) { const int mn = tt0 + 32 * h - (qw0 + 31), mx = tt0 + 32 * h + 31 - qw0;
                md[h] = (mn > Pc.hw || mx < -Pc.hw) ? 0 : ((mn >= -Pc.hw && mx <= Pc.hw) ? 1 : 2); }
            if ((md[0] | md[1]) == 0) continue;
            tile_step(o0, o1, m, l, negm, first, qr, L + j * TILE_BYTES, L + j * TILE_BYTES + 8192, wsf, lane, r32, hi, md[0], md[1], tt0 + 4 * hi - tq, lo, span);
            first = false;
        }
        { auto rr = __builtin_amdgcn_permlane32_swap(__float_as_uint(l), __float_as_uint(l), false, false); l = __uint_as_float(rr[0]) + __uint_as_float(rr[1]); }
        TSEC_END(21);
        TSEC_BEGIN(22);
        if (Pc.isA) store_out(o0, o1, l, wsf, stg, (h16*)(F.ws + WS_OA) + head * 64, 512, Pc.tokb + qw0, 1, lane, r32, hi);
        else {
            if (hi == 0) ((float*)(F.ws + WS_LSE))[((size_t)Pc.p * M + Pc.tokb + tq * Pc.dil) * 8 + head] = (m + __builtin_amdgcn_logf(l)) * LN2;
            store_out(o0, o1, l, wsf, stg, (h16*)(F.ws + WS_OB) + (size_t)Pc.p * M * 512 + head * 64, 512, Pc.tokb + qw0 * Pc.dil, Pc.dil, lane, r32, hi);
        }
        __syncthreads();
        TSEC_END(22);
    }
}
}

__device__ __forceinline__ void p3_combine(Frame& F) {
    const int gw = F.vcu * NWAVES + F.wave, NGW = F.G * NWAVES, lane = F.lane;
    const h16* OA = (const h16*)(F.ws + WS_OA); const h16* OB = (const h16*)(F.ws + WS_OB); const float* LSE = (const float*)(F.ws + WS_LSE);
    h16* MX = (h16*)(F.ws + WS_MIXED);
    f32x4 ga[2], gb[2];
#pragma unroll
    for (int i = 0; i < 2; ++i) { ga[i] = *(const f32x4*)(F.g_out_a + 8 * lane + 4 * i); gb[i] = *(const f32x4*)(F.g_out_b + 8 * lane + 4 * i); }
    for (int t = gw; t < M; t += NGW) {
        const u32x4 ra = __builtin_nontemporal_load((const u32x4*)(OA + (size_t)t * 512 + 8 * lane));
        u32x4 rb[3]; float ls[3];
#pragma unroll
        for (int p = 0; p < 3; ++p) { rb[p] = __builtin_nontemporal_load((const u32x4*)(OB + ((size_t)p * M + t) * 512 + 8 * lane)); ls[p] = LSE[((size_t)p * M + t) * 8 + (lane >> 3)]; }
        float a[8], bsum[8];
#pragma unroll
        for (int i = 0; i < 4; ++i) { a[2 * i] = h2f((unsigned short)(ra[i] & 0xffffu)); a[2 * i + 1] = h2f((unsigned short)(ra[i] >> 16)); }
        const float mx = fmaxf(ls[0], fmaxf(ls[1], ls[2]));
        float w[3]; float ws_ = 0.f;
#pragma unroll
        for (int p = 0; p < 3; ++p) { w[p] = __expf(ls[p] - mx); ws_ += w[p]; }
        const float inv = 1.0f / ws_;
#pragma unroll
        for (int i = 0; i < 8; ++i) bsum[i] = 0.f;
#pragma unroll
        for (int p = 0; p < 3; ++p) { const float wp = w[p] * inv;
#pragma unroll
            for (int i = 0; i < 4; ++i) { bsum[2 * i] += wp * h2f((unsigned short)(rb[p][i] & 0xffffu)); bsum[2 * i + 1] += wp * h2f((unsigned short)(rb[p][i] >> 16)); } }
        float sa = 0.f, sb = 0.f;
#pragma unroll
        for (int i = 0; i < 8; ++i) { sa += a[i] * a[i]; sb += bsum[i] * bsum[i]; }
        const float rsa = 1.0f / sqrtf(wave_sum(sa) * (1.0f / 512.0f) + NORM_EPS), rsb = 1.0f / sqrtf(wave_sum(sb) * (1.0f / 512.0f) + NORM_EPS);
        u32x4 wa, wb;
#pragma unroll
        for (int i = 0; i < 4; ++i) { wa[i] = pk_h2(a[2 * i] * rsa * ga[i >> 1][(2 * i) & 3], a[2 * i + 1] * rsa * ga[i >> 1][(2 * i + 1) & 3]);
                                      wb[i] = pk_h2(bsum[2 * i] * rsb * gb[i >> 1][(2 * i) & 3], bsum[2 * i + 1] * rsb * gb[i >> 1][(2 * i + 1) & 3]); }
        *(u32x4*)(MX + (size_t)t * DM + 8 * lane) = wa;
        *(u32x4*)(MX + (size_t)t * DM + 512 + 8 * lane) = wb;
    }
}

__device__ __forceinline__ void p5_router(Frame& F) {
    const int gw = F.vcu * NWAVES + F.wave, NGW = F.G * NWAVES, lane = F.lane;
    LAS unsigned char* L = F.lds;
    for (int i = F.tid; i < DM * 4; i += NWAVES * 64) { const int k = i >> 2, c = i & 3; *(LAS f32x4*)(L + k * 64 + (k >> 2) * 16 + c * 16) = *(const f32x4*)(F.w_router + k * 16 + c * 4); }
    __syncthreads();
    const h16* X1 = (const h16*)(F.ws + WS_X1); unsigned char* H2 = F.ws + WS_H2; float* AFF = (float*)(F.ws + WS_AFF);
    f32x4 g[4];
#pragma unroll
    for (int j = 0; j < 4; ++j) g[j] = ((const f32x4*)F.g_ffn)[lane + 64 * j];
    u32x2 vn[4];
    if (gw < M) {
#pragma unroll
        for (int j = 0; j < 4; ++j) vn[j] = __builtin_nontemporal_load((const u32x2*)(X1 + (size_t)gw * DM) + lane + 64 * j);
    }
    LAS float* cscr = (LAS float*)(L + 69632 + F.wave * 8448);
    const float* const wg_ = F.w_gate; const float* const wu_ = F.w_up; const float* const wd_ = F.w_down; unsigned char* const ws_ = F.ws;
    const int JT = (int)((CV_TOTAL + (unsigned)NGW - 1u) / (unsigned)NGW), J1 = (F.G > BATCH * NE) ? JT - JT / 8 : JT;
    int cj = 0; bool cpendA = false, cpendB = false;
    ConvItem citA = conv8_decode(wg_, wu_, wd_, ws_, (unsigned)gw < CV_TOTAL ? (unsigned)gw : 0u), citB = citA; float cregA[32], cregB[32];
#define P5_PUMP1(PEND, ITEM, REG) do { __builtin_amdgcn_sched_barrier(0); if (PEND) conv8_finish(ITEM, REG, cscr, lane); __builtin_amdgcn_sched_barrier(0); \
        { const unsigned it_ = (unsigned)cj * (unsigned)NGW + (unsigned)gw; PEND = (cj < J1) && (it_ < CV_TOTAL); if (PEND) ITEM = conv8_decode(wg_, wu_, wd_, ws_, it_); ++cj; conv8_issue(ITEM, REG, lane); } __builtin_amdgcn_sched_barrier(0); } while (0)
#define P5_PUMP() do { if (cj & 1) P5_PUMP1(cpendB, citB, cregB); else P5_PUMP1(cpendA, citA, cregA); } while (0)
    P5_PUMP();
    P5_PUMP();
    for (int t = gw; t < M; t += NGW) {
        f32x4 v[4]; float s = 0.f;
#pragma unroll
        for (int j = 0; j < 4; ++j) { v[j].x = h2f((unsigned short)(vn[j].x & 0xffffu)); v[j].y = h2f((unsigned short)(vn[j].x >> 16)); v[j].z = h2f((unsigned short)(vn[j].y & 0xffffu)); v[j].w = h2f((unsigned short)(vn[j].y >> 16)); }
        if (t + NGW < M) {
#pragma unroll
            for (int j = 0; j < 4; ++j) vn[j] = __builtin_nontemporal_load((const u32x2*)(X1 + (size_t)(t + NGW) * DM) + lane + 64 * j);
        }
        P5_PUMP();
#pragma unroll
        for (int j = 0; j < 4; ++j) s += (v[j].x * v[j].x + v[j].y * v[j].y) + (v[j].z * v[j].z + v[j].w * v[j].w);
        const float rs = 1.0f / sqrtf(wave_sum(s) * (1.0f / DM) + NORM_EPS);
        unsigned* o4 = (unsigned*)(H2 + (size_t)t * DM) + lane;
        float acc[16];
#pragma unroll
        for (int e = 0; e < 16; ++e) acc[e] = 0.f;
#pragma unroll
        for (int j = 0; j < 4; ++j) {
            const f32x4 y = v[j] * rs * g[j];
            o4[64 * j] = pk_fp8x4(clamp8(y.x * S_H2), clamp8(y.y * S_H2), clamp8(y.z * S_H2), clamp8(y.w * S_H2));
#pragma unroll
            for (int c = 0; c < 4; ++c) {
                const int k = 256 * j + 4 * lane + c; LAS const f32x4* wr = (LAS const f32x4*)(L + k * 64 + (k >> 2) * 16);
#pragma unroll
                for (int q = 0; q < 4; ++q) { const f32x4 wv = wr[q];
#pragma unroll
                    for (int z = 0; z < 4; ++z) acc[4 * q + z] += y[c] * wv[z]; }
                if (c & 1) asm volatile("" ::: "memory");
            }
        }
        { const bool up = (lane & 32) != 0;
#pragma unroll
          for (int i = 0; i < 8; ++i) { const float send = up ? acc[i] : acc[i + 8], keep = up ? acc[i + 8] : acc[i]; acc[i] = keep + __shfl_xor(send, 32); } }
        { const bool up = (lane & 16) != 0;
#pragma unroll
          for (int i = 0; i < 4; ++i) { const float send = up ? acc[i] : acc[i + 4], keep = up ? acc[i + 4] : acc[i]; acc[i] = keep + __shfl_xor(send, 16); } }
        { const bool up = (lane & 8) != 0;
#pragma unroll
          for (int i = 0; i < 2; ++i) { const float send = up ? acc[i] : acc[i + 2], keep = up ? acc[i + 2] : acc[i]; acc[i] = keep + __shfl_xor(send, 8); } }
        float lg;
        { const bool up = (lane & 4) != 0; const float send = up ? acc[0] : acc[1], keep = up ? acc[1] : acc[0]; lg = keep + __shfl_xor(send, 4); }
        lg += __shfl_xor(lg, 2); lg += __shfl_xor(lg, 1);
        float mx = lg;
#pragma unroll
        for (int o = 4; o < 64; o <<= 1) mx = fmaxf(mx, __shfl_xor(mx, o));
        const float ex = __expf(lg - mx); float sm = ex;
#pragma unroll
        for (int o = 4; o < 64; o <<= 1) sm += __shfl_xor(sm, o);
        if ((lane & 3) == 0) { const int e = lane >> 2, b = t >> 12, sidx = t & (SEQ - 1); AFF[((size_t)(b * NE + e)) * SEQ + sidx] = ex / sm; }
        P5_PUMP();
    }
#pragma unroll 1
    while (cpendA || cpendB || cj < J1) P5_PUMP();
#undef P5_PUMP
#undef P5_PUMP1
}

__device__ __forceinline__ void p6_topk(Frame& F) {
    LAS unsigned* cnt = (LAS unsigned*)F.lds;
    const int tid = F.tid, lane = F.lane, wid = F.wave;
    const float* AFF = (const float*)(F.ws + WS_AFF);
    int* TOK = (int*)(F.ws + WS_TOK); float* GATE = (float*)(F.ws + WS_GATE); int* SLOT = (int*)(F.ws + WS_SLOT);
    for (int pair = F.vcu; pair < BATCH * NE; pair += F.G) {
        const int b = pair >> 4, e = pair & 15;
        const float* a = AFF + (size_t)pair * SEQ + 8 * tid;
        const f32x4 a0 = *(const f32x4*)a, a1 = *(const f32x4*)(a + 4);
        unsigned key[8];
#pragma unroll
        for (int j = 0; j < 4; ++j) { key[j] = __float_as_uint(a0[j]); key[4 + j] = __float_as_uint(a1[j]); }
        unsigned prefix = 0u;
        __syncthreads();
#pragma unroll 1
        for (int bit = 31; bit >= 0; --bit) {
            const unsigned cand = prefix | (1u << bit);
            unsigned c = 0;
#pragma unroll
            for (int j = 0; j < 8; ++j) c += (unsigned)__popcll(__ballot(key[j] >= cand));
            LAS unsigned* cc = cnt + ((bit & 1) ? 8 : 0);
            if (lane == 0) cc[wid] = c;
            __syncthreads();
            unsigned tot = 0;
#pragma unroll
            for (int w = 0; w < 8; ++w) tot += cc[w];
            if (tot >= (unsigned)CAP) prefix = cand;
        }
        unsigned cg = 0, ce = 0;
#pragma unroll
        for (int j = 0; j < 8; ++j) { cg += key[j] > prefix; ce += key[j] == prefix; }
        unsigned pk = (ce << 16) | cg, inc = pk;
#pragma unroll
        for (int o = 1; o < 64; o <<= 1) { const unsigned n = __shfl_up(inc, o); if (lane >= o) inc += n; }
        __syncthreads();
        LAS unsigned* ws_ = cnt + 16;
        if (lane == 63) ws_[wid] = inc;
        __syncthreads();
        unsigned base = 0, total = 0;
#pragma unroll
        for (int w = 0; w < 8; ++w) { const unsigned x = ws_[w]; if (w < wid) base += x; total += x; }
        const unsigned exc = base + inc - pk;
        unsigned gtb = exc & 0xffffu, eqb = exc >> 16;
        const unsigned need = (unsigned)CAP - (total & 0xffffu);
#pragma unroll
        for (int j = 0; j < 8; ++j) {
            const int sidx = 8 * tid + j; int slot = -1;
            if (key[j] > prefix) { slot = (int)(gtb + (eqb < need ? eqb : need)); ++gtb; }
            else if (key[j] == prefix) { if (eqb < need) slot = (int)(gtb + eqb); ++eqb; }
            SLOT[((size_t)(b * SEQ + sidx)) * NE + e] = slot;
            if (slot >= 0) { TOK[e * EROWS + b * CAP + slot] = b * SEQ + sidx; GATE[e * EROWS + b * CAP + slot] = __uint_as_float(key[j]); }
        }
        __syncthreads();
    }
}

__device__ __forceinline__ void p9_final(Frame& F) {
    const int gw = F.vcu * NWAVES + F.wave, NGW = F.G * NWAVES, lane = F.lane;
    const int* SLOT = (const int*)(F.ws + WS_SLOT); const unsigned char* YE = F.ws + WS_YE;
    f32x4 g[4];
#pragma unroll
    for (int j = 0; j < 4; ++j) g[j] = ((const f32x4*)F.g_final)[lane + 64 * j];
    int myslot = (gw < M) ? SLOT[(size_t)gw * NE + (lane & 15)] : -1;
    for (int t = gw; t < M; t += NGW) {
        f32x4* xr = (f32x4*)(F.out + (size_t)t * DM) + lane;
        const u32x2* xi = (const u32x2*)((const h16*)(F.ws + WS_X1) + (size_t)t * DM) + lane;
        f32x4 v[4];
#pragma unroll
        for (int j = 0; j < 4; ++j) { const u32x2 w = __builtin_nontemporal_load(xi + 64 * j); v[j].x = h2f((unsigned short)(w.x & 0xffffu)); v[j].y = h2f((unsigned short)(w.x >> 16)); v[j].z = h2f((unsigned short)(w.y & 0xffffu)); v[j].w = h2f((unsigned short)(w.y >> 16)); }
        const int slot_cur = myslot;
        const int tn = t + NGW;
        myslot = (tn < M) ? SLOT[(size_t)tn * NE + (lane & 15)] : -1;
        unsigned mask = (unsigned)(__ballot(slot_cur >= 0) & 0xffffull);
        const size_t ebase = (size_t)(t >> 12) * CAP;
        while (mask) {
            int e[4]; float w[4];
#pragma unroll
            for (int q = 0; q < 4; ++q) { const bool has = mask != 0u; e[q] = has ? (int)__builtin_ctz(mask) : e[0]; w[q] = has ? 1.f : 0.f; mask = has ? (mask & (mask - 1u)) : 0u; }
            unsigned y[4][4];
#pragma unroll
            for (int q = 0; q < 4; ++q) { const int sl = __builtin_amdgcn_readlane(slot_cur, e[q]);
                const unsigned* yr = (const unsigned*)(YE + ((size_t)e[q] * EROWS + ebase + sl) * DM) + lane;
#pragma unroll
                for (int j = 0; j < 4; ++j) y[q][j] = __builtin_nontemporal_load(yr + 64 * j); }
#pragma unroll
            for (int q = 0; q < 4; ++q) { const float wq = w[q] * (1.0f / S_YE);
#pragma unroll
                for (int j = 0; j < 4; ++j) { const auto lo2 = __builtin_amdgcn_cvt_pk_f32_fp8((int)y[q][j], false), hi2 = __builtin_amdgcn_cvt_pk_f32_fp8((int)y[q][j], true);
                    v[j].x += wq * lo2[0]; v[j].y += wq * lo2[1]; v[j].z += wq * hi2[0]; v[j].w += wq * hi2[1]; } }
        }
        float s = 0.f;
#pragma unroll
        for (int j = 0; j < 4; ++j) s += (v[j].x * v[j].x + v[j].y * v[j].y) + (v[j].z * v[j].z + v[j].w * v[j].w);
        const float rs = 1.0f / sqrtf(wave_sum(s) * (1.0f / DM) + NORM_EPS);
#pragma unroll
        for (int j = 0; j < 4; ++j) __builtin_nontemporal_store(v[j] * rs * g[j], xr + 64 * j);
    }
}

constexpr int NPHASE = 10;
struct Args { const float* in[13]; float* out; unsigned char* ws; int ph_lo, ph_hi, li, pad; };

__global__ void __launch_bounds__(NWAVES * 64, 2) mk_fwd(Args args) {
    extern __shared__ __attribute__((aligned(16))) unsigned char lds[];
    Frame F;
    F.lds = (LAS unsigned char*)lds;
    F.tid = threadIdx.x; F.lane = F.tid & 63; F.wave = __builtin_amdgcn_readfirstlane(F.tid >> 6);
    F.G = gridDim.x; { const int bx = blockIdx.x; F.vcu = (F.G % 8 == 0) ? (bx % 8) * (F.G / 8) + bx / 8 : bx; }
    F.x = args.in[0]; F.g_mix = args.in[1]; F.w_in = args.in[2]; F.a_sink = args.in[3]; F.g_out_a = args.in[4]; F.g_out_b = args.in[5]; F.w_out = args.in[6];
    F.g_ffn = args.in[7]; F.w_router = args.in[8]; F.w_gate = args.in[9]; F.w_up = args.in[10]; F.w_down = args.in[11]; F.g_final = args.in[12];
    F.out = args.out; F.ws = args.ws; F.tacc = 0;
    volatile LAS unsigned* MISC = (volatile LAS unsigned*)(F.lds + MISC_OFF);
    for (int u = F.tid; u < (LDS_BYTES - LDSCTL_OFF) / 4; u += NWAVES * 64) ((LAS unsigned*)(F.lds + LDSCTL_OFF))[u] = 0u;
    __syncthreads();
    const int lo = args.ph_lo, hi = args.ph_hi;
    const bool multi = (hi - lo) > 1;
    unsigned* barw = (unsigned*)(F.ws + WS_CTL) + CW_BAR + args.li * XCD_BAR_WORDS;
    XcdBarrier bar; bar.bar = barw; bar.x = 0; bar.st = nullptr;
    if (multi) bar = xcd_barrier_post(barw, MISC + 8);
#define IN(k) (((PH_MASK >> (k)) & 1) && lo <= (k) && (k) < hi)
#define SEAM(k) do { if (IN(k) && IN((k) + 1)) xcd_barrier(bar); } while (0)
#define TS0(k) do { if (TIME_PHASE == (k)) ts0_ = __builtin_amdgcn_s_memrealtime(); } while (0)
#define TS1(k) do { if (TIME_PHASE == (k)) ts1_ = __builtin_amdgcn_s_memrealtime(); } while (0)
    unsigned long long ts0_ = 0, ts1_ = 0;
#define REPS(k) for (int rep_ = 0; rep_ < 1 + ((REP_MASK >> (k)) & 1); ++rep_)

    TS0(0);
    if (IN(0)) REPS(0) { p0_prologue(F); SEAM(0); }
    TS1(0);
    TS0(1);
    if (IN(1)) {
        pg8::DenseProb P{(const char*)(F.ws + WS_H), (const char*)(F.ws + WS_WIN), DM * 2};
        pg8::DenseOrder S; S.init(M, NIN, F.G, (int)blockIdx.x, 1 + ((REP_MASK >> 1) & 1));
        pg8::EpiInProj E{(h16*)(F.ws + WS_PROJ), (const float*)(F.ws + WS_ROPE)};
        pg8::gemm_phase<pg8::DenseProb, pg8::EpiInProj, pg8::DenseOrder, true>(F.lds, P, S, E);
        SEAM(1);
    }
    TS1(1);
    TS0(2);
    if (IN(2)) REPS(2) { att::attn_phase(F); SEAM(2); }
    TS1(2);
    TS0(3);
    if (IN(3)) REPS(3) { p3_combine(F); SEAM(3); }
    TS1(3);
    TS0(4);
    if (IN(4)) {
        pg8::DenseProb P{(const char*)(F.ws + WS_MIXED), (const char*)(F.ws + WS_WOUT), DM * 2};
        pg8::DenseOrder S; S.init(M, DM, F.G, (int)blockIdx.x, 1 + ((REP_MASK >> 4) & 1));
        pg8::EpiResidual E{F.x, (h16*)(F.ws + WS_X1)};
        pg8::gemm_phase<pg8::DenseProb, pg8::EpiResidual, pg8::DenseOrder, true>(F.lds, P, S, E);
        SEAM(4);
    }
    TS1(4);
    TS0(5);
    if (IN(5)) REPS(5) { p5_router(F); SEAM(5); }
    TS1(5);
    TS0(6);
    if (IN(6)) REPS(6) {
        p6_topk(F);
        if (F.G > BATCH * NE && F.vcu >= BATCH * NE) {
            const int NGW_ = F.G * NWAVES, JT = (int)((CV_TOTAL + (unsigned)NGW_ - 1u) / (unsigned)NGW_), J1 = JT - JT / 8;
            const unsigned R0 = (unsigned)J1 * (unsigned)NGW_, NCW = (unsigned)(F.G - BATCH * NE) * NWAVES;
            for (unsigned it = R0 + (unsigned)(F.vcu - BATCH * NE) * NWAVES + (unsigned)F.wave; it < CV_TOTAL; it += NCW) conv8_one(F.w_gate, F.w_up, F.w_down, F.ws, it, (LAS float*)(F.lds + F.wave * 16384), F.lane);
        }
        SEAM(6); }
    TS1(6);
    TS0(7);
    if (IN(7)) {
        pg8::Moe1Prob P{(const char*)(F.ws + WS_H2), (const char*)(F.ws + WS_WGU), DM, (const int*)(F.ws + WS_TOK)};
        pg8::GroupOrder S; S.init(EROWS / 256, 4096 / 256, NE, F.G, F.vcu, 1 + ((REP_MASK >> 7) & 1));
        pg8::EpiSwiGLU E{F.ws + WS_HMID};
        pg8::gemm_phase<pg8::Moe1Prob, pg8::EpiSwiGLU, pg8::GroupOrder, true>(F.lds, P, S, E);
        SEAM(7);
    }
    TS1(7);
    TS0(8);
    if (IN(8)) {
        pg8::Moe2Prob P{(const char*)(F.ws + WS_HMID), (const char*)(F.ws + WS_WD), FF};
        pg8::GroupOrder S; S.init(EROWS / 256, DM / 256, NE, F.G, F.vcu, 1 + ((REP_MASK >> 8) & 1));
        pg8::EpiDown E{F.ws + WS_YE, (const float*)(F.ws + WS_GATE)};
        pg8::gemm_phase<pg8::Moe2Prob, pg8::EpiDown, pg8::GroupOrder, true>(F.lds, P, S, E);
        SEAM(8);
    }
    TS1(8);
    TS0(9);
    if (IN(9)) REPS(9) { p9_final(F); if (rep_ == 0 && ((REP_MASK >> 9) & 1)) xcd_barrier(bar); }
    TS1(9);
    if (TIME_PHASE >= 0 && blockIdx.x == 0 && F.tid == 0) { asm volatile("s_waitcnt vmcnt(0)" ::: "memory"); F.out[0] += (float)(TIME_PHASE >= 20 ? F.tacc : (ts1_ - ts0_)) * 0.01f * TIME_SCALE; }
#undef IN
#undef SEAM
}

extern "C" void kernel_launch(void* const* d_in, const int* in_sizes, int n_in, void* d_out, int out_size, void* d_ws, size_t ws_size, hipStream_t stream) {
    static int grid = 0;
    if (grid == 0) {
        if (n_in != 13 || in_sizes[0] != M * DM || out_size != M * DM || ws_size < WS_END) { fprintf(stderr, "kernel_launch: unexpected problem (n_in %d, ws %zu)\n", n_in, ws_size); grid = -1; return; }
        int dev = 0, cus = 0, per_cu = 0;
        if (hipGetDevice(&dev) != hipSuccess || hipDeviceGetAttribute(&cus, hipDeviceAttributeMultiprocessorCount, dev) != hipSuccess) { grid = -1; return; }
        if (hipFuncSetAttribute((const void*)mk_fwd, hipFuncAttributeMaxDynamicSharedMemorySize, LDS_BYTES) != hipSuccess) { fprintf(stderr, "kernel_launch: hipFuncSetAttribute failed\n"); grid = -1; return; }
        if (hipOccupancyMaxActiveBlocksPerMultiprocessor(&per_cu, (const void*)mk_fwd, NWAVES * 64, LDS_BYTES) != hipSuccess || per_cu < 1)
            fprintf(stderr, "kernel_launch: occupancy query reports %d blocks per CU\n", per_cu);
        (void)hipGetLastError();
        grid = cus;
    }
    if (grid < 0) return;
    (void)hipMemsetAsync((char*)d_ws + WS_CTL, 0, CTL_ZERO_BYTES, stream);
    Args a{};
    for (int i = 0; i < 13; ++i) a.in[i] = (const float*)d_in[i];
    a.out = (float*)d_out; a.ws = (unsigned char*)d_ws;
    if (MK_N_LAUNCHES == 1) {
        for (int pass = 0; pass < REP_ALL; ++pass) { a.ph_lo = 0; a.ph_hi = NPHASE; a.li = pass;
        hipLaunchKernelGGL(mk_fwd, dim3(grid), dim3(NWAVES * 64), LDS_BYTES, stream, a); }
    } else {
        for (int li = 0; li < NPHASE; ++li) { a.ph_lo = li; a.ph_hi = li + 1; a.li = 0;
            hipLaunchKernelGGL(mk_fwd, dim3(grid), dim3(NWAVES * 64), LDS_BYTES, stream, a); }
    }
}
```

```cpp
#include <hip/hip_runtime.h>
#include <cstdio>
#include <cstdint>

#ifndef MK_N_LAUNCHES
#define MK_N_LAUNCHES 1
#endif
#ifndef TIME_PHASE
#define TIME_PHASE -1
#endif
#ifndef TIME_SCALE
#define TIME_SCALE 1.0f
#endif
#ifndef PH_MASK
#define PH_MASK 0x3ff
#endif
#ifndef REP_ALL
#define REP_ALL 1
#endif
#ifndef REP_MASK
#define REP_MASK 0
#endif

#define LAS __attribute__((address_space(3)))
#define GAS __attribute__((address_space(1)))
typedef unsigned short h16;
typedef _Float16 half8 __attribute__((ext_vector_type(8)));
typedef _Float16 half2v __attribute__((ext_vector_type(2)));
typedef short s16x4 __attribute__((ext_vector_type(4)));
typedef float f32x4 __attribute__((ext_vector_type(4)));
typedef float f32x16 __attribute__((ext_vector_type(16)));
typedef unsigned u32x2 __attribute__((ext_vector_type(2)));
typedef unsigned u32x4 __attribute__((ext_vector_type(4)));
typedef GAS unsigned gu32;

constexpr int BATCH = 4, SEQ = 4096, DM = 1024, M = BATCH * SEQ;
constexpr int NIN = 2304;
constexpr int OFF_QA = 0, OFF_KA = 512, OFF_VA = 640, OFF_QB = 768, OFF_KB = 1280, OFF_VB = 1792;
constexpr int NE = 16, CAP = 512, FF = 2048, EROWS = BATCH * CAP;
constexpr float NORM_EPS = 1e-6f;
constexpr float LOG2E = 1.4426950408889634f, LN2 = 0.6931471805599453f;
constexpr float QSCALE = 0.18033688011112042f;
constexpr float S_H2 = 4.f, S_W = 32.f, S_HM = 2.f, S_YE = 16.f;

constexpr size_t MiB = 1u << 20;
constexpr size_t WS_CTL = 0, CTL_ZERO_BYTES = 64 * 1024;
constexpr size_t WS_ROPE = 1 * MiB;
constexpr size_t WS_AFF = 2 * MiB;
constexpr size_t WS_TOK = 3 * MiB;
constexpr size_t WS_GATE = 3 * MiB + 256 * 1024;
constexpr size_t WS_SLOT = 4 * MiB;
constexpr size_t WS_LSE = 5 * MiB;
constexpr size_t WS_WIN = 8 * MiB;
constexpr size_t WS_WOUT = 13 * MiB;
constexpr size_t WS_WGU = 16 * MiB;
constexpr size_t WS_WD = 144 * MiB;
constexpr size_t WS_H = 208 * MiB;
constexpr size_t WS_PROJ = 240 * MiB;
constexpr size_t WS_OA = 312 * MiB;
constexpr size_t WS_OB = 328 * MiB;
constexpr size_t WS_HMID = 208 * MiB;
constexpr size_t WS_MIXED = 376 * MiB;
constexpr size_t WS_H2 = 408 * MiB;
constexpr size_t WS_YE = 376 * MiB;
constexpr size_t WS_X1 = 440 * MiB;
constexpr size_t WS_END = 504 * MiB;
constexpr int CW_CONV = 64, CW_P1DONE = 128;
constexpr int CW_BAR = 1024;

constexpr int RING_BYTES = 131072;
constexpr int LDSCTL_OFF = 143360, MISC_OFF = LDSCTL_OFF + 320;
constexpr int LDS_BYTES = 147456;
constexpr int NWAVES = 8;

#define RLX_AGENT __ATOMIC_RELAXED, __HIP_MEMORY_SCOPE_AGENT
#define LDS_WAIT() asm volatile("s_waitcnt lgkmcnt(0)" ::: "memory")
#define VM_WAIT() asm volatile("s_waitcnt vmcnt(0)" ::: "memory")

__device__ __forceinline__ unsigned pk_h2(float lo, float hi) { half2v v = {(_Float16)lo, (_Float16)hi}; return __builtin_bit_cast(unsigned, v); }
__device__ __forceinline__ unsigned pk_h2_rtz(float lo, float hi) { return __builtin_bit_cast(unsigned, __builtin_amdgcn_cvt_pkrtz(lo, hi)); }
__device__ __forceinline__ unsigned pk_fp8x4(float a, float b, float c, float d) {
    int w = __builtin_amdgcn_cvt_pk_fp8_f32(a, b, 0, false); w = __builtin_amdgcn_cvt_pk_fp8_f32(c, d, w, true); return (unsigned)w; }
__device__ __forceinline__ float clamp8(float x) { return fminf(fmaxf(x, -448.f), 448.f); }
__device__ __forceinline__ float h2f(unsigned short b) { return (float)__builtin_bit_cast(_Float16, b); }
__device__ __forceinline__ float wave_sum(float v) {
#pragma unroll
    for (int o = 1; o < 64; o <<= 1) v += __shfl_xor(v, o);
    return v;
}


constexpr unsigned CV_PER = (DM / 64) * (FF / 32);
constexpr unsigned CV_TOTAL = (unsigned)NE * 3u * CV_PER;
struct ConvItem { const float* W; unsigned char* D; int N, K; };
__device__ __forceinline__ ConvItem conv8_decode(const float* wg, const float* wu, const float* wd, unsigned char* ws, unsigned it) {
    ConvItem c;
    if (it < (unsigned)NE * 2u * CV_PER) {
        const unsigned e = it / (2u * CV_PER); unsigned r = it - e * 2u * CV_PER; const unsigned which = r / CV_PER; r -= which * CV_PER;
        const int kb = (int)(r / (FF / 32)), n0 = 32 * (int)(r % (FF / 32));
        c.N = FF; c.K = DM; c.W = (which ? wu : wg) + (size_t)e * DM * FF + (size_t)(64 * kb) * FF + n0;
        c.D = ws + WS_WGU + ((size_t)e * 4096 + (size_t)((n0 >> 7) * 256 + (int)which * 128 + (n0 & 127))) * DM + 64 * kb;
    } else {
        const unsigned r0 = it - (unsigned)NE * 2u * CV_PER, e = r0 / CV_PER, r = r0 - e * CV_PER;
        const int kb = (int)(r / (DM / 32)), n0 = 32 * (int)(r % (DM / 32));
        c.N = DM; c.K = FF; c.W = wd + (size_t)e * FF * DM + (size_t)(64 * kb) * DM + n0;
        c.D = ws + WS_WD + ((size_t)e * DM + n0) * FF + 64 * kb;
    }
    return c;
}
__device__ __forceinline__ void conv8_issue(const ConvItem& c, float (&r)[32], int lane) {
#pragma unroll
    for (int i = 0; i < 32; ++i) r[i] = __builtin_nontemporal_load(c.W + (size_t)(2 * i + (lane >> 5)) * c.N + (lane & 31));
}
__device__ __forceinline__ void conv8_finish(const ConvItem& c, const float (&r)[32], LAS float* scr, int lane) {
#pragma unroll
    for (int i = 0; i < 32; ++i) scr[(2 * i + (lane >> 5)) * 33 + (lane & 31)] = r[i];
    LDS_WAIT(); asm volatile("" ::: "memory");
    const int n = lane >> 1, kh = (lane & 1) * 32; const LAS float* s = scr + kh * 33 + n;
    u32x4 o0, o1;
#pragma unroll
    for (int q = 0; q < 4; ++q) {
        o0[q] = pk_fp8x4(s[(4 * q) * 33] * S_W, s[(4 * q + 1) * 33] * S_W, s[(4 * q + 2) * 33] * S_W, s[(4 * q + 3) * 33] * S_W);
        o1[q] = pk_fp8x4(s[(16 + 4 * q) * 33] * S_W, s[(17 + 4 * q) * 33] * S_W, s[(18 + 4 * q) * 33] * S_W, s[(19 + 4 * q) * 33] * S_W); }
    unsigned char* d = c.D + (size_t)n * c.K + kh;
    *(GAS u32x4*)d = o0; *(GAS u32x4*)(d + 16) = o1;
    LDS_WAIT(); asm volatile("" ::: "memory");
}
__device__ __forceinline__ void conv8_one(const float* wg, const float* wu, const float* wd, unsigned char* ws, unsigned it, LAS float* scr, int lane) {
    const ConvItem c = conv8_decode(wg, wu, wd, ws, it); float r[32]; conv8_issue(c, r, lane); conv8_finish(c, r, scr, lane);
}
constexpr unsigned CV_BATCH = 64;
__device__ __forceinline__ void conv8_dynamic(const float* wg, const float* wu, const float* wd, unsigned char* ws, unsigned* ctr, unsigned* done_ctr, unsigned until_done,
                                              LAS float* scr, volatile LAS unsigned* sh, int tid, int wave, int lane) {
    for (;;) {
        if (tid == 0) { sh[0] = __hip_atomic_fetch_add(ctr, CV_BATCH, __ATOMIC_RELAXED, __HIP_MEMORY_SCOPE_AGENT);
                        sh[1] = until_done ? __hip_atomic_load(done_ctr, __ATOMIC_RELAXED, __HIP_MEMORY_SCOPE_AGENT) : 0u; }
        __syncthreads();
        const unsigned b0 = sh[0]; const bool stop = until_done && sh[1] >= until_done;
        __syncthreads();
        if (b0 >= CV_TOTAL) break;
#pragma unroll 1
        for (unsigned q = 0; q < CV_BATCH / 8; ++q) { const unsigned it = b0 + (unsigned)wave * (CV_BATCH / 8) + q; if (it < CV_TOTAL) conv8_one(wg, wu, wd, ws, it, scr, lane); }
        if (stop) break;
    }
}
struct NoSide { static constexpr bool ON = false; };

namespace pg8 {
constexpr int BM = 256, BK = 64, HALF = 128, HTB = HALF * BK * 2, STAGE_BYTES = 8 * HTB, NXCD = 8, WGM = 8;
__host__ __device__ __forceinline__ int lds_byte(int r, int c) { const int st = (r >> 4) * 2 + (c >> 5), rr = r & 15, cc = c & 31, ob = rr * 64 + cc * 2; return st * 1024 + (ob ^ (((ob >> 9) & 1) << 5)); }
__host__ __device__ __forceinline__ void stage_rc(int b, int& R, int& C) { const int st = b / 1024, sb = b % 1024, swz = sb ^ (((sb >> 9) & 1) << 5); R = (st >> 1) * 16 + swz / 64; C = (st & 1) * 32 + (swz % 64) / 2; }
__host__ __device__ __forceinline__ int perm32(int rho) { const int n = rho >> 4, i = rho & 15; return 8 * (i >> 2) + 4 * n + (i & 3); }

struct Unit { int pm, pn, g; };

struct DenseOrder {
    int nM, nN, nwg, G, c, reps;
    __device__ void init(int M_, int N_, int G_, int c_, int reps_ = 1) { nM = M_ / BM; nN = N_ / BM; nwg = nM * nN; G = G_; c = c_; reps = reps_; }
    __device__ bool next(int i, Unit& u) const {
        const int mine = (nwg - c + G - 1) / G; if (mine <= 0 || i >= mine * reps) return false; i %= mine;
        const long L = (long)i * G + c;
        int wgid = (int)L; { const int q = nwg / NXCD, r = nwg % NXCD, xcd = wgid % NXCD, off = wgid / NXCD; wgid = (xcd < r ? xcd * (q + 1) : r * (q + 1) + (xcd - r) * q) + off; }
        const int nig = WGM * nN, gid = wgid / nig, fm = gid * WGM, gsz = (nM - fm) < WGM ? (nM - fm) : WGM;
        u.pm = fm + ((wgid % nig) % gsz); u.pn = (wgid % nig) / gsz; u.g = 0; return true;
    }
};
struct GroupOrder {
    int nPM, nPN, total, G, c, reps;
    __device__ void init(int nPM_, int nPN_, int groups, int G_, int c_, int reps_ = 1) { nPM = nPM_; nPN = nPN_; total = nPM_ * nPN_ * groups; G = G_; c = c_; reps = reps_; }
    __device__ bool next(int i, Unit& u) const {
        const int mine = (total - c + G - 1) / G; if (mine <= 0 || i >= mine * reps) return false; i %= mine;
        const int L = i * G + c;
        const int per = nPM * nPN; u.g = L / per; const int rem = L % per; u.pn = rem / nPM; u.pm = rem % nPM; return true;
    }
};

struct DenseProb {
    static constexpr bool BKN = false, FP8 = false;
    const char* A; const char* Bt; int KB;
    __device__ __forceinline__ unsigned a_row(const Unit& u, int r) const { return (unsigned)(u.pm * BM + r); }
    __device__ __forceinline__ const char* b_base(const Unit& u, int half) const { return Bt + ((size_t)u.pn * BM + (size_t)half * HALF) * KB; }
    __device__ __forceinline__ size_t b_kstep() const { return (size_t)BK * 2; }
    __device__ __forceinline__ unsigned b_pitch() const { return (unsigned)KB; }
};
struct Moe1Prob {
    static constexpr bool BKN = false, FP8 = true;
    const char* A; const char* Bt; int KB; const int* tok;
    __device__ __forceinline__ unsigned a_row(const Unit& u, int r) const { return (unsigned)tok[u.g * EROWS + u.pm * BM + r]; }
    __device__ __forceinline__ const char* b_base(const Unit& u, int half) const { return Bt + ((size_t)u.g * 4096 + (size_t)u.pn * BM + (size_t)half * HALF) * KB; }
    __device__ __forceinline__ size_t b_kstep() const { return (size_t)BK * 2; }
    __device__ __forceinline__ unsigned b_pitch() const { return (unsigned)KB; }
};
struct Moe2Prob {
    static constexpr bool BKN = false, FP8 = true;
    const char* A; const char* Bt; int KB;
    __device__ __forceinline__ unsigned a_row(const Unit& u, int r) const { return (unsigned)(u.g * EROWS + u.pm * BM + r); }
    __device__ __forceinline__ const char* b_base(const Unit& u, int half) const { return Bt + ((size_t)u.g * DM + (size_t)u.pn * BM + (size_t)half * HALF) * KB; }
    __device__ __forceinline__ size_t b_kstep() const { return (size_t)BK * 2; }
    __device__ __forceinline__ unsigned b_pitch() const { return (unsigned)KB; }
};

struct EpiInProj {
    static constexpr bool PERM = true;
    h16* O; const float* rope;
    __device__ __forceinline__ void operator()(const f32x4 (&acc)[2][2][4][2], const Unit& u, int wr, int wc, int fr, int fq) const {
        const int row0 = u.pm * BM + wr * 64 + fr;
        const int ct0 = u.pn * BM;
        const bool rt0 = (ct0 < OFF_VA) || (ct0 >= OFF_QB && ct0 < OFF_VB), rt1 = (ct0 + HALF < OFF_VA) || (ct0 + HALF >= OFF_QB && ct0 + HALF < OFF_VB);
        const bool any_rope = (rt0 || rt1) && ((wc & 1) == 0);
        float c[8], s[8];
        if (any_rope) { const float* rp = rope + (size_t)(row0 & (SEQ - 1)) * 16;
            const f32x4 c0 = *(const f32x4*)(rp), c1 = *(const f32x4*)(rp + 4), s0 = *(const f32x4*)(rp + 8), s1 = *(const f32x4*)(rp + 12);
#pragma unroll
            for (int j = 0; j < 4; ++j) { c[j] = c0[j]; c[4 + j] = c1[j]; s[j] = s0[j]; s[4 + j] = s1[j]; } }
        else {
#pragma unroll
            for (int j = 0; j < 8; ++j) { c[j] = 1.f; s[j] = 0.f; } }
        const float cd16[8] = {-9.576594803e-01f, -9.992462593e-01f, 8.243765146e-01f, 9.932003012e-01f, 9.997440109e-01f, 9.999903729e-01f, 9.999996380e-01f, 9.999999864e-01f};
        const float sd16[8] = {-2.879033167e-01f, 3.881898152e-02f, 5.660418378e-01f, 1.164180468e-01f, 2.262548617e-02f, 4.387956730e-03f, 8.509272408e-04f, 1.650141653e-04f};
        const float cd80[8] = {-1.103872438e-01f, -9.812132344e-01f, -9.911539132e-01f, 8.345872775e-01f, 9.936068238e-01f, 9.997593311e-01f, 9.999909490e-01f, 9.999996596e-01f};
        const float sd80[8] = {-9.938886539e-01f, 1.929263812e-01f, 1.327174458e-01f, 5.508757358e-01f, 1.128958803e-01f, 2.193809395e-02f, 4.254623881e-03f, 8.250707366e-04f};
        const float sg = (fq == 0) ? -1.f : 1.f;
#pragma unroll
        for (int ai = 0; ai < 2; ++ai)
#pragma unroll
            for (int m = 0; m < 4; ++m) {
                const int row = row0 + ai * HALF + m * 16;
                if (any_rope && (ai | m) != 0) {
#pragma unroll
                    for (int j = 0; j < 8; ++j) { const float cdv = (m == 0) ? cd80[j] : cd16[j], sdv = (m == 0) ? sd80[j] : sd16[j];
                        const float cn = c[j] * cdv - s[j] * sdv, sn = s[j] * cdv + c[j] * sdv; c[j] = cn; s[j] = sn; }
                }
#pragma unroll
                for (int bj = 0; bj < 2; ++bj) {
                    const bool do_rope = (bj ? rt1 : rt0) && ((wc & 1) == 0);
                    const int col0 = ct0 + bj * HALF + wc * 32 + 8 * fq;
                    f32x4 v0 = acc[ai][bj][m][0], v1 = acc[ai][bj][m][1];
                    if (do_rope) {
                        f32x4 p0, p1;
#pragma unroll
                        for (int j = 0; j < 4; ++j) { p0[j] = __shfl_xor(v0[j], 16); p1[j] = __shfl_xor(v1[j], 16); }
                        if (fq < 2) {
#pragma unroll
                            for (int j = 0; j < 4; ++j) { v0[j] = v0[j] * c[j] + (p0[j] * s[j]) * sg; v1[j] = v1[j] * c[4 + j] + (p1[j] * s[4 + j]) * sg; } }
                    }
                    u32x4 w; w.x = pk_h2(v0[0], v0[1]); w.y = pk_h2(v0[2], v0[3]); w.z = pk_h2(v1[0], v1[1]); w.w = pk_h2(v1[2], v1[3]);
                    *(u32x4*)(O + (size_t)row * NIN + col0) = w;
                }
            }
    }
};
struct EpiResidual {
    static constexpr bool PERM = true;
    const float* base; h16* out;
    __device__ __forceinline__ void operator()(const f32x4 (&acc)[2][2][4][2], const Unit& u, int wr, int wc, int fr, int fq) const {
        const int row0 = u.pm * BM + wr * 64 + fr, col0 = u.pn * BM + wc * 32 + 8 * fq;
#pragma unroll
        for (int ai = 0; ai < 2; ++ai) {
            f32x4 xb[4][2][2];
#pragma unroll
            for (int m = 0; m < 4; ++m) { const size_t off = (size_t)(row0 + ai * HALF + m * 16) * DM + col0;
#pragma unroll
                for (int bj = 0; bj < 2; ++bj) { xb[m][bj][0] = __builtin_nontemporal_load((const f32x4*)(base + off + bj * HALF)); xb[m][bj][1] = __builtin_nontemporal_load((const f32x4*)(base + off + bj * HALF + 4)); } }
#pragma unroll
            for (int m = 0; m < 4; ++m) { const size_t off = (size_t)(row0 + ai * HALF + m * 16) * DM + col0;
#pragma unroll
                for (int bj = 0; bj < 2; ++bj) { const f32x4 v0 = xb[m][bj][0] + acc[ai][bj][m][0], v1 = xb[m][bj][1] + acc[ai][bj][m][1];
                    u32x4 w; w.x = pk_h2(v0[0], v0[1]); w.y = pk_h2(v0[2], v0[3]); w.z = pk_h2(v1[0], v1[1]); w.w = pk_h2(v1[2], v1[3]);
                    *(u32x4*)(out + off + bj * HALF) = w; } }
            asm volatile("" ::: "memory");
        }
    }
};
struct EpiSwiGLU {
    static constexpr bool PERM = true;
    unsigned char* O;
    __device__ __forceinline__ void operator()(const f32x4 (&acc)[2][2][4][2], const Unit& u, int wr, int wc, int fr, int fq) const {
        const int row0 = u.g * EROWS + u.pm * BM + wr * 64 + fr, col0 = u.pn * HALF + wc * 32 + 8 * fq;
        constexpr float IS = 1.0f / (S_H2 * S_W);
#pragma unroll
        for (int ai = 0; ai < 2; ++ai)
#pragma unroll
            for (int m = 0; m < 4; ++m) {
                float r[8];
#pragma unroll
                for (int n = 0; n < 2; ++n)
#pragma unroll
                    for (int j = 0; j < 4; ++j) { const float a = acc[ai][0][m][n][j] * IS, up = acc[ai][1][m][n][j] * (IS * S_HM);
                        r[n * 4 + j] = clamp8(a * __builtin_amdgcn_rcpf(1.0f + __builtin_amdgcn_exp2f(-a * LOG2E)) * up); }
                u32x2 w; w.x = pk_fp8x4(r[0], r[1], r[2], r[3]); w.y = pk_fp8x4(r[4], r[5], r[6], r[7]);
                *(u32x2*)(O + (size_t)(row0 + ai * HALF + m * 16) * FF + col0) = w;
            }
    }
};
struct EpiDown {
    static constexpr bool PERM = true;
    unsigned char* O; const float* gate;
    __device__ __forceinline__ void operator()(const f32x4 (&acc)[2][2][4][2], const Unit& u, int wr, int wc, int fr, int fq) const {
        const int row0 = u.g * EROWS + u.pm * BM + wr * 64 + fr, col0 = u.pn * BM + wc * 32 + 8 * fq;
        float gts[2][4];
#pragma unroll
        for (int ai = 0; ai < 2; ++ai)
#pragma unroll
            for (int m = 0; m < 4; ++m) gts[ai][m] = gate[row0 + ai * HALF + m * 16];
#pragma unroll
        for (int ai = 0; ai < 2; ++ai)
#pragma unroll
            for (int m = 0; m < 4; ++m) {
                const int row = row0 + ai * HALF + m * 16; const float gt = gts[ai][m] * (S_YE / (S_HM * S_W));
#pragma unroll
                for (int bj = 0; bj < 2; ++bj) { const f32x4 v0 = acc[ai][bj][m][0] * gt, v1 = acc[ai][bj][m][1] * gt;
                    u32x2 w; w.x = pk_fp8x4(clamp8(v0[0]), clamp8(v0[1]), clamp8(v0[2]), clamp8(v0[3])); w.y = pk_fp8x4(clamp8(v1[0]), clamp8(v1[1]), clamp8(v1[2]), clamp8(v1[3]));
                    *(u32x2*)(O + (size_t)row * DM + col0 + bj * HALF) = w; }
            }
    }
};

template <class Prob, class Epi, class Sched, bool ALIGN_EPI, class Side = NoSide>
__device__ __forceinline__ void gemm_phase(LAS unsigned char* lds, const Prob P, const Sched& S, const Epi& E, const Side SD = Side()) {
    const int tid = threadIdx.x, wid = __builtin_amdgcn_readfirstlane(tid >> 6), lane = tid & 63, wr = wid >> 2, wc = wid & 3, fr = lane & 15, fq = lane >> 4;
    const int KB = P.KB, nt = KB / 128;
    int RA[2]; unsigned CA2[2], voffB[2];
#pragma unroll
    for (int i = 0; i < 2; ++i) { int R, C; stage_rc(tid * 16 + i * 8192, R, C); const int Rb = Epi::PERM ? ((R & ~31) + perm32(R & 31)) : R;
        RA[i] = R; CA2[i] = (unsigned)C * 2u;
        if constexpr (Prob::BKN) {
            static_assert(Epi::PERM, "the [K][N] B path is written for PERM epilogues");
            const int r = 4 * wid + 32 * i + (lane >> 4), g = (r & 3) | (((r >> 3) & 1) << 2), c = (lane & 15) ^ (g << 1);
            voffB[i] = (unsigned)r * P.b_pitch() + (unsigned)c * 16u;
        } else voffB[i] = (unsigned)(Rb * KB) + (unsigned)C * 2u; }
    const unsigned kstep = (unsigned)(BK * 2);
    const size_t kstepB = P.b_kstep();
    int btr[2];
    { const int q = fr >> 2, p = fr & 3, X = ((q | ((fq & 1) << 2)) << 2) | (q & 1);
#pragma unroll
      for (int n = 0; n < 2; ++n) btr[n] = (8 * fq + q) * 256 + (((8 * wc + 2 * p + n) ^ X) * 8); }
    const unsigned lds_u32 = (unsigned)(__UINTPTR_TYPE__)lds;
    unsigned bta[2]; bta[0] = lds_u32 + (unsigned)btr[0]; bta[1] = lds_u32 + (unsigned)btr[1];
    const unsigned rowb = (unsigned)KB;
    const unsigned ldsw = (unsigned)wid * 1024u;
    const int aoff = lds_byte(wr * 64 + fr, fq * 8), boff = lds_byte(wc * 32 + fr, fq * 8);
#define PG8_SA(b, h) (((b) * 2 + (h)) * HTB)
#define PG8_SB(b, h) ((4 + (b) * 2 + (h)) * HTB)
#define PG8_STAGE_B(bufoff, gbase) do { _Pragma("unroll") for (int _i = 0; _i < 2; ++_i) \
        __builtin_amdgcn_global_load_lds((const unsigned*)((const char*)(gbase) + voffB[_i]), (LAS unsigned*)(lds + (bufoff) + ldsw + _i * 8192), 16, 0, 0); } while (0)
#define PG8_STAGE_A(bufoff, kb, offs) do { _Pragma("unroll") for (int _i = 0; _i < 2; ++_i) \
        __builtin_amdgcn_global_load_lds((const unsigned*)(P.A + (size_t)(kb) + (offs)[_i]), (LAS unsigned*)(lds + (bufoff) + ldsw + _i * 8192), 16, 0, 0); } while (0)
#define PG8_LDA(dst, b, h) do { if constexpr (Prob::FP8) { _Pragma("unroll") for (int m = 0; m < 4; ++m) { dst##8[m].lo = *(const LAS v4i_*)(lds + PG8_SA(b, h) + aoff + m * 2048); dst##8[m].hi = *(const LAS v4i_*)(lds + PG8_SA(b, h) + aoff + m * 2048 + 1024); } } \
        else { _Pragma("unroll") for (int m = 0; m < 4; ++m) _Pragma("unroll") for (int k = 0; k < 2; ++k) dst[m][k] = *(const LAS half8*)(lds + PG8_SA(b, h) + aoff + m * 2048 + k * 1024); } } while (0)
#define PG8_LDB(dst, b, h) do { if constexpr (Prob::BKN) { _Pragma("unroll") for (int n = 0; n < 2; ++n) { const unsigned ad_ = bta[n] + (unsigned)PG8_SB(b, h); _Pragma("unroll") for (int k = 0; k < 2; ++k) { \
            asm volatile("ds_read_b64_tr_b16 %0, %1 offset:%c2" : "=&v"(dst##lo[n][k]) : "v"(ad_), "i"(k * 8192) : "memory"); \
            asm volatile("ds_read_b64_tr_b16 %0, %1 offset:%c2" : "=&v"(dst##hi[n][k]) : "v"(ad_), "i"(k * 8192 + 1024) : "memory"); } } } \
        else if constexpr (Prob::FP8) { _Pragma("unroll") for (int n = 0; n < 2; ++n) { dst##8[n].lo = *(const LAS v4i_*)(lds + PG8_SB(b, h) + boff + n * 2048); dst##8[n].hi = *(const LAS v4i_*)(lds + PG8_SB(b, h) + boff + n * 2048 + 1024); } } \
        else { _Pragma("unroll") for (int n = 0; n < 2; ++n) _Pragma("unroll") for (int k = 0; k < 2; ++k) dst[n][k] = *(const LAS half8*)(lds + PG8_SB(b, h) + boff + n * 2048 + k * 1024); } } while (0)
#define PG8_BFIX(dst) do { if constexpr (Prob::BKN) { typedef short s16x8_ __attribute__((ext_vector_type(8))); _Pragma("unroll") for (int n = 0; n < 2; ++n) _Pragma("unroll") for (int k = 0; k < 2; ++k) { \
            const s16x8_ v_ = __builtin_shufflevector(dst##lo[n][k], dst##hi[n][k], 0, 1, 2, 3, 4, 5, 6, 7); dst[n][k] = __builtin_bit_cast(half8, v_); } } } while (0)
#define PG8_MMA(ai, bj, At, Bt) do { __builtin_amdgcn_s_setprio(1); _Pragma("unroll") for (int m = 0; m < 4; ++m) _Pragma("unroll") for (int n = 0; n < 2; ++n) { \
        if constexpr (Prob::FP8) asm volatile("v_mfma_f32_16x16x128_f8f6f4 %0, %1, %2, %0" : "+v"(acc[ai][bj][m][n]) : "v"(Bt##8[n]), "v"(At##8[m])); \
        else { _Pragma("unroll") for (int k = 0; k < 2; ++k) acc[ai][bj][m][n] = __builtin_amdgcn_mfma_f32_16x16x32_f16(Bt[n][k], At[m][k], acc[ai][bj][m][n], 0, 0, 0); } } \
        __builtin_amdgcn_s_setprio(0); } while (0)
#define PG8_WAIT_V(n) asm volatile("s_waitcnt vmcnt(" #n ")" ::: "memory")
#define PG8_WAIT_L(n) asm volatile("s_waitcnt lgkmcnt(" #n ")" ::: "memory")
#define PG8_BAR __builtin_amdgcn_s_barrier()
#define PG8_SCHED __builtin_amdgcn_sched_barrier(0)
#define PG8_SIDE_ISSUE(slot) do { if constexpr (Side::ON) { sfly = SD.L->pending() && (((slot) % SD.every) == 0); \
        if (sfly) { scc = SD.L->chunk(SD.L->done); const float* sp_ = SD.L->src_of(SD.L->wa, SD.L->wb, scc); \
            asm volatile("global_load_dwordx4 %0, %2, off\n\tglobal_load_dwordx4 %1, %2, off offset:16" : "=&v"(sr0), "=&v"(sr1) : "v"(sp_) : "memory"); } } } while (0)
#define PG8_SIDE_FINISH() do { if constexpr (Side::ON) { if (sfly) { asm volatile("" : "+v"(sr0), "+v"(sr1)); SD.L->store(SD.L->da, scc, sr0, sr1); SD.L->done += 1; } PG8_SCHED; } } while (0)
#define PG8_WAIT_VS(extra) do { if constexpr (Side::ON) { if (sfly) { if ((extra) == 2) PG8_WAIT_V(10); else PG8_WAIT_V(9); } else PG8_WAIT_V(8); } else PG8_WAIT_V(8); } while (0)
#define PG8_AOFF(dst, un) do { _Pragma("unroll") for (int _h = 0; _h < 2; ++_h) _Pragma("unroll") for (int _i = 0; _i < 2; ++_i) dst[_h][_i] = P.a_row(un, _h * HALF + RA[_i]) * rowb + CA2[_i]; } while (0)
    Unit cur, nxt; int ui = 0;
    if (!S.next(0, cur)) return;
    bool sfly = false; f32x4 sr0, sr1; unsigned scc = 0;
    f32x4 acc[2][2][4][2];
#pragma unroll
    for (int a = 0; a < 2; ++a)
#pragma unroll
        for (int b = 0; b < 2; ++b)
#pragma unroll
            for (int m = 0; m < 4; ++m)
#pragma unroll
                for (int n = 0; n < 2; ++n) acc[a][b][m][n] = (f32x4){0.f, 0.f, 0.f, 0.f};
    typedef int v4i_ __attribute__((ext_vector_type(4))); typedef int v8i_ __attribute__((ext_vector_type(8)));
    half8 At[4][2], B0[2][2], B1[2][2];
    s16x4 B0lo[2][2], B0hi[2][2], B1lo[2][2], B1hi[2][2];
    v8i_ At8[4], B08[2], B18[2];
    unsigned cuo[2][2], nxo[2][2];
    PG8_AOFF(cuo, cur);
    const char* cB0 = P.b_base(cur, 0); const char* cB1 = P.b_base(cur, 1);
    PG8_STAGE_B(PG8_SB(0, 0), cB0); PG8_STAGE_B(PG8_SB(0, 1), cB1); PG8_STAGE_A(PG8_SA(0, 0), 0, cuo[0]); PG8_STAGE_A(PG8_SA(0, 1), 0, cuo[1]);
    if (wr == 1) PG8_BAR;
    PG8_WAIT_V(2); PG8_BAR;
    PG8_STAGE_B(PG8_SB(1, 0), cB0 + kstepB); PG8_STAGE_A(PG8_SA(1, 0), kstep, cuo[0]); PG8_STAGE_B(PG8_SB(1, 1), cB1 + kstepB);
    PG8_WAIT_V(6); PG8_BAR;
    for (;;) {
        const bool has_next = S.next(ui + 1, nxt);
        if (!has_next) nxt = cur;
        PG8_AOFF(nxo, nxt);
        const char* nB0 = P.b_base(nxt, 0); const char* nB1 = P.b_base(nxt, 1);
        for (int t = 0; t < nt; t += 2) {
            const bool last = (t == nt - 2);
            const unsigned k1 = (unsigned)(t + 1) * kstep;
            const unsigned k2 = last ? 0u : (unsigned)(t + 2) * kstep, k3 = k2 + kstep;
            const char* b20 = last ? nB0 : cB0 + (size_t)(t + 2) * kstepB; const char* b21 = last ? nB1 : cB1 + (size_t)(t + 2) * kstepB;
            const char* b30 = b20 + kstepB; const char* b31 = b21 + kstepB;
            unsigned o20[2], o21[2];
#pragma unroll
            for (int i = 0; i < 2; ++i) { o20[i] = last ? nxo[0][i] : cuo[0][i]; o21[i] = last ? nxo[1][i] : cuo[1][i]; }
            PG8_LDB(B0, 0, 0); PG8_LDB(B1, 0, 1); PG8_SCHED; PG8_LDA(At, 0, 0); PG8_STAGE_A(PG8_SA(1, 1), k1, cuo[1]); PG8_SIDE_ISSUE((ui * nt + t) >> 1);
            PG8_WAIT_VS(2);
            PG8_WAIT_L(0); PG8_SCHED; PG8_BFIX(B0); PG8_BFIX(B1); PG8_BAR; PG8_MMA(0, 0, At, B0); PG8_MMA(0, 1, At, B1); PG8_BAR; PG8_SCHED;
            PG8_LDA(At, 0, 1); PG8_STAGE_B(PG8_SB(0, 0), b20); PG8_STAGE_B(PG8_SB(0, 1), b21); PG8_STAGE_A(PG8_SA(0, 0), k2, o20);
            PG8_WAIT_VS(2); PG8_WAIT_L(0); PG8_BAR; PG8_MMA(1, 0, At, B0); PG8_MMA(1, 1, At, B1); PG8_BAR; PG8_SCHED;
            PG8_LDB(B0, 1, 0); PG8_LDB(B1, 1, 1); PG8_SCHED; PG8_LDA(At, 1, 0); PG8_STAGE_A(PG8_SA(0, 1), k2, o21);
            PG8_WAIT_V(8);
            PG8_WAIT_L(0); PG8_SCHED; PG8_BFIX(B0); PG8_BFIX(B1); PG8_BAR; PG8_MMA(0, 0, At, B0); PG8_MMA(0, 1, At, B1); PG8_BAR; PG8_SCHED;
            PG8_SIDE_FINISH();
            PG8_LDA(At, 1, 1); PG8_STAGE_B(PG8_SB(1, 0), b30); PG8_STAGE_B(PG8_SB(1, 1), b31); PG8_STAGE_A(PG8_SA(1, 0), k3, o20);
            PG8_WAIT_VS(1); PG8_WAIT_L(0); PG8_BAR; PG8_MMA(1, 0, At, B0); PG8_MMA(1, 1, At, B1); PG8_BAR; PG8_SCHED;
            if constexpr (Side::ON) sfly = false;
        }
        if constexpr (ALIGN_EPI) { if (wr == 0) PG8_BAR; }
        if constexpr (Prob::FP8) asm volatile("s_nop 15\n\ts_nop 15" ::: "memory");
        E(acc, cur, wr, wc, fr, fq);
        if (!has_next) break;
#pragma unroll
        for (int a = 0; a < 2; ++a)
#pragma unroll
            for (int b = 0; b < 2; ++b)
#pragma unroll
                for (int m = 0; m < 4; ++m)
#pragma unroll
                    for (int n = 0; n < 2; ++n) acc[a][b][m][n] = (f32x4){0.f, 0.f, 0.f, 0.f};
        cur = nxt; cB0 = nB0; cB1 = nB1; ++ui;
#pragma unroll
        for (int h = 0; h < 2; ++h)
#pragma unroll
            for (int i = 0; i < 2; ++i) cuo[h][i] = nxo[h][i];
        if constexpr (ALIGN_EPI) { if (wr == 1) PG8_BAR; }
    }
    PG8_WAIT_V(0);
    if constexpr (!ALIGN_EPI) { if (wr == 0) PG8_BAR; }
    PG8_BAR;
#undef PG8_SA
#undef PG8_SB
#undef PG8_STAGE_A
#undef PG8_STAGE_B
#undef PG8_LDA
#undef PG8_LDB
#undef PG8_BFIX
#undef PG8_MMA
#undef PG8_WAIT_V
#undef PG8_WAIT_L
#undef PG8_BAR
#undef PG8_SCHED
#undef PG8_AOFF
#undef PG8_SIDE_ISSUE
#undef PG8_SIDE_FINISH
#undef PG8_WAIT_VS
}
}

#define XB_TMO      128
#define XB_XCNT(j)  (256  + 64 * (j))
#define XB_XSUB(j)  (1280 + 64 * (j))
#define XB_XGEN(j)  (2304 + 64 * (j))
#define XB_TOP      3328
#define XB_TOPGEN   3392
#define XCD_BAR_WORDS 3456
#define XB_SPIN_CAP (1u << 18)
__device__ __forceinline__ unsigned xb_ld(unsigned* p)              { return __hip_atomic_load(p, __ATOMIC_RELAXED, __HIP_MEMORY_SCOPE_AGENT); }
__device__ __forceinline__ unsigned xb_add(unsigned* p, unsigned v) { return __hip_atomic_fetch_add(p, v, __ATOMIC_RELAXED, __HIP_MEMORY_SCOPE_AGENT); }
__device__ __forceinline__ unsigned xb_xcc_id() { return (unsigned)__builtin_amdgcn_s_getreg((3 << 11) | 20) & 0xFu; }
#define XB_SPIN(cond, bar) do { unsigned _sp = 0; while (cond) { __builtin_amdgcn_s_sleep(1); \
    if ((++_sp & 255u) == 0u) { if (xb_ld(&(bar)[XB_TMO])) break; if (_sp > XB_SPIN_CAP) { atomicAdd(&(bar)[XB_TMO], 1u); break; } } } } while (0)
struct XcdBarrier { unsigned* bar; unsigned x; volatile LAS unsigned* st; };
__device__ __forceinline__ XcdBarrier xcd_barrier_post(unsigned* bar, volatile LAS unsigned* st) {
    XcdBarrier b; b.bar = bar; b.x = xb_xcc_id(); b.st = st;
    if (threadIdx.x == 0) (void)xb_add(&bar[XB_XCNT(b.x)], 1u);
    return b;
}
__device__ __forceinline__ void xcd_barrier_complete(unsigned* bar, unsigned x, unsigned& nloc, unsigned& nx) {
    const unsigned G = gridDim.x * gridDim.y * gridDim.z;
    unsigned sum, cnt, mine, sp = 0u;
    for (;;) {
        sum = 0u; cnt = 0u; mine = 0u;
#pragma unroll
        for (unsigned j = 0; j < 16; ++j) { const unsigned c = xb_ld(&bar[XB_XCNT(j)]); sum += c; cnt += (c > 0u) ? 1u : 0u; mine = (j == x) ? c : mine; }
        if (sum == G) break;
        __builtin_amdgcn_s_sleep(1);
        if ((++sp & 255u) == 0u) { if (xb_ld(&bar[XB_TMO])) break; if (sp > XB_SPIN_CAP) { atomicAdd(&bar[XB_TMO], 1u); break; } }
    }
    nloc = mine > 0u ? mine : 1u; nx = cnt > 0u ? cnt : 1u;
}
__device__ __forceinline__ void xcd_barrier(const XcdBarrier& b) {
    asm volatile("s_waitcnt vmcnt(0)" ::: "memory");
    __syncthreads();
    if (threadIdx.x == 0) {
        unsigned* bar = b.bar;
        __builtin_amdgcn_s_waitcnt(0);
        unsigned nloc = b.st[0], nx = b.st[1];
        if (nloc == 0u) { xcd_barrier_complete(bar, b.x, nloc, nx); b.st[0] = nloc; b.st[1] = nx; }
        const unsigned old = xb_add(&bar[XB_XSUB(b.x)], 1u);
        const unsigned gen = old / nloc;
        if (old + 1u == (gen + 1u) * nloc) {
            __builtin_amdgcn_fence(__ATOMIC_RELEASE, "agent");
            asm volatile("s_waitcnt vmcnt(0)" ::: "memory");
            const unsigned og = xb_add(&bar[XB_TOP], 1u);
            const unsigned tg = og / nx;
            if (og + 1u == (tg + 1u) * nx) xb_add(&bar[XB_TOPGEN], 1u);
            else XB_SPIN(xb_ld(&bar[XB_TOPGEN]) == tg, bar);
            __builtin_amdgcn_fence(__ATOMIC_ACQUIRE, "agent");
            xb_add(&bar[XB_XGEN(b.x)], 1u);
            asm volatile("s_waitcnt vmcnt(0)" ::: "memory");
        } else {
            XB_SPIN(xb_ld(&bar[XB_XGEN(b.x)]) == gen, bar);
            __builtin_amdgcn_fence(__ATOMIC_ACQUIRE, "agent");
            asm volatile("s_waitcnt vmcnt(0)" ::: "memory");
        }
    }
    __syncthreads();
}

struct Frame {
    LAS unsigned char* lds;
    int tid, lane, wave, vcu, G;
    const float *x, *g_mix, *w_in, *a_sink, *g_out_a, *g_out_b, *w_out, *g_ffn, *w_router, *w_gate, *w_up, *w_down, *g_final;
    float* out; unsigned char* ws;
    unsigned long long tacc;
};

__device__ __forceinline__ void p0_transpose_item(const float* W, int K, int N, h16* WT, int k0, int n0, int drow0, float sc, LAS float* scr, int lane) {
#pragma unroll 8
    for (int i = 0; i < 32; ++i) { const int kk = 2 * i + (lane >> 5); scr[kk * 33 + (lane & 31)] = W[(size_t)(k0 + kk) * N + n0 + (lane & 31)]; }
    LDS_WAIT(); asm volatile("" ::: "memory");
    const int c = lane & 7;
#pragma unroll
    for (int j = 0; j < 4; ++j) { const int n = (lane >> 3) + 8 * j; const LAS float* s = scr + (8 * c) * 33 + n;
        u32x4 o; o.x = pk_h2(s[0 * 33] * sc, s[1 * 33] * sc); o.y = pk_h2(s[2 * 33] * sc, s[3 * 33] * sc); o.z = pk_h2(s[4 * 33] * sc, s[5 * 33] * sc); o.w = pk_h2(s[6 * 33] * sc, s[7 * 33] * sc);
        *(GAS u32x4*)(WT + (size_t)(drow0 + n) * K + k0 + 8 * c) = o; }
    LDS_WAIT(); asm volatile("" ::: "memory");
}
__device__ __forceinline__ void sincos_d(double a, float& s, float& c) {
    const double q = __builtin_rint(a * 0.63661977236758134308);
    double r = __builtin_fma(-q, 1.570796325802803, a); r = __builtin_fma(-q, 9.920935796805404e-10, r);
    const double r2 = r * r;
    double sp = -7.6471637318198164759e-13;
    sp = sp * r2 + 1.6059043836821614599e-10; sp = sp * r2 - 2.5052108385441718775e-08; sp = sp * r2 + 2.7557319223985890653e-06;
    sp = sp * r2 - 1.9841269841269841270e-04; sp = sp * r2 + 8.3333333333333333333e-03; sp = sp * r2 - 1.6666666666666666667e-01;
    const double sn = r + r * r2 * sp;
    double cp = 4.7794773323873852974e-14;
    cp = cp * r2 - 1.1470745597729724714e-11; cp = cp * r2 + 2.0876756987868098979e-09; cp = cp * r2 - 2.7557319223985890653e-07;
    cp = cp * r2 + 2.4801587301587301587e-05; cp = cp * r2 - 1.3888888888888888889e-03; cp = cp * r2 + 4.1666666666666666667e-02; cp = cp * r2 - 0.5;
    const double cs = 1.0 + r2 * cp;
    const int qi = (int)q & 3;
    const double ss = (qi & 1) ? cs : sn, cc = (qi & 1) ? sn : cs;
    s = (float)((qi & 2) ? -ss : ss); c = (float)(((qi + 1) & 2) ? -cc : cc);
}

__device__ __forceinline__ void p0_prologue(Frame& F) {
    LAS float* scr = (LAS float*)(F.lds + F.wave * 16384);
    const int gw = F.vcu * NWAVES + F.wave, NGW = F.G * NWAVES;
    {
        const double invf[8] = {1.0, 0.19392274474868576, 0.03760603093086393, 0.007292664737217109, 0.001414213562373095, 0.0002742481756762073, 5.318295896944988e-05, 1.031338537721246e-05};
        float* rope = (float*)(F.ws + WS_ROPE);
        for (int idx = F.vcu * 512 + F.tid; idx < SEQ * 8; idx += F.G * 512) {
            const int pos = idx >> 3, i = idx & 7;
            double f = invf[0];
#pragma unroll
            for (int j = 1; j < 8; ++j) f = (i == j) ? invf[j] : f;
            float s, c; sincos_d((double)pos * f, s, c);
            rope[pos * 16 + i] = c; rope[pos * 16 + 8 + i] = s;
        }
    }
    {
        h16* H = (h16*)(F.ws + WS_H);
        for (int m = gw; m < M; m += NGW) {
            const GAS f32x4* xr = (const GAS f32x4*)(F.x + (size_t)m * DM) + F.lane;
            f32x4 v[4]; float s = 0.f;
#pragma unroll
            for (int j = 0; j < 4; ++j) { v[j] = __builtin_nontemporal_load(xr + 64 * j); s += (v[j].x * v[j].x + v[j].y * v[j].y) + (v[j].z * v[j].z + v[j].w * v[j].w); }
            const float rs = 1.0f / sqrtf(wave_sum(s) * (1.0f / DM) + NORM_EPS);
            GAS u32x2* o8 = (GAS u32x2*)(H + (size_t)m * DM) + F.lane;
#pragma unroll
            for (int j = 0; j < 4; ++j) { const f32x4 g = ((const GAS f32x4*)F.g_mix)[F.lane + 64 * j]; const f32x4 y = v[j] * rs * g;
                u32x2 w; w.x = pk_h2(y.x, y.y); w.y = pk_h2(y.z, y.w); o8[64 * j] = w; }
        }
    }
    {
        constexpr int I_IN = (DM / 64) * (NIN / 32), I_OUT = (DM / 64) * (DM / 32);
        constexpr int NITEMS = I_IN + I_OUT;
        for (int it = gw; it < NITEMS; it += NGW) {
            int r = it;
            if (r < I_IN) { const int nblk = NIN / 32, kb = r / nblk, nb = r % nblk, n0 = 32 * nb;
                const float sc = (n0 < OFF_KA || (n0 >= OFF_QB && n0 < OFF_KB)) ? QSCALE : 1.0f;
                p0_transpose_item(F.w_in, DM, NIN, (h16*)(F.ws + WS_WIN), 64 * kb, n0, n0, sc, scr, F.lane); continue; }
            r -= I_IN;
            { const int nblk = DM / 32, kb = r / nblk, nb = r % nblk, n0 = 32 * nb;
              p0_transpose_item(F.w_out, DM, DM, (h16*)(F.ws + WS_WOUT), 64 * kb, n0, n0, 1.0f, scr, F.lane); }
        }
    }
}

#define TSEC_BEGIN(code) unsigned long long tsec_##code = 0; if (TIME_PHASE == (code)) tsec_##code = __builtin_amdgcn_s_memrealtime()
#define TSEC_END(code) do { if (TIME_PHASE == (code)) F.tacc += __builtin_amdgcn_s_memrealtime() - tsec_##code; } while (0)
namespace att {
__device__ __forceinline__ int crow(int r, int hi) { return (r & 3) + 8 * (r >> 2) + 4 * hi; }
constexpr float THR = 8.0f;
constexpr int ATT_SIDE = 0;
constexpr int TILE_BYTES = 16384;
constexpr int WSF_OFF = 98304, STG_OFF = 100352;

__device__ __forceinline__ float max3f(float a, float b, float c) { float r; asm("v_max3_f32 %0, %1, %2, %3" : "=v"(r) : "v"(a), "v"(b), "v"(c)); return r; }
__device__ __forceinline__ float max16(const f32x16& p) {
    float a = max3f(p[0], p[1], p[2]), b = max3f(p[3], p[4], p[5]); a = max3f(a, p[6], p[7]); b = max3f(b, p[8], p[9]); a = max3f(a, p[10], p[11]); b = max3f(b, p[12], p[13]);
    return max3f(a, b, max3f(p[14], p[15], p[15])); }
__device__ __forceinline__ void tile_step(f32x16& o0, f32x16& o1, float& m, float& l, f32x16& negm, bool first, const half8 (&qr)[4],
                                          LAS const unsigned char* kt, LAS const unsigned char* vt, LAS float* wsf, int lane, int r32, int hi,
                                          int mode0, int mode1, int rel0, int lo, unsigned span) {
    f32x16 p0 = negm, p1 = negm;
    LAS const unsigned char* kb = kt + hi * 1024 + r32 * 16;
    const float NINF = -__builtin_inff();
    float rm = NINF;
    if (mode0) {
#pragma unroll
        for (int d0 = 0; d0 < 4; ++d0) p0 = __builtin_amdgcn_mfma_f32_32x32x16_f16(*(LAS const half8*)(kb + d0 * 2048), qr[d0], p0, 0, 0, 0);
        asm volatile("s_nop 15\n\ts_nop 7" : "+v"(p0));
        if (mode0 == 2) {
#pragma unroll
            for (int r = 0; r < 16; ++r) { const int rel = rel0 + (r & 3) + 8 * (r >> 2); if ((unsigned)(rel - lo) > span) p0[r] = NINF; }
        }
        rm = max16(p0);
    }
    if (mode1) {
#pragma unroll
        for (int d0 = 0; d0 < 4; ++d0) p1 = __builtin_amdgcn_mfma_f32_32x32x16_f16(*(LAS const half8*)(kb + d0 * 2048 + 512), qr[d0], p1, 0, 0, 0);
        asm volatile("s_nop 15\n\ts_nop 7" : "+v"(p1));
        if (mode1 == 2) {
#pragma unroll
            for (int r = 0; r < 16; ++r) { const int rel = rel0 + 32 + (r & 3) + 8 * (r >> 2); if ((unsigned)(rel - lo) > span) p1[r] = NINF; }
        }
        rm = fmaxf(rm, max16(p1));
    }
    { auto rr = __builtin_amdgcn_permlane32_swap(__float_as_uint(rm), __float_as_uint(rm), false, false); rm = fmaxf(__uint_as_float(rr[0]), __uint_as_float(rr[1])); }
    if (first || __any(rm > THR)) {
        const float dl = first ? fmaxf(rm, -100.f) : fmaxf(rm, 0.f); m += dl;
#pragma unroll
        for (int r = 0; r < 16; ++r) { p0[r] -= dl; p1[r] -= dl; negm[r] = -m; }
        if (!first) {
            const float f = __builtin_amdgcn_exp2f(-dl); l *= f;
            if (hi == 0) wsf[r32] = f;
            LDS_WAIT();
#pragma unroll
            for (int r = 0; r < 16; ++r) { const float fr_ = wsf[crow(r, hi)]; o0[r] *= fr_; o1[r] *= fr_; }
        }
    }
    LAS const unsigned char* vb = vt + (4 * hi + ((lane & 15) >> 2)) * 64 + ((lane >> 4) & 1) * 32 + (lane & 3) * 8;
    typedef short s16x8 __attribute__((ext_vector_type(8)));
    float s = 0.f;
#define ATT_HALF(P, KS0) do { \
        _Pragma("unroll") for (int r = 0; r < 16; ++r) { P[r] = __builtin_amdgcn_exp2f(P[r]); s += P[r]; } \
        u32x4 pwa, pwb; \
        _Pragma("unroll") for (int j = 0; j < 4; ++j) { pwa[j] = pk_h2_rtz(P[2 * j], P[2 * j + 1]); pwb[j] = pk_h2_rtz(P[8 + 2 * j], P[9 + 2 * j]); } \
        _Pragma("unroll") for (int kk = 0; kk < 2; ++kk) { const half8 pa = __builtin_bit_cast(half8, kk ? pwb : pwa); \
            _Pragma("unroll") for (int d0 = 0; d0 < 2; ++d0) { \
                const s16x4 vlo = __builtin_amdgcn_ds_read_tr16_b64_v4i16((LAS s16x4*)(vb + d0 * 4096 + ((KS0) + kk) * 1024)); \
                const s16x4 vhi = __builtin_amdgcn_ds_read_tr16_b64_v4i16((LAS s16x4*)(vb + d0 * 4096 + ((KS0) + kk) * 1024 + 512)); \
                const s16x8 vv = {vlo[0], vlo[1], vlo[2], vlo[3], vhi[0], vhi[1], vhi[2], vhi[3]}; \
                const half8 vf = __builtin_bit_cast(half8, vv); \
                if (d0 == 0) o0 = __builtin_amdgcn_mfma_f32_32x32x16_f16(pa, vf, o0, 0, 0, 0); \
                else         o1 = __builtin_amdgcn_mfma_f32_32x32x16_f16(pa, vf, o1, 0, 0, 0); } } } while (0)
    if (mode0) ATT_HALF(p0, 0);
    if (mode1) ATT_HALF(p1, 2);
#undef ATT_HALF
    l += s;
}

__device__ __forceinline__ void load_tile_regs(u32x4& kreg, u32x4& vreg, const h16* proj, int tokb, int dil, int LF, int tt0, int kcol, int vcol, int wid, int lane) {
    int tk = tt0 + lane; tk = tk < 0 ? 0 : (tk >= LF ? LF - 1 : tk);
    kreg = *(const u32x4*)(proj + (size_t)(tokb + tk * dil) * NIN + kcol + wid * 8);
    int tv = tt0 + (wid & 3) * 16 + (lane >> 2); tv = tv < 0 ? 0 : (tv >= LF ? LF - 1 : tv);
    vreg = *(const u32x4*)(proj + (size_t)(tokb + tv * dil) * NIN + vcol + (wid >> 2) * 32 + (lane & 3) * 8);
}

__device__ __forceinline__ void store_out(const f32x16& o0, const f32x16& o1, float l_tot, LAS float* wsf, LAS h16* stg, h16* dst, size_t pitch, int tok0, int dil, int lane, int r32, int hi) {
    if (hi == 0) wsf[32 + r32] = l_tot;
    LDS_WAIT();
#pragma unroll
    for (int r = 0; r < 16; ++r) { const int orow = crow(r, hi); const float rl = __builtin_amdgcn_rcpf(wsf[32 + orow]);
        stg[orow * 64 + r32] = __builtin_bit_cast(h16, (_Float16)(o0[r] * rl)); stg[orow * 64 + 32 + r32] = __builtin_bit_cast(h16, (_Float16)(o1[r] * rl)); }
    LDS_WAIT();
#pragma unroll
    for (int i = 0; i < 4; ++i) { const int row = i * 8 + (lane >> 3), ch = lane & 7; const u32x4 v = *(LAS const u32x4*)(stg + row * 64 + ch * 8);
        *(u32x4*)(dst + (size_t)(tok0 + row * dil) * pitch + ch * 8) = v; }
    LDS_WAIT();
}

struct UnitP { int isA, ntile, tt_first, dil, LF, tokb, kcol, vcol, hw, q0, g, h, p; };
__device__ __forceinline__ UnitP decode_unit(int u) {
    UnitP P;
    if (u < 512) { const int qb = u & 63, g = (u >> 6) & 1, b = u >> 7;
        P.isA = 1; P.ntile = 5; P.q0 = qb * 64; P.tt_first = P.q0 - 128; P.dil = 1; P.LF = SEQ; P.tokb = b * SEQ; P.kcol = OFF_KA + g * 64; P.vcol = OFF_VA + g * 64; P.hw = 128; P.g = g; P.h = 0; P.p = 0; }
    else { const int v = u - 512, u16 = v & 15, p = (v >> 4) % 3, bh = v / 48, h = bh & 7, b = bh >> 3, sh = 2 * p, dil = 1 << sh, res = u16 & (dil - 1), qb = u16 >> sh;
        P.isA = 0; P.ntile = 6; P.q0 = 256 * qb; P.tt_first = P.q0 - 64; P.dil = dil; P.LF = SEQ >> sh; P.tokb = b * SEQ + res; P.kcol = OFF_KB + h * 64; P.vcol = OFF_VB + h * 64; P.hw = 64; P.g = 0; P.h = h; P.p = p; }
    return P;
}
__device__ __forceinline__ void issue_tiles(u32x4 (&kr)[6], u32x4 (&vr)[6], const UnitP& P, const h16* proj, int wid, int lane) {
#pragma unroll
    for (int j = 0; j < 6; ++j) { const int tt0 = P.tt_first + 64 * j; if (j < P.ntile && tt0 >= 0 && tt0 < P.LF) load_tile_regs(kr[j], vr[j], proj, P.tokb, P.dil, P.LF, tt0, P.kcol, P.vcol, wid, lane); }
}
__device__ __forceinline__ void write_tiles(LAS unsigned char* L, const u32x4 (&kr)[6], const u32x4 (&vr)[6], const UnitP& P, int wid, int lane) {
#pragma unroll
    for (int j = 0; j < 6; ++j) { const int tt0 = P.tt_first + 64 * j; if (j < P.ntile && tt0 >= 0 && tt0 < P.LF) {
        *(LAS u32x4*)(L + j * TILE_BYTES + wid * 1024 + lane * 16) = kr[j];
        *(LAS u32x4*)(L + j * TILE_BYTES + 8192 + wid * 1024 + lane * 16) = vr[j]; } }
}

__device__ __forceinline__ void attn_phase(Frame& F) {
    const int lane = F.lane, wid = F.wave, r32 = lane & 31, hi = lane >> 5;
    LAS unsigned char* L = F.lds;
    LAS float* wsf = (LAS float*)(L + WSF_OFF) + wid * 64;
    LAS h16* stg = (LAS h16*)(L + STG_OFF + wid * 4096);
    const h16* proj = (const h16*)(F.ws + WS_PROJ);
    int u = F.vcu;
    if (u >= 2048) return;
    UnitP P = decode_unit(u);
    u32x4 kr[6], vr[6];
    issue_tiles(kr, vr, P, proj, wid, lane);
    half8 qn[4];
#define ATT_QLOAD(PP) do { const int qw_ = (PP).isA ? (PP).q0 + 32 * (wid >> 2) : (PP).q0 + 32 * wid, qc_ = (PP).isA ? OFF_QA + (4 * (PP).g + (wid & 3)) * 64 : OFF_QB + (PP).h * 64; \
        const h16* qp_ = proj + (size_t)((PP).tokb + (qw_ + r32) * (PP).dil) * NIN + qc_ + hi * 8; _Pragma("unroll") for (int d0 = 0; d0 < 4; ++d0) qn[d0] = *(const half8*)(qp_ + d0 * 16); } while (0)
    ATT_QLOAD(P);
#pragma unroll 1
    for (; u < 2048; u += F.G) {
        TSEC_BEGIN(20);
        write_tiles(L, kr, vr, P, wid, lane);
        int head, tq, qcol, jb, je, qw0;
        if (P.isA) { head = 4 * P.g + (wid & 3); qw0 = P.q0 + 32 * (wid >> 2); qcol = OFF_QA + head * 64; jb = 0; je = 5; }
        else       { head = P.h; qw0 = P.q0 + 32 * wid; qcol = OFF_QB + head * 64; jb = wid >> 1; je = jb + 3; }
        tq = qw0 + r32; (void)qcol;
        half8 qr[4];
#pragma unroll
        for (int d0 = 0; d0 < 4; ++d0) qr[d0] = qn[d0];
        float m = P.isA ? F.a_sink[head] * LOG2E : 0.f, l = (P.isA && hi == 0) ? 1.0f : 0.0f;
        bool first = !P.isA;
        asm volatile("" ::: "memory");
        __syncthreads();
#pragma unroll
        for (int d0 = 0; d0 < 4; ++d0) asm volatile("" : "+v"(qr[d0]));
        TSEC_END(20);
        TSEC_BEGIN(21);
        const UnitP Pc = P;
        if (u + F.G < 2048) { P = decode_unit(u + F.G); issue_tiles(kr, vr, P, proj, wid, lane); ATT_QLOAD(P); }
        asm volatile("" ::: "memory");
        f32x16 o0, o1, negm;
#pragma unroll
        for (int r = 0; r < 16; ++r) { o0[r] = 0.f; o1[r] = 0.f; negm[r] = -m; }
        const int lo = (-Pc.hw > -tq) ? -Pc.hw : -tq, hi_ = (Pc.hw < Pc.LF - 1 - tq) ? Pc.hw : (Pc.LF - 1 - tq); const unsigned span = (unsigned)(hi_ - lo);
#pragma unroll 1
        for (int j = jb; j < je; ++j) {
            const int tt0 = Pc.tt_first + 64 * j; if (tt0 < 0 || tt0 >= Pc.LF) continue;
            int md[2];
#pragma unroll
            for (int h = 0; h < 2; ++h) { const int mn = tt0 + 32 * h - (qw0 + 31), mx = tt0 + 32 * h + 31 - qw0;
                md[h] = (mn > Pc.hw || mx < -Pc.hw) ? 0 : ((mn >= -Pc.hw && mx <= Pc.hw) ? 1 : 2); }
            if ((md[0] | md[1]) == 0) continue;
            tile_step(o0, o1, m, l, negm, first, qr, L + j * TILE_BYTES, L + j * TILE_BYTES + 8192, wsf, lane, r32, hi, md[0], md[1], tt0 + 4 * hi - tq, lo, span);
            first = false;
        }
        { auto rr = __builtin_amdgcn_permlane32_swap(__float_as_uint(l), __float_as_uint(l), false, false); l = __uint_as_float(rr[0]) + __uint_as_float(rr[1]); }
        TSEC_END(21);
        TSEC_BEGIN(22);
        if (Pc.isA) store_out(o0, o1, l, wsf, stg, (h16*)(F.ws + WS_OA) + head * 64, 512, Pc.tokb + qw0, 1, lane, r32, hi);
        else {
            if (hi == 0) ((float*)(F.ws + WS_LSE))[((size_t)Pc.p * M + Pc.tokb + tq * Pc.dil) * 8 + head] = (m + __builtin_amdgcn_logf(l)) * LN2;
            store_out(o0, o1, l, wsf, stg, (h16*)(F.ws + WS_OB) + (size_t)Pc.p * M * 512 + head * 64, 512, Pc.tokb + qw0 * Pc.dil, Pc.dil, lane, r32, hi);
        }
        __syncthreads();
        TSEC_END(22);
    }
}
}

__device__ __forceinline__ void p3_combine(Frame& F) {
    const int gw = F.vcu * NWAVES + F.wave, NGW = F.G * NWAVES, lane = F.lane;
    const h16* OA = (const h16*)(F.ws + WS_OA); const h16* OB = (const h16*)(F.ws + WS_OB); const float* LSE = (const float*)(F.ws + WS_LSE);
    h16* MX = (h16*)(F.ws + WS_MIXED);
    f32x4 ga[2], gb[2];
#pragma unroll
    for (int i = 0; i < 2; ++i) { ga[i] = *(const f32x4*)(F.g_out_a + 8 * lane + 4 * i); gb[i] = *(const f32x4*)(F.g_out_b + 8 * lane + 4 * i); }
    for (int t = gw; t < M; t += NGW) {
        const u32x4 ra = __builtin_nontemporal_load((const u32x4*)(OA + (size_t)t * 512 + 8 * lane));
        u32x4 rb[3]; float ls[3];
#pragma unroll
        for (int p = 0; p < 3; ++p) { rb[p] = __builtin_nontemporal_load((const u32x4*)(OB + ((size_t)p * M + t) * 512 + 8 * lane)); ls[p] = LSE[((size_t)p * M + t) * 8 + (lane >> 3)]; }
        float a[8], bsum[8];
#pragma unroll
        for (int i = 0; i < 4; ++i) { a[2 * i] = h2f((unsigned short)(ra[i] & 0xffffu)); a[2 * i + 1] = h2f((unsigned short)(ra[i] >> 16)); }
        const float mx = fmaxf(ls[0], fmaxf(ls[1], ls[2]));
        float w[3]; float ws_ = 0.f;
#pragma unroll
        for (int p = 0; p < 3; ++p) { w[p] = __expf(ls[p] - mx); ws_ += w[p]; }
        const float inv = 1.0f / ws_;
#pragma unroll
        for (int i = 0; i < 8; ++i) bsum[i] = 0.f;
#pragma unroll
        for (int p = 0; p < 3; ++p) { const float wp = w[p] * inv;
#pragma unroll
            for (int i = 0; i < 4; ++i) { bsum[2 * i] += wp * h2f((unsigned short)(rb[p][i] & 0xffffu)); bsum[2 * i + 1] += wp * h2f((unsigned short)(rb[p][i] >> 16)); } }
        float sa = 0.f, sb = 0.f;
#pragma unroll
        for (int i = 0; i < 8; ++i) { sa += a[i] * a[i]; sb += bsum[i] * bsum[i]; }
        const float rsa = 1.0f / sqrtf(wave_sum(sa) * (1.0f / 512.0f) + NORM_EPS), rsb = 1.0f / sqrtf(wave_sum(sb) * (1.0f / 512.0f) + NORM_EPS);
        u32x4 wa, wb;
#pragma unroll
        for (int i = 0; i < 4; ++i) { wa[i] = pk_h2(a[2 * i] * rsa * ga[i >> 1][(2 * i) & 3], a[2 * i + 1] * rsa * ga[i >> 1][(2 * i + 1) & 3]);
                                      wb[i] = pk_h2(bsum[2 * i] * rsb * gb[i >> 1][(2 * i) & 3], bsum[2 * i + 1] * rsb * gb[i >> 1][(2 * i + 1) & 3]); }
        *(u32x4*)(MX + (size_t)t * DM + 8 * lane) = wa;
        *(u32x4*)(MX + (size_t)t * DM + 512 + 8 * lane) = wb;
    }
}

__device__ __forceinline__ void p5_router(Frame& F) {
    const int gw = F.vcu * NWAVES + F.wave, NGW = F.G * NWAVES, lane = F.lane;
    LAS unsigned char* L = F.lds;
    for (int i = F.tid; i < DM * 4; i += NWAVES * 64) { const int k = i >> 2, c = i & 3; *(LAS f32x4*)(L + k * 64 + (k >> 2) * 16 + c * 16) = *(const f32x4*)(F.w_router + k * 16 + c * 4); }
    __syncthreads();
    const h16* X1 = (const h16*)(F.ws + WS_X1); unsigned char* H2 = F.ws + WS_H2; float* AFF = (float*)(F.ws + WS_AFF);
    f32x4 g[4];
#pragma unroll
    for (int j = 0; j < 4; ++j) g[j] = ((const f32x4*)F.g_ffn)[lane + 64 * j];
    u32x2 vn[4];
    if (gw < M) {
#pragma unroll
        for (int j = 0; j < 4; ++j) vn[j] = __builtin_nontemporal_load((const u32x2*)(X1 + (size_t)gw * DM) + lane + 64 * j);
    }
    LAS float* cscr = (LAS float*)(L + 69632 + F.wave * 8448);
    const float* const wg_ = F.w_gate; const float* const wu_ = F.w_up; const float* const wd_ = F.w_down; unsigned char* const ws_ = F.ws;
    const int JT = (int)((CV_TOTAL + (unsigned)NGW - 1u) / (unsigned)NGW), J1 = (F.G > BATCH * NE) ? JT - JT / 8 : JT;
    int cj = 0; bool cpendA = false, cpendB = false;
    ConvItem citA = conv8_decode(wg_, wu_, wd_, ws_, (unsigned)gw < CV_TOTAL ? (unsigned)gw : 0u), citB = citA; float cregA[32], cregB[32];
#define P5_PUMP1(PEND, ITEM, REG) do { __builtin_amdgcn_sched_barrier(0); if (PEND) conv8_finish(ITEM, REG, cscr, lane); __builtin_amdgcn_sched_barrier(0); \
        { const unsigned it_ = (unsigned)cj * (unsigned)NGW + (unsigned)gw; PEND = (cj < J1) && (it_ < CV_TOTAL); if (PEND) ITEM = conv8_decode(wg_, wu_, wd_, ws_, it_); ++cj; conv8_issue(ITEM, REG, lane); } __builtin_amdgcn_sched_barrier(0); } while (0)
#define P5_PUMP() do { if (cj & 1) P5_PUMP1(cpendB, citB, cregB); else P5_PUMP1(cpendA, citA, cregA); } while (0)
    P5_PUMP();
    P5_PUMP();
    for (int t = gw; t < M; t += NGW) {
        f32x4 v[4]; float s = 0.f;
#pragma unroll
        for (int j = 0; j < 4; ++j) { v[j].x = h2f((unsigned short)(vn[j].x & 0xffffu)); v[j].y = h2f((unsigned short)(vn[j].x >> 16)); v[j].z = h2f((unsigned short)(vn[j].y & 0xffffu)); v[j].w = h2f((unsigned short)(vn[j].y >> 16)); }
        if (t + NGW < M) {
#pragma unroll
            for (int j = 0; j < 4; ++j) vn[j] = __builtin_nontemporal_load((const u32x2*)(X1 + (size_t)(t + NGW) * DM) + lane + 64 * j);
        }
        P5_PUMP();
#pragma unroll
        for (int j = 0; j < 4; ++j) s += (v[j].x * v[j].x + v[j].y * v[j].y) + (v[j].z * v[j].z + v[j].w * v[j].w);
        const float rs = 1.0f / sqrtf(wave_sum(s) * (1.0f / DM) + NORM_EPS);
        unsigned* o4 = (unsigned*)(H2 + (size_t)t * DM) + lane;
        float acc[16];
#pragma unroll
        for (int e = 0; e < 16; ++e) acc[e] = 0.f;
#pragma unroll
        for (int j = 0; j < 4; ++j) {
            const f32x4 y = v[j] * rs * g[j];
            o4[64 * j] = pk_fp8x4(clamp8(y.x * S_H2), clamp8(y.y * S_H2), clamp8(y.z * S_H2), clamp8(y.w * S_H2));
#pragma unroll
            for (int c = 0; c < 4; ++c) {
                const int k = 256 * j + 4 * lane + c; LAS const f32x4* wr = (LAS const f32x4*)(L + k * 64 + (k >> 2) * 16);
#pragma unroll
                for (int q = 0; q < 4; ++q) { const f32x4 wv = wr[q];
#pragma unroll
                    for (int z = 0; z < 4; ++z) acc[4 * q + z] += y[c] * wv[z]; }
                if (c & 1) asm volatile("" ::: "memory");
            }
        }
        { const bool up = (lane & 32) != 0;
#pragma unroll
          for (int i = 0; i < 8; ++i) { const float send = up ? acc[i] : acc[i + 8], keep = up ? acc[i + 8] : acc[i]; acc[i] = keep + __shfl_xor(send, 32); } }
        { const bool up = (lane & 16) != 0;
#pragma unroll
          for (int i = 0; i < 4; ++i) { const float send = up ? acc[i] : acc[i + 4], keep = up ? acc[i + 4] : acc[i]; acc[i] = keep + __shfl_xor(send, 16); } }
        { const bool up = (lane & 8) != 0;
#pragma unroll
          for (int i = 0; i < 2; ++i) { const float send = up ? acc[i] : acc[i + 2], keep = up ? acc[i + 2] : acc[i]; acc[i] = keep + __shfl_xor(send, 8); } }
        float lg;
        { const bool up = (lane & 4) != 0; const float send = up ? acc[0] : acc[1], keep = up ? acc[1] : acc[0]; lg = keep + __shfl_xor(send, 4); }
        lg += __shfl_xor(lg, 2); lg += __shfl_xor(lg, 1);
        float mx = lg;
#pragma unroll
        for (int o = 4; o < 64; o <<= 1) mx = fmaxf(mx, __shfl_xor(mx, o));
        const float ex = __expf(lg - mx); float sm = ex;
#pragma unroll
        for (int o = 4; o < 64; o <<= 1) sm += __shfl_xor(sm, o);
        if ((lane & 3) == 0) { const int e = lane >> 2, b = t >> 12, sidx = t & (SEQ - 1); AFF[((size_t)(b * NE + e)) * SEQ + sidx] = ex / sm; }
        P5_PUMP();
    }
#pragma unroll 1
    while (cpendA || cpendB || cj < J1) P5_PUMP();
#undef P5_PUMP
#undef P5_PUMP1
}

__device__ __forceinline__ void p6_topk(Frame& F) {
    LAS unsigned* cnt = (LAS unsigned*)F.lds;
    const int tid = F.tid, lane = F.lane, wid = F.wave;
    const float* AFF = (const float*)(F.ws + WS_AFF);
    int* TOK = (int*)(F.ws + WS_TOK); float* GATE = (float*)(F.ws + WS_GATE); int* SLOT = (int*)(F.ws + WS_SLOT);
    for (int pair = F.vcu; pair < BATCH * NE; pair += F.G) {
        const int b = pair >> 4, e = pair & 15;
        const float* a = AFF + (size_t)pair * SEQ + 8 * tid;
        const f32x4 a0 = *(const f32x4*)a, a1 = *(const f32x4*)(a + 4);
        unsigned key[8];
#pragma unroll
        for (int j = 0; j < 4; ++j) { key[j] = __float_as_uint(a0[j]); key[4 + j] = __float_as_uint(a1[j]); }
        unsigned prefix = 0u;
        __syncthreads();
#pragma unroll 1
        for (int bit = 31; bit >= 0; --bit) {
            const unsigned cand = prefix | (1u << bit);
            unsigned c = 0;
#pragma unroll
            for (int j = 0; j < 8; ++j) c += (unsigned)__popcll(__ballot(key[j] >= cand));
            LAS unsigned* cc = cnt + ((bit & 1) ? 8 : 0);
            if (lane == 0) cc[wid] = c;
            __syncthreads();
            unsigned tot = 0;
#pragma unroll
            for (int w = 0; w < 8; ++w) tot += cc[w];
            if (tot >= (unsigned)CAP) prefix = cand;
        }
        unsigned cg = 0, ce = 0;
#pragma unroll
        for (int j = 0; j < 8; ++j) { cg += key[j] > prefix; ce += key[j] == prefix; }
        unsigned pk = (ce << 16) | cg, inc = pk;
#pragma unroll
        for (int o = 1; o < 64; o <<= 1) { const unsigned n = __shfl_up(inc, o); if (lane >= o) inc += n; }
        __syncthreads();
        LAS unsigned* ws_ = cnt + 16;
        if (lane == 63) ws_[wid] = inc;
        __syncthreads();
        unsigned base = 0, total = 0;
#pragma unroll
        for (int w = 0; w < 8; ++w) { const unsigned x = ws_[w]; if (w < wid) base += x; total += x; }
        const unsigned exc = base + inc - pk;
        unsigned gtb = exc & 0xffffu, eqb = exc >> 16;
        const unsigned need = (unsigned)CAP - (total & 0xffffu);
#pragma unroll
        for (int j = 0; j < 8; ++j) {
            const int sidx = 8 * tid + j; int slot = -1;
            if (key[j] > prefix) { slot = (int)(gtb + (eqb < need ? eqb : need)); ++gtb; }
            else if (key[j] == prefix) { if (eqb < need) slot = (int)(gtb + eqb); ++eqb; }
            SLOT[((size_t)(b * SEQ + sidx)) * NE + e] = slot;
            if (slot >= 0) { TOK[e * EROWS + b * CAP + slot] = b * SEQ + sidx; GATE[e * EROWS + b * CAP + slot] = __uint_as_float(key[j]); }
        }
        __syncthreads();
    }
}

__device__ __forceinline__ void p9_final(Frame& F) {
    const int gw = F.vcu * NWAVES + F.wave, NGW = F.G * NWAVES, lane = F.lane;
    const int* SLOT = (const int*)(F.ws + WS_SLOT); const unsigned char* YE = F.ws + WS_YE;
    f32x4 g[4];
#pragma unroll
    for (int j = 0; j < 4; ++j) g[j] = ((const f32x4*)F.g_final)[lane + 64 * j];
    int myslot = (gw < M) ? SLOT[(size_t)gw * NE + (lane & 15)] : -1;
    for (int t = gw; t < M; t += NGW) {
        f32x4* xr = (f32x4*)(F.out + (size_t)t * DM) + lane;
        const u32x2* xi = (const u32x2*)((const h16*)(F.ws + WS_X1) + (size_t)t * DM) + lane;
        f32x4 v[4];
#pragma unroll
        for (int j = 0; j < 4; ++j) { const u32x2 w = __builtin_nontemporal_load(xi + 64 * j); v[j].x = h2f((unsigned short)(w.x & 0xffffu)); v[j].y = h2f((unsigned short)(w.x >> 16)); v[j].z = h2f((unsigned short)(w.y & 0xffffu)); v[j].w = h2f((unsigned short)(w.y >> 16)); }
        const int slot_cur = myslot;
        const int tn = t + NGW;
        myslot = (tn < M) ? SLOT[(size_t)tn * NE + (lane & 15)] : -1;
        unsigned mask = (unsigned)(__ballot(slot_cur >= 0) & 0xffffull);
        const size_t ebase = (size_t)(t >> 12) * CAP;
        while (mask) {
            int e[4]; float w[4];
#pragma unroll
            for (int q = 0; q < 4; ++q) { const bool has = mask != 0u; e[q] = has ? (int)__builtin_ctz(mask) : e[0]; w[q] = has ? 1.f : 0.f; mask = has ? (mask & (mask - 1u)) : 0u; }
            unsigned y[4][4];
#pragma unroll
            for (int q = 0; q < 4; ++q) { const int sl = __builtin_amdgcn_readlane(slot_cur, e[q]);
                const unsigned* yr = (const unsigned*)(YE + ((size_t)e[q] * EROWS + ebase + sl) * DM) + lane;
#pragma unroll
                for (int j = 0; j < 4; ++j) y[q][j] = __builtin_nontemporal_load(yr + 64 * j); }
#pragma unroll
            for (int q = 0; q < 4; ++q) { const float wq = w[q] * (1.0f / S_YE);
#pragma unroll
                for (int j = 0; j < 4; ++j) { const auto lo2 = __builtin_amdgcn_cvt_pk_f32_fp8((int)y[q][j], false), hi2 = __builtin_amdgcn_cvt_pk_f32_fp8((int)y[q][j], true);
                    v[j].x += wq * lo2[0]; v[j].y += wq * lo2[1]; v[j].z += wq * hi2[0]; v[j].w += wq * hi2[1]; } }
        }
        float s = 0.f;
#pragma unroll
        for (int j = 0; j < 4; ++j) s += (v[j].x * v[j].x + v[j].y * v[j].y) + (v[j].z * v[j].z + v[j].w * v[j].w);
        const float rs = 1.0f / sqrtf(wave_sum(s) * (1.0f / DM) + NORM_EPS);
#pragma unroll
        for (int j = 0; j < 4; ++j) __builtin_nontemporal_store(v[j] * rs * g[j], xr + 64 * j);
    }
}

constexpr int NPHASE = 10;
struct Args { const float* in[13]; float* out; unsigned char* ws; int ph_lo, ph_hi, li, pad; };

__global__ void __launch_bounds__(NWAVES * 64, 2) mk_fwd(Args args) {
    extern __shared__ __attribute__((aligned(16))) unsigned char lds[];
    Frame F;
    F.lds = (LAS unsigned char*)lds;
    F.tid = threadIdx.x; F.lane = F.tid & 63; F.wave = __builtin_amdgcn_readfirstlane(F.tid >> 6);
    F.G = gridDim.x; { const int bx = blockIdx.x; F.vcu = (F.G % 8 == 0) ? (bx % 8) * (F.G / 8) + bx / 8 : bx; }
    F.x = args.in[0]; F.g_mix = args.in[1]; F.w_in = args.in[2]; F.a_sink = args.in[3]; F.g_out_a = args.in[4]; F.g_out_b = args.in[5]; F.w_out = args.in[6];
    F.g_ffn = args.in[7]; F.w_router = args.in[8]; F.w_gate = args.in[9]; F.w_up = args.in[10]; F.w_down = args.in[11]; F.g_final = args.in[12];
    F.out = args.out; F.ws = args.ws; F.tacc = 0;
    volatile LAS unsigned* MISC = (volatile LAS unsigned*)(F.lds + MISC_OFF);
    for (int u = F.tid; u < (LDS_BYTES - LDSCTL_OFF) / 4; u += NWAVES * 64) ((LAS unsigned*)(F.lds + LDSCTL_OFF))[u] = 0u;
    __syncthreads();
    const int lo = args.ph_lo, hi = args.ph_hi;
    const bool multi = (hi - lo) > 1;
    unsigned* barw = (unsigned*)(F.ws + WS_CTL) + CW_BAR + args.li * XCD_BAR_WORDS;
    XcdBarrier bar; bar.bar = barw; bar.x = 0; bar.st = nullptr;
    if (multi) bar = xcd_barrier_post(barw, MISC + 8);
#define IN(k) (((PH_MASK >> (k)) & 1) && lo <= (k) && (k) < hi)
#define SEAM(k) do { if (IN(k) && IN((k) + 1)) xcd_barrier(bar); } while (0)
#define TS0(k) do { if (TIME_PHASE == (k)) ts0_ = __builtin_amdgcn_s_memrealtime(); } while (0)
#define TS1(k) do { if (TIME_PHASE == (k)) ts1_ = __builtin_amdgcn_s_memrealtime(); } while (0)
    unsigned long long ts0_ = 0, ts1_ = 0;
#define REPS(k) for (int rep_ = 0; rep_ < 1 + ((REP_MASK >> (k)) & 1); ++rep_)

    TS0(0);
    if (IN(0)) REPS(0) { p0_prologue(F); SEAM(0); }
    TS1(0);
    TS0(1);
    if (IN(1)) {
        pg8::DenseProb P{(const char*)(F.ws + WS_H), (const char*)(F.ws + WS_WIN), DM * 2};
        pg8::DenseOrder S; S.init(M, NIN, F.G, (int)blockIdx.x, 1 + ((REP_MASK >> 1) & 1));
        pg8::EpiInProj E{(h16*)(F.ws + WS_PROJ), (const float*)(F.ws + WS_ROPE)};
        pg8::gemm_phase<pg8::DenseProb, pg8::EpiInProj, pg8::DenseOrder, true>(F.lds, P, S, E);
        SEAM(1);
    }
    TS1(1);
    TS0(2);
    if (IN(2)) REPS(2) { att::attn_phase(F); SEAM(2); }
    TS1(2);
    TS0(3);
    if (IN(3)) REPS(3) { p3_combine(F); SEAM(3); }
    TS1(3);
    TS0(4);
    if (IN(4)) {
        pg8::DenseProb P{(const char*)(F.ws + WS_MIXED), (const char*)(F.ws + WS_WOUT), DM * 2};
        pg8::DenseOrder S; S.init(M, DM, F.G, (int)blockIdx.x, 1 + ((REP_MASK >> 4) & 1));
        pg8::EpiResidual E{F.x, (h16*)(F.ws + WS_X1)};
        pg8::gemm_phase<pg8::DenseProb, pg8::EpiResidual, pg8::DenseOrder, true>(F.lds, P, S, E);
        SEAM(4);
    }
    TS1(4);
    TS0(5);
    if (IN(5)) REPS(5) { p5_router(F); SEAM(5); }
    TS1(5);
    TS0(6);
    if (IN(6)) REPS(6) {
        p6_topk(F);
        if (F.G > BATCH * NE && F.vcu >= BATCH * NE) {
            const int NGW_ = F.G * NWAVES, JT = (int)((CV_TOTAL + (unsigned)NGW_ - 1u) / (unsigned)NGW_), J1 = JT - JT / 8;
            const unsigned R0 = (unsigned)J1 * (unsigned)NGW_, NCW = (unsigned)(F.G - BATCH * NE) * NWAVES;
            for (unsigned it = R0 + (unsigned)(F.vcu - BATCH * NE) * NWAVES + (unsigned)F.wave; it < CV_TOTAL; it += NCW) conv8_one(F.w_gate, F.w_up, F.w_down, F.ws, it, (LAS float*)(F.lds + F.wave * 16384), F.lane);
        }
        SEAM(6); }
    TS1(6);
    TS0(7);
    if (IN(7)) {
        pg8::Moe1Prob P{(const char*)(F.ws + WS_H2), (const char*)(F.ws + WS_WGU), DM, (const int*)(F.ws + WS_TOK)};
        pg8::GroupOrder S; S.init(EROWS / 256, 4096 / 256, NE, F.G, F.vcu, 1 + ((REP_MASK >> 7) & 1));
        pg8::EpiSwiGLU E{F.ws + WS_HMID};
        pg8::gemm_phase<pg8::Moe1Prob, pg8::EpiSwiGLU, pg8::GroupOrder, true>(F.lds, P, S, E);
        SEAM(7);
    }
    TS1(7);
    TS0(8);
    if (IN(8)) {
        pg8::Moe2Prob P{(const char*)(F.ws + WS_HMID), (const char*)(F.ws + WS_WD), FF};
        pg8::GroupOrder S; S.init(EROWS / 256, DM / 256, NE, F.G, F.vcu, 1 + ((REP_MASK >> 8) & 1));
        pg8::EpiDown E{F.ws + WS_YE, (const float*)(F.ws + WS_GATE)};
        pg8::gemm_phase<pg8::Moe2Prob, pg8::EpiDown, pg8::GroupOrder, true>(F.lds, P, S, E);
        SEAM(8);
    }
    TS1(8);
    TS0(9);
    if (IN(9)) REPS(9) { p9_final(F); if (rep_ == 0 && ((REP_MASK >> 9) & 1)) xcd_barrier(bar); }
    TS1(9);
    if (TIME_PHASE >= 0 && blockIdx.x == 0 && F.tid == 0) { asm volatile("s_waitcnt vmcnt(0)" ::: "memory"); F.out[0] += (float)(TIME_PHASE >= 20 ? F.tacc : (ts1_ - ts0_)) * 0.01f * TIME_SCALE; }
#undef IN
#undef SEAM
}

extern "C" void kernel_launch(void* const* d_in, const int* in_sizes, int n_in, void* d_out, int out_size, void* d_ws, size_t ws_size, hipStream_t stream) {
    static int grid = 0;
    if (grid == 0) {
        if (n_in != 13 || in_sizes[0] != M * DM || out_size != M * DM || ws_size < WS_END) { fprintf(stderr, "kernel_launch: unexpected problem (n_in %d, ws %zu)\n", n_in, ws_size); grid = -1; return; }
        int dev = 0, cus = 0, per_cu = 0;
        if (hipGetDevice(&dev) != hipSuccess || hipDeviceGetAttribute(&cus, hipDeviceAttributeMultiprocessorCount, dev) != hipSuccess) { grid = -1; return; }
        if (hipFuncSetAttribute((const void*)mk_fwd, hipFuncAttributeMaxDynamicSharedMemorySize, LDS_BYTES) != hipSuccess) { fprintf(stderr, "kernel_launch: hipFuncSetAttribute failed\n"); grid = -1; return; }
        if (hipOccupancyMaxActiveBlocksPerMultiprocessor(&per_cu, (const void*)mk_fwd, NWAVES * 64, LDS_BYTES) != hipSuccess || per_cu < 1)
            fprintf(stderr, "kernel_launch: occupancy query reports %d blocks per CU\n", per_cu);
        (void)hipGetLastError();
        grid = cus;
    }
    if (grid < 0) return;
    (void)hipMemsetAsync((char*)d_ws + WS_CTL, 0, CTL_ZERO_BYTES, stream);
    Args a{};
    for (int i = 0; i < 13; ++i) a.in[i] = (const float*)d_in[i];
    a.out = (float*)d_out; a.ws = (unsigned char*)d_ws;
    if (MK_N_LAUNCHES == 1) {
        for (int pass = 0; pass < REP_ALL; ++pass) { a.ph_lo = 0; a.ph_hi = NPHASE; a.li = pass;
        hipLaunchKernelGGL(mk_fwd, dim3(grid), dim3(NWAVES * 64), LDS_BYTES, stream, a); }
    } else {
        for (int li = 0; li < NPHASE; ++li) { a.ph_lo = li; a.ph_hi = li + 1; a.li = 0;
            hipLaunchKernelGGL(mk_fwd, dim3(grid), dim3(NWAVES * 64), LDS_BYTES, stream, a); }
    }
}
```

```cpp
#include <hip/hip_runtime.h>
#include <cstdio>
#include <cstdint>

#ifndef MK_N_LAUNCHES
#define MK_N_LAUNCHES 1
#endif
#ifndef TIME_PHASE
#define TIME_PHASE -1
#endif
#ifndef TIME_SCALE
#define TIME_SCALE 1.0f
#endif
#ifndef PH_MASK
#define PH_MASK 0x3ff
#endif
#ifndef REP_ALL
#define REP_ALL 1
#endif
#ifndef REP_MASK
#define REP_MASK 0
#endif

#define LAS __attribute__((address_space(3)))
#define GAS __attribute__((address_space(1)))
typedef unsigned short h16;
typedef _Float16 half8 __attribute__((ext_vector_type(8)));
typedef _Float16 half2v __attribute__((ext_vector_type(2)));
typedef short s16x4 __attribute__((ext_vector_type(4)));
typedef float f32x4 __attribute__((ext_vector_type(4)));
typedef float f32x16 __attribute__((ext_vector_type(16)));
typedef unsigned u32x2 __attribute__((ext_vector_type(2)));
typedef unsigned u32x4 __attribute__((ext_vector_type(4)));
typedef GAS unsigned gu32;

constexpr int BATCH = 4, SEQ = 4096, DM = 1024, M = BATCH * SEQ;
constexpr int NIN = 2304;
constexpr int OFF_QA = 0, OFF_KA = 512, OFF_VA = 640, OFF_QB = 768, OFF_KB = 1280, OFF_VB = 1792;
constexpr int NE = 16, CAP = 512, FF = 2048, EROWS = BATCH * CAP;
constexpr float NORM_EPS = 1e-6f;
constexpr float LOG2E = 1.4426950408889634f, LN2 = 0.6931471805599453f;
constexpr float QSCALE = 0.18033688011112042f;
constexpr float S_H2 = 4.f, S_W = 32.f, S_HM = 2.f, S_YE = 16.f;

constexpr size_t MiB = 1u << 20;
constexpr size_t WS_CTL = 0, CTL_ZERO_BYTES = 64 * 1024;
constexpr size_t WS_ROPE = 1 * MiB;
constexpr size_t WS_AFF = 2 * MiB;
constexpr size_t WS_TOK = 3 * MiB;
constexpr size_t WS_GATE = 3 * MiB + 256 * 1024;
constexpr size_t WS_SLOT = 4 * MiB;
constexpr size_t WS_LSE = 5 * MiB;
constexpr size_t WS_WIN = 8 * MiB;
constexpr size_t WS_WOUT = 13 * MiB;
constexpr size_t WS_WGU = 16 * MiB;
constexpr size_t WS_WD = 144 * MiB;
constexpr size_t WS_H = 208 * MiB;
constexpr size_t WS_PROJ = 240 * MiB;
constexpr size_t WS_OA = 312 * MiB;
constexpr size_t WS_OB = 328 * MiB;
constexpr size_t WS_HMID = 208 * MiB;
constexpr size_t WS_MIXED = 376 * MiB;
constexpr size_t WS_H2 = 408 * MiB;
constexpr size_t WS_YE = 376 * MiB;
constexpr size_t WS_X1 = 440 * MiB;
constexpr size_t WS_END = 504 * MiB;
constexpr int CW_CONV = 64, CW_P1DONE = 128;
constexpr int CW_BAR = 1024;

constexpr int RING_BYTES = 131072;
constexpr int LDSCTL_OFF = 143360, MISC_OFF = LDSCTL_OFF + 320;
constexpr int LDS_BYTES = 147456;
constexpr int NWAVES = 8;

#define RLX_AGENT __ATOMIC_RELAXED, __HIP_MEMORY_SCOPE_AGENT
#define LDS_WAIT() asm volatile("s_waitcnt lgkmcnt(0)" ::: "memory")
#define VM_WAIT() asm volatile("s_waitcnt vmcnt(0)" ::: "memory")

__device__ __forceinline__ unsigned pk_h2(float lo, float hi) { half2v v = {(_Float16)lo, (_Float16)hi}; return __builtin_bit_cast(unsigned, v); }
__device__ __forceinline__ unsigned pk_h2_rtz(float lo, float hi) { return __builtin_bit_cast(unsigned, __builtin_amdgcn_cvt_pkrtz(lo, hi)); }
__device__ __forceinline__ unsigned pk_fp8x4(float a, float b, float c, float d) {
    int w = __builtin_amdgcn_cvt_pk_fp8_f32(a, b, 0, false); w = __builtin_amdgcn_cvt_pk_fp8_f32(c, d, w, true); return (unsigned)w; }
__device__ __forceinline__ float clamp8(float x) { return fminf(fmaxf(x, -448.f), 448.f); }
__device__ __forceinline__ float h2f(unsigned short b) { return (float)__builtin_bit_cast(_Float16, b); }
__device__ __forceinline__ float wave_sum(float v) {
#pragma unroll
    for (int o = 1; o < 64; o <<= 1) v += __shfl_xor(v, o);
    return v;
}


constexpr unsigned CV_PER = (DM / 64) * (FF / 32);
constexpr unsigned CV_TOTAL = (unsigned)NE * 3u * CV_PER;
struct ConvItem { const float* W; unsigned char* D; int N, K; };
__device__ __forceinline__ ConvItem conv8_decode(const float* wg, const float* wu, const float* wd, unsigned char* ws, unsigned it) {
    ConvItem c;
    if (it < (unsigned)NE * 2u * CV_PER) {
        const unsigned e = it / (2u * CV_PER); unsigned r = it - e * 2u * CV_PER; const unsigned which = r / CV_PER; r -= which * CV_PER;
        const int kb = (int)(r / (FF / 32)), n0 = 32 * (int)(r % (FF / 32));
        c.N = FF; c.K = DM; c.W = (which ? wu : wg) + (size_t)e * DM * FF + (size_t)(64 * kb) * FF + n0;
        c.D = ws + WS_WGU + ((size_t)e * 4096 + (size_t)((n0 >> 7) * 256 + (int)which * 128 + (n0 & 127))) * DM + 64 * kb;
    } else {
        const unsigned r0 = it - (unsigned)NE * 2u * CV_PER, e = r0 / CV_PER, r = r0 - e * CV_PER;
        const int kb = (int)(r / (DM / 32)), n0 = 32 * (int)(r % (DM / 32));
        c.N = DM; c.K = FF; c.W = wd + (size_t)e * FF * DM + (size_t)(64 * kb) * DM + n0;
        c.D = ws + WS_WD + ((size_t)e * DM + n0) * FF + 64 * kb;
    }
    return c;
}
__device__ __forceinline__ void conv8_issue(const ConvItem& c, float (&r)[32], int lane) {
#pragma unroll
    for (int i = 0; i < 32; ++i) r[i] = __builtin_nontemporal_load(c.W + (size_t)(2 * i + (lane >> 5)) * c.N + (lane & 31));
}
__device__ __forceinline__ void conv8_finish(const ConvItem& c, const float (&r)[32], LAS float* scr, int lane) {
#pragma unroll
    for (int i = 0; i < 32; ++i) scr[(2 * i + (lane >> 5)) * 33 + (lane & 31)] = r[i];
    LDS_WAIT(); asm volatile("" ::: "memory");
    const int n = lane >> 1, kh = (lane & 1) * 32; const LAS float* s = scr + kh * 33 + n;
    u32x4 o0, o1;
#pragma unroll
    for (int q = 0; q < 4; ++q) {
        o0[q] = pk_fp8x4(s[(4 * q) * 33] * S_W, s[(4 * q + 1) * 33] * S_W, s[(4 * q + 2) * 33] * S_W, s[(4 * q + 3) * 33] * S_W);
        o1[q] = pk_fp8x4(s[(16 + 4 * q) * 33] * S_W, s[(17 + 4 * q) * 33] * S_W, s[(18 + 4 * q) * 33] * S_W, s[(19 + 4 * q) * 33] * S_W); }
    unsigned char* d = c.D + (size_t)n * c.K + kh;
    *(GAS u32x4*)d = o0; *(GAS u32x4*)(d + 16) = o1;
    LDS_WAIT(); asm volatile("" ::: "memory");
}
__device__ __forceinline__ void conv8_one(const float* wg, const float* wu, const float* wd, unsigned char* ws, unsigned it, LAS float* scr, int lane) {
    const ConvItem c = conv8_decode(wg, wu, wd, ws, it); float r[32]; conv8_issue(c, r, lane); conv8_finish(c, r, scr, lane);
}
constexpr unsigned CV_BATCH = 64;
__device__ __forceinline__ void conv8_dynamic(const float* wg, const float* wu, const float* wd, unsigned char* ws, unsigned* ctr, unsigned* done_ctr, unsigned until_done,
                                              LAS float* scr, volatile LAS unsigned* sh, int tid, int wave, int lane) {
    for (;;) {
        if (tid == 0) { sh[0] = __hip_atomic_fetch_add(ctr, CV_BATCH, __ATOMIC_RELAXED, __HIP_MEMORY_SCOPE_AGENT);
                        sh[1] = until_done ? __hip_atomic_load(done_ctr, __ATOMIC_RELAXED, __HIP_MEMORY_SCOPE_AGENT) : 0u; }
        __syncthreads();
        const unsigned b0 = sh[0]; const bool stop = until_done && sh[1] >= until_done;
        __syncthreads();
        if (b0 >= CV_TOTAL) break;
#pragma unroll 1
        for (unsigned q = 0; q < CV_BATCH / 8; ++q) { const unsigned it = b0 + (unsigned)wave * (CV_BATCH / 8) + q; if (it < CV_TOTAL) conv8_one(wg, wu, wd, ws, it, scr, lane); }
        if (stop) break;
    }
}
struct NoSide { static constexpr bool ON = false; };

namespace pg8 {
constexpr int BM = 256, BK = 64, HALF = 128, HTB = HALF * BK * 2, STAGE_BYTES = 8 * HTB, NXCD = 8, WGM = 8;
__host__ __device__ __forceinline__ int lds_byte(int r, int c) { const int st = (r >> 4) * 2 + (c >> 5), rr = r & 15, cc = c & 31, ob = rr * 64 + cc * 2; return st * 1024 + (ob ^ (((ob >> 9) & 1) << 5)); }
__host__ __device__ __forceinline__ void stage_rc(int b, int& R, int& C) { const int st = b / 1024, sb = b % 1024, swz = sb ^ (((sb >> 9) & 1) << 5); R = (st >> 1) * 16 + swz / 64; C = (st & 1) * 32 + (swz % 64) / 2; }
__host__ __device__ __forceinline__ int perm32(int rho) { const int n = rho >> 4, i = rho & 15; return 8 * (i >> 2) + 4 * n + (i & 3); }

struct Unit { int pm, pn, g; };

struct DenseOrder {
    int nM, nN, nwg, G, c, reps;
    __device__ void init(int M_, int N_, int G_, int c_, int reps_ = 1) { nM = M_ / BM; nN = N_ / BM; nwg = nM * nN; G = G_; c = c_; reps = reps_; }
    __device__ bool next(int i, Unit& u) const {
        const int mine = (nwg - c + G - 1) / G; if (mine <= 0 || i >= mine * reps) return false; i %= mine;
        const long L = (long)i * G + c;
        int wgid = (int)L; { const int q = nwg / NXCD, r = nwg % NXCD, xcd = wgid % NXCD, off = wgid / NXCD; wgid = (xcd < r ? xcd * (q + 1) : r * (q + 1) + (xcd - r) * q) + off; }
        const int nig = WGM * nN, gid = wgid / nig, fm = gid * WGM, gsz = (nM - fm) < WGM ? (nM - fm) : WGM;
        u.pm = fm + ((wgid % nig) % gsz); u.pn = (wgid % nig) / gsz; u.g = 0; return true;
    }
};
struct GroupOrder {
    int nPM, nPN, total, G, c, reps;
    __device__ void init(int nPM_, int nPN_, int groups, int G_, int c_, int reps_ = 1) { nPM = nPM_; nPN = nPN_; total = nPM_ * nPN_ * groups; G = G_; c = c_; reps = reps_; }
    __device__ bool next(int i, Unit& u) const {
        const int mine = (total - c + G - 1) / G; if (mine <= 0 || i >= mine * reps) return false; i %= mine;
        const int L = i * G + c;
        const int per = nPM * nPN; u.g = L / per; const int rem = L % per; u.pn = rem / nPM; u.pm = rem % nPM; return true;
    }
};

struct DenseProb {
    static constexpr bool BKN = false, FP8 = false;
    const char* A; const char* Bt; int KB;
    __device__ __forceinline__ unsigned a_row(const Unit& u, int r) const { return (unsigned)(u.pm * BM + r); }
    __device__ __forceinline__ const char* b_base(const Unit& u, int half) const { return Bt + ((size_t)u.pn * BM + (size_t)half * HALF) * KB; }
    __device__ __forceinline__ size_t b_kstep() const { return (size_t)BK * 2; }
    __device__ __forceinline__ unsigned b_pitch() const { return (unsigned)KB; }
};
struct Moe1Prob {
    static constexpr bool BKN = false, FP8 = true;
    const char* A; const char* Bt; int KB; const int* tok;
    __device__ __forceinline__ unsigned a_row(const Unit& u, int r) const { return (unsigned)tok[u.g * EROWS + u.pm * BM + r]; }
    __device__ __forceinline__ const char* b_base(const Unit& u, int half) const { return Bt + ((size_t)u.g * 4096 + (size_t)u.pn * BM + (size_t)half * HALF) * KB; }
    __device__ __forceinline__ size_t b_kstep() const { return (size_t)BK * 2; }
    __device__ __forceinline__ unsigned b_pitch() const { return (unsigned)KB; }
};
struct Moe2Prob {
    static constexpr bool BKN = false, FP8 = true;
    const char* A; const char* Bt; int KB;
    __device__ __forceinline__ unsigned a_row(const Unit& u, int r) const { return (unsigned)(u.g * EROWS + u.pm * BM + r); }
    __device__ __forceinline__ const char* b_base(const Unit& u, int half) const { return Bt + ((size_t)u.g * DM + (size_t)u.pn * BM + (size_t)half * HALF) * KB; }
    __device__ __forceinline__ size_t b_kstep() const { return (size_t)BK * 2; }
    __device__ __forceinline__ unsigned b_pitch() const { return (unsigned)KB; }
};

struct EpiInProj {
    static constexpr bool PERM = true;
    h16* O; const float* rope;
    __device__ __forceinline__ void operator()(const f32x4 (&acc)[2][2][4][2], const Unit& u, int wr, int wc, int fr, int fq) const {
        const int row0 = u.pm * BM + wr * 64 + fr;
        const int ct0 = u.pn * BM;
        const bool rt0 = (ct0 < OFF_VA) || (ct0 >= OFF_QB && ct0 < OFF_VB), rt1 = (ct0 + HALF < OFF_VA) || (ct0 + HALF >= OFF_QB && ct0 + HALF < OFF_VB);
        const bool any_rope = (rt0 || rt1) && ((wc & 1) == 0);
        float c[8], s[8];
        if (any_rope) { const float* rp = rope + (size_t)(row0 & (SEQ - 1)) * 16;
            const f32x4 c0 = *(const f32x4*)(rp), c1 = *(const f32x4*)(rp + 4), s0 = *(const f32x4*)(rp + 8), s1 = *(const f32x4*)(rp + 12);
#pragma unroll
            for (int j = 0; j < 4; ++j) { c[j] = c0[j]; c[4 + j] = c1[j]; s[j] = s0[j]; s[4 + j] = s1[j]; } }
        else {
#pragma unroll
            for (int j = 0; j < 8; ++j) { c[j] = 1.f; s[j] = 0.f; } }
        const float cd16[8] = {-9.576594803e-01f, -9.992462593e-01f, 8.243765146e-01f, 9.932003012e-01f, 9.997440109e-01f, 9.999903729e-01f, 9.999996380e-01f, 9.999999864e-01f};
        const float sd16[8] = {-2.879033167e-01f, 3.881898152e-02f, 5.660418378e-01f, 1.164180468e-01f, 2.262548617e-02f, 4.387956730e-03f, 8.509272408e-04f, 1.650141653e-04f};
        const float cd80[8] = {-1.103872438e-01f, -9.812132344e-01f, -9.911539132e-01f, 8.345872775e-01f, 9.936068238e-01f, 9.997593311e-01f, 9.999909490e-01f, 9.999996596e-01f};
        const float sd80[8] = {-9.938886539e-01f, 1.929263812e-01f, 1.327174458e-01f, 5.508757358e-01f, 1.128958803e-01f, 2.193809395e-02f, 4.254623881e-03f, 8.250707366e-04f};
        const float sg = (fq == 0) ? -1.f : 1.f;
#pragma unroll
        for (int ai = 0; ai < 2; ++ai)
#pragma unroll
            for (int m = 0; m < 4; ++m) {
                const int row = row0 + ai * HALF + m * 16;
                if (any_rope && (ai | m) != 0) {
#pragma unroll
                    for (int j = 0; j < 8; ++j) { const float cdv = (m == 0) ? cd80[j] : cd16[j], sdv = (m == 0) ? sd80[j] : sd16[j];
                        const float cn = c[j] * cdv - s[j] * sdv, sn = s[j] * cdv + c[j] * sdv; c[j] = cn; s[j] = sn; }
                }
#pragma unroll
                for (int bj = 0; bj < 2; ++bj) {
                    const bool do_rope = (bj ? rt1 : rt0) && ((wc & 1) == 0);
                    const int col0 = ct0 + bj * HALF + wc * 32 + 8 * fq;
                    f32x4 v0 = acc[ai][bj][m][0], v1 = acc[ai][bj][m][1];
                    if (do_rope) {
                        f32x4 p0, p1;
#pragma unroll
                        for (int j = 0; j < 4; ++j) { p0[j] = __shfl_xor(v0[j], 16); p1[j] = __shfl_xor(v1[j], 16); }
                        if (fq < 2) {
#pragma unroll
                            for (int j = 0; j < 4; ++j) { v0[j] = v0[j] * c[j] + (p0[j] * s[j]) * sg; v1[j] = v1[j] * c[4 + j] + (p1[j] * s[4 + j]) * sg; } }
                    }
                    u32x4 w; w.x = pk_h2(v0[0], v0[1]); w.y = pk_h2(v0[2], v0[3]); w.z = pk_h2(v1[0], v1[1]); w.w = pk_h2(v1[2], v1[3]);
                    *(u32x4*)(O + (size_t)row * NIN + col0) = w;
                }
            }
    }
};
struct EpiResidual {
    static constexpr bool PERM = true;
    const float* base; h16* out;
    __device__ __forceinline__ void operator()(const f32x4 (&acc)[2][2][4][2], const Unit& u, int wr, int wc, int fr, int fq) const {
        const int row0 = u.pm * BM + wr * 64 + fr, col0 = u.pn * BM + wc * 32 + 8 * fq;
#pragma unroll
        for (int ai = 0; ai < 2; ++ai) {
            f32x4 xb[4][2][2];
#pragma unroll
            for (int m = 0; m < 4; ++m) { const size_t off = (size_t)(row0 + ai * HALF + m * 16) * DM + col0;
#pragma unroll
                for (int bj = 0; bj < 2; ++bj) { xb[m][bj][0] = __builtin_nontemporal_load((const f32x4*)(base + off + bj * HALF)); xb[m][bj][1] = __builtin_nontemporal_load((const f32x4*)(base + off + bj * HALF + 4)); } }
#pragma unroll
            for (int m = 0; m < 4; ++m) { const size_t off = (size_t)(row0 + ai * HALF + m * 16) * DM + col0;
#pragma unroll
                for (int bj = 0; bj < 2; ++bj) { const f32x4 v0 = xb[m][bj][0] + acc[ai][bj][m][0], v1 = xb[m][bj][1] + acc[ai][bj][m][1];
                    u32x4 w; w.x = pk_h2(v0[0], v0[1]); w.y = pk_h2(v0[2], v0[3]); w.z = pk_h2(v1[0], v1[1]); w.w = pk_h2(v1[2], v1[3]);
                    *(u32x4*)(out + off + bj * HALF) = w; } }
            asm volatile("" ::: "memory");
        }
    }
};
struct EpiSwiGLU {
    static constexpr bool PERM = true;
    unsigned char* O;
    __device__ __forceinline__ void operator()(const f32x4 (&acc)[2][2][4][2], const Unit& u, int wr, int wc, int fr, int fq) const {
        const int row0 = u.g * EROWS + u.pm * BM + wr * 64 + fr, col0 = u.pn * HALF + wc * 32 + 8 * fq;
        constexpr float IS = 1.0f / (S_H2 * S_W);
#pragma unroll
        for (int ai = 0; ai < 2; ++ai)
#pragma unroll
            for (int m = 0; m < 4; ++m) {
                float r[8];
#pragma unroll
                for (int n = 0; n < 2; ++n)
#pragma unroll
                    for (int j = 0; j < 4; ++j) { const float a = acc[ai][0][m][n][j] * IS, up = acc[ai][1][m][n][j] * (IS * S_HM);
                        r[n * 4 + j] = clamp8(a * __builtin_amdgcn_rcpf(1.0f + __builtin_amdgcn_exp2f(-a * LOG2E)) * up); }
                u32x2 w; w.x = pk_fp8x4(r[0], r[1], r[2], r[3]); w.y = pk_fp8x4(r[4], r[5], r[6], r[7]);
                *(u32x2*)(O + (size_t)(row0 + ai * HALF + m * 16) * FF + col0) = w;
            }
    }
};
struct EpiDown {
    static constexpr bool PERM = true;
    unsigned char* O; const float* gate;
    __device__ __forceinline__ void operator()(const f32x4 (&acc)[2][2][4][2], const Unit& u, int wr, int wc, int fr, int fq) const {
        const int row0 = u.g * EROWS + u.pm * BM + wr * 64 + fr, col0 = u.pn * BM + wc * 32 + 8 * fq;
        float gts[2][4];
#pragma unroll
        for (int ai = 0; ai < 2; ++ai)
#pragma unroll
            for (int m = 0; m < 4; ++m) gts[ai][m] = gate[row0 + ai * HALF + m * 16];
#pragma unroll
        for (int ai = 0; ai < 2; ++ai)
#pragma unroll
            for (int m = 0; m < 4; ++m) {
                const int row = row0 + ai * HALF + m * 16; const float gt = gts[ai][m] * (S_YE / (S_HM * S_W));
#pragma unroll
                for (int bj = 0; bj < 2; ++bj) { const f32x4 v0 = acc[ai][bj][m][0] * gt, v1 = acc[ai][bj][m][1] * gt;
                    u32x2 w; w.x = pk_fp8x4(clamp8(v0[0]), clamp8(v0[1]), clamp8(v0[2]), clamp8(v0[3])); w.y = pk_fp8x4(clamp8(v1[0]), clamp8(v1[1]), clamp8(v1[2]), clamp8(v1[3]));
                    *(u32x2*)(O + (size_t)row * DM + col0 + bj * HALF) = w; }
            }
    }
};

template <class Prob, class Epi, class Sched, bool ALIGN_EPI, class Side = NoSide>
__device__ __forceinline__ void gemm_phase(LAS unsigned char* lds, const Prob P, const Sched& S, const Epi& E, const Side SD = Side()) {
    const int tid = threadIdx.x, wid = __builtin_amdgcn_readfirstlane(tid >> 6), lane = tid & 63, wr = wid >> 2, wc = wid & 3, fr = lane & 15, fq = lane >> 4;
    const int KB = P.KB, nt = KB / 128;
    int RA[2]; unsigned CA2[2], voffB[2];
#pragma unroll
    for (int i = 0; i < 2; ++i) { int R, C; stage_rc(tid * 16 + i * 8192, R, C); const int Rb = Epi::PERM ? ((R & ~31) + perm32(R & 31)) : R;
        RA[i] = R; CA2[i] = (unsigned)C * 2u;
        if constexpr (Prob::BKN) {
            static_assert(Epi::PERM, "the [K][N] B path is written for PERM epilogues");
            const int r = 4 * wid + 32 * i + (lane >> 4), g = (r & 3) | (((r >> 3) & 1) << 2), c = (lane & 15) ^ (g << 1);
            voffB[i] = (unsigned)r * P.b_pitch() + (unsigned)c * 16u;
        } else voffB[i] = (unsigned)(Rb * KB) + (unsigned)C * 2u; }
    const unsigned kstep = (unsigned)(BK * 2);
    const size_t kstepB = P.b_kstep();
    int btr[2];
    { const int q = fr >> 2, p = fr & 3, X = ((q | ((fq & 1) << 2)) << 2) | (q & 1);
#pragma unroll
      for (int n = 0; n < 2; ++n) btr[n] = (8 * fq + q) * 256 + (((8 * wc + 2 * p + n) ^ X) * 8); }
    const unsigned lds_u32 = (unsigned)(__UINTPTR_TYPE__)lds;
    unsigned bta[2]; bta[0] = lds_u32 + (unsigned)btr[0]; bta[1] = lds_u32 + (unsigned)btr[1];
    const unsigned rowb = (unsigned)KB;
    const unsigned ldsw = (unsigned)wid * 1024u;
    const int aoff = lds_byte(wr * 64 + fr, fq * 8), boff = lds_byte(wc * 32 + fr, fq * 8);
#define PG8_SA(b, h) (((b) * 2 + (h)) * HTB)
#define PG8_SB(b, h) ((4 + (b) * 2 + (h)) * HTB)
#define PG8_STAGE_B(bufoff, gbase) do { _Pragma("unroll") for (int _i = 0; _i < 2; ++_i) \
        __builtin_amdgcn_global_load_lds((const unsigned*)((const char*)(gbase) + voffB[_i]), (LAS unsigned*)(lds + (bufoff) + ldsw + _i * 8192), 16, 0, 0); } while (0)
#define PG8_STAGE_A(bufoff, kb, offs) do { _Pragma("unroll") for (int _i = 0; _i < 2; ++_i) \
        __builtin_amdgcn_global_load_lds((const unsigned*)(P.A + (size_t)(kb) + (offs)[_i]), (LAS unsigned*)(lds + (bufoff) + ldsw + _i * 8192), 16, 0, 0); } while (0)
#define PG8_LDA(dst, b, h) do { if constexpr (Prob::FP8) { _Pragma("unroll") for (int m = 0; m < 4; ++m) { dst##8[m].lo = *(const LAS v4i_*)(lds + PG8_SA(b, h) + aoff + m * 2048); dst##8[m].hi = *(const LAS v4i_*)(lds + PG8_SA(b, h) + aoff + m * 2048 + 1024); } } \
        else { _Pragma("unroll") for (int m = 0; m < 4; ++m) _Pragma("unroll") for (int k = 0; k < 2; ++k) dst[m][k] = *(const LAS half8*)(lds + PG8_SA(b, h) + aoff + m * 2048 + k * 1024); } } while (0)
#define PG8_LDB(dst, b, h) do { if constexpr (Prob::BKN) { _Pragma("unroll") for (int n = 0; n < 2; ++n) { const unsigned ad_ = bta[n] + (unsigned)PG8_SB(b, h); _Pragma("unroll") for (int k = 0; k < 2; ++k) { \
            asm volatile("ds_read_b64_tr_b16 %0, %1 offset:%c2" : "=&v"(dst##lo[n][k]) : "v"(ad_), "i"(k * 8192) : "memory"); \
            asm volatile("ds_read_b64_tr_b16 %0, %1 offset:%c2" : "=&v"(dst##hi[n][k]) : "v"(ad_), "i"(k * 8192 + 1024) : "memory"); } } } \
        else if constexpr (Prob::FP8) { _Pragma("unroll") for (int n = 0; n < 2; ++n) { dst##8[n].lo = *(const LAS v4i_*)(lds + PG8_SB(b, h) + boff + n * 2048); dst##8[n].hi = *(const LAS v4i_*)(lds + PG8_SB(b, h) + boff + n * 2048 + 1024); } } \
        else { _Pragma("unroll") for (int n = 0; n < 2; ++n) _Pragma("unroll") for (int k = 0; k < 2; ++k) dst[n][k] = *(const LAS half8*)(lds + PG8_SB(b, h) + boff + n * 2048 + k * 1024); } } while (0)
#define PG8_BFIX(dst) do { if constexpr (Prob::BKN) { typedef short s16x8_ __attribute__((ext_vector_type(8))); _Pragma("unroll") for (int n = 0; n < 2; ++n) _Pragma("unroll") for (int k = 0; k < 2; ++k) { \
            const s16x8_ v_ = __builtin_shufflevector(dst##lo[n][k], dst##hi[n][k], 0, 1, 2, 3, 4, 5, 6, 7); dst[n][k] = __builtin_bit_cast(half8, v_); } } } while (0)
#define PG8_MMA(ai, bj, At, Bt) do { __builtin_amdgcn_s_setprio(1); _Pragma("unroll") for (int m = 0; m < 4; ++m) _Pragma("unroll") for (int n = 0; n < 2; ++n) { \
        if constexpr (Prob::FP8) asm volatile("v_mfma_f32_16x16x128_f8f6f4 %0, %1, %2, %0" : "+v"(acc[ai][bj][m][n]) : "v"(Bt##8[n]), "v"(At##8[m])); \
        else { _Pragma("unroll") for (int k = 0; k < 2; ++k) acc[ai][bj][m][n] = __builtin_amdgcn_mfma_f32_16x16x32_f16(Bt[n][k], At[m][k], acc[ai][bj][m][n], 0, 0, 0); } } \
        __builtin_amdgcn_s_setprio(0); } while (0)
#define PG8_WAIT_V(n) asm volatile("s_waitcnt vmcnt(" #n ")" ::: "memory")
#define PG8_WAIT_L(n) asm volatile("s_waitcnt lgkmcnt(" #n ")" ::: "memory")
#define PG8_BAR __builtin_amdgcn_s_barrier()
#define PG8_SCHED __builtin_amdgcn_sched_barrier(0)
#define PG8_SIDE_ISSUE(slot) do { if constexpr (Side::ON) { sfly = SD.L->pending() && (((slot) % SD.every) == 0); \
        if (sfly) { scc = SD.L->chunk(SD.L->done); const float* sp_ = SD.L->src_of(SD.L->wa, SD.L->wb, scc); \
            asm volatile("global_load_dwordx4 %0, %2, off\n\tglobal_load_dwordx4 %1, %2, off offset:16" : "=&v"(sr0), "=&v"(sr1) : "v"(sp_) : "memory"); } } } while (0)
#define PG8_SIDE_FINISH() do { if constexpr (Side::ON) { if (sfly) { asm volatile("" : "+v"(sr0), "+v"(sr1)); SD.L->store(SD.L->da, scc, sr0, sr1); SD.L->done += 1; } PG8_SCHED; } } while (0)
#define PG8_WAIT_VS(extra) do { if constexpr (Side::ON) { if (sfly) { if ((extra) == 2) PG8_WAIT_V(10); else PG8_WAIT_V(9); } else PG8_WAIT_V(8); } else PG8_WAIT_V(8); } while (0)
#define PG8_AOFF(dst, un) do { _Pragma("unroll") for (int _h = 0; _h < 2; ++_h) _Pragma("unroll") for (int _i = 0; _i < 2; ++_i) dst[_h][_i] = P.a_row(un, _h * HALF + RA[_i]) * rowb + CA2[_i]; } while (0)
    Unit cur, nxt; int ui = 0;
    if (!S.next(0, cur)) return;
    bool sfly = false; f32x4 sr0, sr1; unsigned scc = 0;
    f32x4 acc[2][2][4][2];
#pragma unroll
    for (int a = 0; a < 2; ++a)
#pragma unroll
        for (int b = 0; b < 2; ++b)
#pragma unroll
            for (int m = 0; m < 4; ++m)
#pragma unroll
                for (int n = 0; n < 2; ++n) acc[a][b][m][n] = (f32x4){0.f, 0.f, 0.f, 0.f};
    typedef int v4i_ __attribute__((ext_vector_type(4))); typedef int v8i_ __attribute__((ext_vector_type(8)));
    half8 At[4][2], B0[2][2], B1[2][2];
    s16x4 B0lo[2][2], B0hi[2][2], B1lo[2][2], B1hi[2][2];
    v8i_ At8[4], B08[2], B18[2];
    unsigned cuo[2][2], nxo[2][2];
    PG8_AOFF(cuo, cur);
    const char* cB0 = P.b_base(cur, 0); const char* cB1 = P.b_base(cur, 1);
    PG8_STAGE_B(PG8_SB(0, 0), cB0); PG8_STAGE_B(PG8_SB(0, 1), cB1); PG8_STAGE_A(PG8_SA(0, 0), 0, cuo[0]); PG8_STAGE_A(PG8_SA(0, 1), 0, cuo[1]);
    if (wr == 1) PG8_BAR;
    PG8_WAIT_V(2); PG8_BAR;
    PG8_STAGE_B(PG8_SB(1, 0), cB0 + kstepB); PG8_STAGE_A(PG8_SA(1, 0), kstep, cuo[0]); PG8_STAGE_B(PG8_SB(1, 1), cB1 + kstepB);
    PG8_WAIT_V(6); PG8_BAR;
    for (;;) {
        const bool has_next = S.next(ui + 1, nxt);
        if (!has_next) nxt = cur;
        PG8_AOFF(nxo, nxt);
        const char* nB0 = P.b_base(nxt, 0); const char* nB1 = P.b_base(nxt, 1);
        for (int t = 0; t < nt; t += 2) {
            const bool last = (t == nt - 2);
            const unsigned k1 = (unsigned)(t + 1) * kstep;
            const unsigned k2 = last ? 0u : (unsigned)(t + 2) * kstep, k3 = k2 + kstep;
            const char* b20 = last ? nB0 : cB0 + (size_t)(t + 2) * kstepB; const char* b21 = last ? nB1 : cB1 + (size_t)(t + 2) * kstepB;
            const char* b30 = b20 + kstepB; const char* b31 = b21 + kstepB;
            unsigned o20[2], o21[2];
#pragma unroll
            for (int i = 0; i < 2; ++i) { o20[i] = last ? nxo[0][i] : cuo[0][i]; o21[i] = last ? nxo[1][i] : cuo[1][i]; }
            PG8_LDB(B0, 0, 0); PG8_LDB(B1, 0, 1); PG8_SCHED; PG8_LDA(At, 0, 0); PG8_STAGE_A(PG8_SA(1, 1), k1, cuo[1]); PG8_SIDE_ISSUE((ui * nt + t) >> 1);
            PG8_WAIT_VS(2);
            PG8_WAIT_L(0); PG8_SCHED; PG8_BFIX(B0); PG8_BFIX(B1); PG8_BAR; PG8_MMA(0, 0, At, B0); PG8_MMA(0, 1, At, B1); PG8_BAR; PG8_SCHED;
            PG8_LDA(At, 0, 1); PG8_STAGE_B(PG8_SB(0, 0), b20); PG8_STAGE_B(PG8_SB(0, 1), b21); PG8_STAGE_A(PG8_SA(0, 0), k2, o20);
            PG8_WAIT_VS(2); PG8_WAIT_L(0); PG8_BAR; PG8_MMA(1, 0, At, B0); PG8_MMA(1, 1, At, B1); PG8_BAR; PG8_SCHED;
            PG8_LDB(B0, 1, 0); PG8_LDB(B1, 1, 1); PG8_SCHED; PG8_LDA(At, 1, 0); PG8_STAGE_A(PG8_SA(0, 1), k2, o21);
            PG8_WAIT_V(8);
            PG8_WAIT_L(0); PG8_SCHED; PG8_BFIX(B0); PG8_BFIX(B1); PG8_BAR; PG8_MMA(0, 0, At, B0); PG8_MMA(0, 1, At, B1); PG8_BAR; PG8_SCHED;
            PG8_SIDE_FINISH();
            PG8_LDA(At, 1, 1); PG8_STAGE_B(PG8_SB(1, 0), b30); PG8_STAGE_B(PG8_SB(1, 1), b31); PG8_STAGE_A(PG8_SA(1, 0), k3, o20);
            PG8_WAIT_VS(1); PG8_WAIT_L(0); PG8_BAR; PG8_MMA(1, 0, At, B0); PG8_MMA(1, 1, At, B1); PG8_BAR; PG8_SCHED;
            if constexpr (Side::ON) sfly = false;
        }
        if constexpr (ALIGN_EPI) { if (wr == 0) PG8_BAR; }
        if constexpr (Prob::FP8) asm volatile("s_nop 15\n\ts_nop 15" ::: "memory");
        E(acc, cur, wr, wc, fr, fq);
        if (!has_next) break;
#pragma unroll
        for (int a = 0; a < 2; ++a)
#pragma unroll
            for (int b = 0; b < 2; ++b)
#pragma unroll
                for (int m = 0; m < 4; ++m)
#pragma unroll
                    for (int n = 0; n < 2; ++n) acc[a][b][m][n] = (f32x4){0.f, 0.f, 0.f, 0.f};
        cur = nxt; cB0 = nB0; cB1 = nB1; ++ui;
#pragma unroll
        for (int h = 0; h < 2; ++h)
#pragma unroll
            for (int i = 0; i < 2; ++i) cuo[h][i] = nxo[h][i];
        if constexpr (ALIGN_EPI) { if (wr == 1) PG8_BAR; }
    }
    PG8_WAIT_V(0);
    if constexpr (!ALIGN_EPI) { if (wr == 0) PG8_BAR; }
    PG8_BAR;
#undef PG8_SA
#undef PG8_SB
#undef PG8_STAGE_A
#undef PG8_STAGE_B
#undef PG8_LDA
#undef PG8_LDB
#undef PG8_BFIX
#undef PG8_MMA
#undef PG8_WAIT_V
#undef PG8_WAIT_L
#undef PG8_BAR
#undef PG8_SCHED
#undef PG8_AOFF
#undef PG8_SIDE_ISSUE
#undef PG8_SIDE_FINISH
#undef PG8_WAIT_VS
}
}

#define XB_TMO      128
#define XB_XCNT(j)  (256  + 64 * (j))
#define XB_XSUB(j)  (1280 + 64 * (j))
#define XB_XGEN(j)  (2304 + 64 * (j))
#define XB_TOP      3328
#define XB_TOPGEN   3392
#define XCD_BAR_WORDS 3456
#define XB_SPIN_CAP (1u << 18)
__device__ __forceinline__ unsigned xb_ld(unsigned* p)              { return __hip_atomic_load(p, __ATOMIC_RELAXED, __HIP_MEMORY_SCOPE_AGENT); }
__device__ __forceinline__ unsigned xb_add(unsigned* p, unsigned v) { return __hip_atomic_fetch_add(p, v, __ATOMIC_RELAXED, __HIP_MEMORY_SCOPE_AGENT); }
__device__ __forceinline__ unsigned xb_xcc_id() { return (unsigned)__builtin_amdgcn_s_getreg((3 << 11) | 20) & 0xFu; }
#define XB_SPIN(cond, bar) do { unsigned _sp = 0; while (cond) { __builtin_amdgcn_s_sleep(1); \
    if ((++_sp & 255u) == 0u) { if (xb_ld(&(bar)[XB_TMO])) break; if (_sp > XB_SPIN_CAP) { atomicAdd(&(bar)[XB_TMO], 1u); break; } } } } while (0)
struct XcdBarrier { unsigned* bar; unsigned x; volatile LAS unsigned* st; };
__device__ __forceinline__ XcdBarrier xcd_barrier_post(unsigned* bar, volatile LAS unsigned* st) {
    XcdBarrier b; b.bar = bar; b.x = xb_xcc_id(); b.st = st;
    if (threadIdx.x == 0) (void)xb_add(&bar[XB_XCNT(b.x)], 1u);
    return b;
}
__device__ __forceinline__ void xcd_barrier_complete(unsigned* bar, unsigned x, unsigned& nloc, unsigned& nx) {
    const unsigned G = gridDim.x * gridDim.y * gridDim.z;
    unsigned sum, cnt, mine, sp = 0u;
    for (;;) {
        sum = 0u; cnt = 0u; mine = 0u;
#pragma unroll
        for (unsigned j = 0; j < 16; ++j) { const unsigned c = xb_ld(&bar[XB_XCNT(j)]); sum += c; cnt += (c > 0u) ? 1u : 0u; mine = (j == x) ? c : mine; }
        if (sum == G) break;
        __builtin_amdgcn_s_sleep(1);
        if ((++sp & 255u) == 0u) { if (xb_ld(&bar[XB_TMO])) break; if (sp > XB_SPIN_CAP) { atomicAdd(&bar[XB_TMO], 1u); break; } }
    }
    nloc = mine > 0u ? mine : 1u; nx = cnt > 0u ? cnt : 1u;
}
__device__ __forceinline__ void xcd_barrier(const XcdBarrier& b) {
    asm volatile("s_waitcnt vmcnt(0)" ::: "memory");
    __syncthreads();
    if (threadIdx.x == 0) {
        unsigned* bar = b.bar;
        __builtin_amdgcn_s_waitcnt(0);
        unsigned nloc = b.st[0], nx = b.st[1];
        if (nloc == 0u) { xcd_barrier_complete(bar, b.x, nloc, nx); b.st[0] = nloc; b.st[1] = nx; }
        const unsigned old = xb_add(&bar[XB_XSUB(b.x)], 1u);
        const unsigned gen = old / nloc;
        if (old + 1u == (gen + 1u) * nloc) {
            __builtin_amdgcn_fence(__ATOMIC_RELEASE, "agent");
            asm volatile("s_waitcnt vmcnt(0)" ::: "memory");
            const unsigned og = xb_add(&bar[XB_TOP], 1u);
            const unsigned tg = og / nx;
            if (og + 1u == (tg + 1u) * nx) xb_add(&bar[XB_TOPGEN], 1u);
            else XB_SPIN(xb_ld(&bar[XB_TOPGEN]) == tg, bar);
            __builtin_amdgcn_fence(__ATOMIC_ACQUIRE, "agent");
            xb_add(&bar[XB_XGEN(b.x)], 1u);
            asm volatile("s_waitcnt vmcnt(0)" ::: "memory");
        } else {
            XB_SPIN(xb_ld(&bar[XB_XGEN(b.x)]) == gen, bar);
            __builtin_amdgcn_fence(__ATOMIC_ACQUIRE, "agent");
            asm volatile("s_waitcnt vmcnt(0)" ::: "memory");
        }
    }
    __syncthreads();
}

struct Frame {
    LAS unsigned char* lds;
    int tid, lane, wave, vcu, G;
    const float *x, *g_mix, *w_in, *a_sink, *g_out_a, *g_out_b, *w_out, *g_ffn, *w_router, *w_gate, *w_up, *w_down, *g_final;
    float* out; unsigned char* ws;
    unsigned long long tacc;
};

__device__ __forceinline__ void p0_transpose_item(const float* W, int K, int N, h16* WT, int k0, int n0, int drow0, float sc, LAS float* scr, int lane) {
#pragma unroll 8
    for (int i = 0; i < 32; ++i) { const int kk = 2 * i + (lane >> 5); scr[kk * 33 + (lane & 31)] = W[(size_t)(k0 + kk) * N + n0 + (lane & 31)]; }
    LDS_WAIT(); asm volatile("" ::: "memory");
    const int c = lane & 7;
#pragma unroll
    for (int j = 0; j < 4; ++j) { const int n = (lane >> 3) + 8 * j; const LAS float* s = scr + (8 * c) * 33 + n;
        u32x4 o; o.x = pk_h2(s[0 * 33] * sc, s[1 * 33] * sc); o.y = pk_h2(s[2 * 33] * sc, s[3 * 33] * sc); o.z = pk_h2(s[4 * 33] * sc, s[5 * 33] * sc); o.w = pk_h2(s[6 * 33] * sc, s[7 * 33] * sc);
        *(GAS u32x4*)(WT + (size_t)(drow0 + n) * K + k0 + 8 * c) = o; }
    LDS_WAIT(); asm volatile("" ::: "memory");
}
__device__ __forceinline__ void sincos_d(double a, float& s, float& c) {
    const double q = __builtin_rint(a * 0.63661977236758134308);
    double r = __builtin_fma(-q, 1.570796325802803, a); r = __builtin_fma(-q, 9.920935796805404e-10, r);
    const double r2 = r * r;
    double sp = -7.6471637318198164759e-13;
    sp = sp * r2 + 1.6059043836821614599e-10; sp = sp * r2 - 2.5052108385441718775e-08; sp = sp * r2 + 2.7557319223985890653e-06;
    sp = sp * r2 - 1.9841269841269841270e-04; sp = sp * r2 + 8.3333333333333333333e-03; sp = sp * r2 - 1.6666666666666666667e-01;
    const double sn = r + r * r2 * sp;
    double cp = 4.7794773323873852974e-14;
    cp = cp * r2 - 1.1470745597729724714e-11; cp = cp * r2 + 2.0876756987868098979e-09; cp = cp * r2 - 2.7557319223985890653e-07;
    cp = cp * r2 + 2.4801587301587301587e-05; cp = cp * r2 - 1.3888888888888888889e-03; cp = cp * r2 + 4.1666666666666666667e-02; cp = cp * r2 - 0.5;
    const double cs = 1.0 + r2 * cp;
    const int qi = (int)q & 3;
    const double ss = (qi & 1) ? cs : sn, cc = (qi & 1) ? sn : cs;
    s = (float)((qi & 2) ? -ss : ss); c = (float)(((qi + 1) & 2) ? -cc : cc);
}

__device__ __forceinline__ void p0_prologue(Frame& F) {
    LAS float* scr = (LAS float*)(F.lds + F.wave * 16384);
    const int gw = F.vcu * NWAVES + F.wave, NGW = F.G * NWAVES;
    {
        const double invf[8] = {1.0, 0.19392274474868576, 0.03760603093086393, 0.007292664737217109, 0.001414213562373095, 0.0002742481756762073, 5.318295896944988e-05, 1.031338537721246e-05};
        float* rope = (float*)(F.ws + WS_ROPE);
        for (int idx = F.vcu * 512 + F.tid; idx < SEQ * 8; idx += F.G * 512) {
            const int pos = idx >> 3, i = idx & 7;
            double f = invf[0];
#pragma unroll
            for (int j = 1; j < 8; ++j) f = (i == j) ? invf[j] : f;
            float s, c; sincos_d((double)pos * f, s, c);
            rope[pos * 16 + i] = c; rope[pos * 16 + 8 + i] = s;
        }
    }
    {
        h16* H = (h16*)(F.ws + WS_H);
        for (int m = gw; m < M; m += NGW) {
            const GAS f32x4* xr = (const GAS f32x4*)(F.x + (size_t)m * DM) + F.lane;
            f32x4 v[4]; float s = 0.f;
#pragma unroll
            for (int j = 0; j < 4; ++j) { v[j] = __builtin_nontemporal_load(xr + 64 * j); s += (v[j].x * v[j].x + v[j].y * v[j].y) + (v[j].z * v[j].z + v[j].w * v[j].w); }
            const float rs = 1.0f / sqrtf(wave_sum(s) * (1.0f / DM) + NORM_EPS);
            GAS u32x2* o8 = (GAS u32x2*)(H + (size_t)m * DM) + F.lane;
#pragma unroll
            for (int j = 0; j < 4; ++j) { const f32x4 g = ((const GAS f32x4*)F.g_mix)[F.lane + 64 * j]; const f32x4 y = v[j] * rs * g;
                u32x2 w; w.x = pk_h2(y.x, y.y); w.y = pk_h2(y.z, y.w); o8[64 * j] = w; }
        }
    }
    {
        constexpr int I_IN = (DM / 64) * (NIN / 32), I_OUT = (DM / 64) * (DM / 32);
        constexpr int NITEMS = I_IN + I_OUT;
        for (int it = gw; it < NITEMS; it += NGW) {
            int r = it;
            if (r < I_IN) { const int nblk = NIN / 32, kb = r / nblk, nb = r % nblk, n0 = 32 * nb;
                const float sc = (n0 < OFF_KA || (n0 >= OFF_QB && n0 < OFF_KB)) ? QSCALE : 1.0f;
                p0_transpose_item(F.w_in, DM, NIN, (h16*)(F.ws + WS_WIN), 64 * kb, n0, n0, sc, scr, F.lane); continue; }
            r -= I_IN;
            { const int nblk = DM / 32, kb = r / nblk, nb = r % nblk, n0 = 32 * nb;
              p0_transpose_item(F.w_out, DM, DM, (h16*)(F.ws + WS_WOUT), 64 * kb, n0, n0, 1.0f, scr, F.lane); }
        }
    }
}

#define TSEC_BEGIN(code) unsigned long long tsec_##code = 0; if (TIME_PHASE == (code)) tsec_##code = __builtin_amdgcn_s_memrealtime()
#define TSEC_END(code) do { if (TIME_PHASE == (code)) F.tacc += __builtin_amdgcn_s_memrealtime() - tsec_##code; } while (0)
namespace att {
__device__ __forceinline__ int crow(int r, int hi) { return (r & 3) + 8 * (r >> 2) + 4 * hi; }
constexpr float THR = 8.0f;
constexpr int ATT_SIDE = 0;
constexpr int TILE_BYTES = 16384;
constexpr int WSF_OFF = 98304, STG_OFF = 100352;

__device__ __forceinline__ float max3f(float a, float b, float c) { float r; asm("v_max3_f32 %0, %1, %2, %3" : "=v"(r) : "v"(a), "v"(b), "v"(c)); return r; }
__device__ __forceinline__ float max16(const f32x16& p) {
    float a = max3f(p[0], p[1], p[2]), b = max3f(p[3], p[4], p[5]); a = max3f(a, p[6], p[7]); b = max3f(b, p[8], p[9]); a = max3f(a, p[10], p[11]); b = max3f(b, p[12], p[13]);
    return max3f(a, b, max3f(p[14], p[15], p[15])); }
__device__ __forceinline__ void tile_step(f32x16& o0, f32x16& o1, float& m, float& l, f32x16& negm, bool first, const half8 (&qr)[4],
                                          LAS const unsigned char* kt, LAS const unsigned char* vt, LAS float* wsf, int lane, int r32, int hi,
                                          int mode0, int mode1, int rel0, int lo, unsigned span) {
    f32x16 p0 = negm, p1 = negm;
    LAS const unsigned char* kb = kt + hi * 1024 + r32 * 16;
    const float NINF = -__builtin_inff();
    float rm = NINF;
    if (mode0) {
#pragma unroll
        for (int d0 = 0; d0 < 4; ++d0) p0 = __builtin_amdgcn_mfma_f32_32x32x16_f16(*(LAS const half8*)(kb + d0 * 2048), qr[d0], p0, 0, 0, 0);
        asm volatile("s_nop 15\n\ts_nop 7" : "+v"(p0));
        if (mode0 == 2) {
#pragma unroll
            for (int r = 0; r < 16; ++r) { const int rel = rel0 + (r & 3) + 8 * (r >> 2); if ((unsigned)(rel - lo) > span) p0[r] = NINF; }
        }
        rm = max16(p0);
    }
    if (mode1) {
#pragma unroll
        for (int d0 = 0; d0 < 4; ++d0) p1 = __builtin_amdgcn_mfma_f32_32x32x16_f16(*(LAS const half8*)(kb + d0 * 2048 + 512), qr[d0], p1, 0, 0, 0);
        asm volatile("s_nop 15\n\ts_nop 7" : "+v"(p1));
        if (mode1 == 2) {
#pragma unroll
            for (int r = 0; r < 16; ++r) { const int rel = rel0 + 32 + (r & 3) + 8 * (r >> 2); if ((unsigned)(rel - lo) > span) p1[r] = NINF; }
        }
        rm = fmaxf(rm, max16(p1));
    }
    { auto rr = __builtin_amdgcn_permlane32_swap(__float_as_uint(rm), __float_as_uint(rm), false, false); rm = fmaxf(__uint_as_float(rr[0]), __uint_as_float(rr[1])); }
    if (first || __any(rm > THR)) {
        const float dl = first ? fmaxf(rm, -100.f) : fmaxf(rm, 0.f); m += dl;
#pragma unroll
        for (int r = 0; r < 16; ++r) { p0[r] -= dl; p1[r] -= dl; negm[r] = -m; }
        if (!first) {
            const float f = __builtin_amdgcn_exp2f(-dl); l *= f;
            if (hi == 0) wsf[r32] = f;
            LDS_WAIT();
#pragma unroll
            for (int r = 0; r < 16; ++r) { const float fr_ = wsf[crow(r, hi)]; o0[r] *= fr_; o1[r] *= fr_; }
        }
    }
    LAS const unsigned char* vb = vt + (4 * hi + ((lane & 15) >> 2)) * 64 + ((lane >> 4) & 1) * 32 + (lane & 3) * 8;
    typedef short s16x8 __attribute__((ext_vector_type(8)));
    float s = 0.f;
#define ATT_HALF(P, KS0) do { \
        _Pragma("unroll") for (int r = 0; r < 16; ++r) { P[r] = __builtin_amdgcn_exp2f(P[r]); s += P[r]; } \
        u32x4 pwa, pwb; \
        _Pragma("unroll") for (int j = 0; j < 4; ++j) { pwa[j] = pk_h2_rtz(P[2 * j], P[2 * j + 1]); pwb[j] = pk_h2_rtz(P[8 + 2 * j], P[9 + 2 * j]); } \
        _Pragma("unroll") for (int kk = 0; kk < 2; ++kk) { const half8 pa = __builtin_bit_cast(half8, kk ? pwb : pwa); \
            _Pragma("unroll") for (int d0 = 0; d0 < 2; ++d0) { \
                const s16x4 vlo = __builtin_amdgcn_ds_read_tr16_b64_v4i16((LAS s16x4*)(vb + d0 * 4096 + ((KS0) + kk) * 1024)); \
                const s16x4 vhi = __builtin_amdgcn_ds_read_tr16_b64_v4i16((LAS s16x4*)(vb + d0 * 4096 + ((KS0) + kk) * 1024 + 512)); \
                const s16x8 vv = {vlo[0], vlo[1], vlo[2], vlo[3], vhi[0], vhi[1], vhi[2], vhi[3]}; \
                const half8 vf = __builtin_bit_cast(half8, vv); \
                if (d0 == 0) o0 = __builtin_amdgcn_mfma_f32_32x32x16_f16(pa, vf, o0, 0, 0, 0); \
                else         o1 = __builtin_amdgcn_mfma_f32_32x32x16_f16(pa, vf, o1, 0, 0, 0); } } } while (0)
    if (mode0) ATT_HALF(p0, 0);
    if (mode1) ATT_HALF(p1, 2);
#undef ATT_HALF
    l += s;
}

__device__ __forceinline__ void load_tile_regs(u32x4& kreg, u32x4& vreg, const h16* proj, int tokb, int dil, int LF, int tt0, int kcol, int vcol, int wid, int lane) {
    int tk = tt0 + lane; tk = tk < 0 ? 0 : (tk >= LF ? LF - 1 : tk);
    kreg = *(const u32x4*)(proj + (size_t)(tokb + tk * dil) * NIN + kcol + wid * 8);
    int tv = tt0 + (wid & 3) * 16 + (lane >> 2); tv = tv < 0 ? 0 : (tv >= LF ? LF - 1 : tv);
    vreg = *(const u32x4*)(proj + (size_t)(tokb + tv * dil) * NIN + vcol + (wid >> 2) * 32 + (lane & 3) * 8);
}

__device__ __forceinline__ void store_out(const f32x16& o0, const f32x16& o1, float l_tot, LAS float* wsf, LAS h16* stg, h16* dst, size_t pitch, int tok0, int dil, int lane, int r32, int hi) {
    if (hi == 0) wsf[32 + r32] = l_tot;
    LDS_WAIT();
#pragma unroll
    for (int r = 0; r < 16; ++r) { const int orow = crow(r, hi); const float rl = __builtin_amdgcn_rcpf(wsf[32 + orow]);
        stg[orow * 64 + r32] = __builtin_bit_cast(h16, (_Float16)(o0[r] * rl)); stg[orow * 64 + 32 + r32] = __builtin_bit_cast(h16, (_Float16)(o1[r] * rl)); }
    LDS_WAIT();
#pragma unroll
    for (int i = 0; i < 4; ++i) { const int row = i * 8 + (lane >> 3), ch = lane & 7; const u32x4 v = *(LAS const u32x4*)(stg + row * 64 + ch * 8);
        *(u32x4*)(dst + (size_t)(tok0 + row * dil) * pitch + ch * 8) = v; }
    LDS_WAIT();
}

struct UnitP { int isA, ntile, tt_first, dil, LF, tokb, kcol, vcol, hw, q0, g, h, p; };
__device__ __forceinline__ UnitP decode_unit(int u) {
    UnitP P;
    if (u < 512) { const int qb = u & 63, g = (u >> 6) & 1, b = u >> 7;
        P.isA = 1; P.ntile = 5; P.q0 = qb * 64; P.tt_first = P.q0 - 128; P.dil = 1; P.LF = SEQ; P.tokb = b * SEQ; P.kcol = OFF_KA + g * 64; P.vcol = OFF_VA + g * 64; P.hw = 128; P.g = g; P.h = 0; P.p = 0; }
    else { const int v = u - 512, u16 = v & 15, p = (v >> 4) % 3, bh = v / 48, h = bh & 7, b = bh >> 3, sh = 2 * p, dil = 1 << sh, res = u16 & (dil - 1), qb = u16 >> sh;
        P.isA = 0; P.ntile = 6; P.q0 = 256 * qb; P.tt_first = P.q0 - 64; P.dil = dil; P.LF = SEQ >> sh; P.tokb = b * SEQ + res; P.kcol = OFF_KB + h * 64; P.vcol = OFF_VB + h * 64; P.hw = 64; P.g = 0; P.h = h; P.p = p; }
    return P;
}
__device__ __forceinline__ void issue_tiles(u32x4 (&kr)[6], u32x4 (&vr)[6], const UnitP& P, const h16* proj, int wid, int lane) {
#pragma unroll
    for (int j = 0; j < 6; ++j) { const int tt0 = P.tt_first + 64 * j; if (j < P.ntile && tt0 >= 0 && tt0 < P.LF) load_tile_regs(kr[j], vr[j], proj, P.tokb, P.dil, P.LF, tt0, P.kcol, P.vcol, wid, lane); }
}
__device__ __forceinline__ void write_tiles(LAS unsigned char* L, const u32x4 (&kr)[6], const u32x4 (&vr)[6], const UnitP& P, int wid, int lane) {
#pragma unroll
    for (int j = 0; j < 6; ++j) { const int tt0 = P.tt_first + 64 * j; if (j < P.ntile && tt0 >= 0 && tt0 < P.LF) {
        *(LAS u32x4*)(L + j * TILE_BYTES + wid * 1024 + lane * 16) = kr[j];
        *(LAS u32x4*)(L + j * TILE_BYTES + 8192 + wid * 1024 + lane * 16) = vr[j]; } }
}

__device__ __forceinline__ void attn_phase(Frame& F) {
    const int lane = F.lane, wid = F.wave, r32 = lane & 31, hi = lane >> 5;
    LAS unsigned char* L = F.lds;
    LAS float* wsf = (LAS float*)(L + WSF_OFF) + wid * 64;
    LAS h16* stg = (LAS h16*)(L + STG_OFF + wid * 4096);
    const h16* proj = (const h16*)(F.ws + WS_PROJ);
    int u = F.vcu;
    if (u >= 2048) return;
    UnitP P = decode_unit(u);
    u32x4 kr[6], vr[6];
    issue_tiles(kr, vr, P, proj, wid, lane);
    half8 qn[4];
#define ATT_QLOAD(PP) do { const int qw_ = (PP).isA ? (PP).q0 + 32 * (wid >> 2) : (PP).q0 + 32 * wid, qc_ = (PP).isA ? OFF_QA + (4 * (PP).g + (wid & 3)) * 64 : OFF_QB + (PP).h * 64; \
        const h16* qp_ = proj + (size_t)((PP).tokb + (qw_ + r32) * (PP).dil) * NIN + qc_ + hi * 8; _Pragma("unroll") for (int d0 = 0; d0 < 4; ++d0) qn[d0] = *(const half8*)(qp_ + d0 * 16); } while (0)
    ATT_QLOAD(P);
#pragma unroll 1
    for (; u < 2048; u += F.G) {
        TSEC_BEGIN(20);
        write_tiles(L, kr, vr, P, wid, lane);
        int head, tq, qcol, jb, je, qw0;
        if (P.isA) { head = 4 * P.g + (wid & 3); qw0 = P.q0 + 32 * (wid >> 2); qcol = OFF_QA + head * 64; jb = 0; je = 5; }
        else       { head = P.h; qw0 = P.q0 + 32 * wid; qcol = OFF_QB + head * 64; jb = wid >> 1; je = jb + 3; }
        tq = qw0 + r32; (void)qcol;
        half8 qr[4];
#pragma unroll
        for (int d0 = 0; d0 < 4; ++d0) qr[d0] = qn[d0];
        float m = P.isA ? F.a_sink[head] * LOG2E : 0.f, l = (P.isA && hi == 0) ? 1.0f : 0.0f;
        bool first = !P.isA;
        asm volatile("" ::: "memory");
        __syncthreads();
#pragma unroll
        for (int d0 = 0; d0 < 4; ++d0) asm volatile("" : "+v"(qr[d0]));
        TSEC_END(20);
        TSEC_BEGIN(21);
        const UnitP Pc = P;
        if (u + F.G < 2048) { P = decode_unit(u + F.G); issue_tiles(kr, vr, P, proj, wid, lane); ATT_QLOAD(P); }
        asm volatile("" ::: "memory");
        f32x16 o0, o1, negm;
#pragma unroll
        for (int r = 0; r < 16; ++r) { o0[r] = 0.f; o1[r] = 0.f; negm[r] = -m; }
        const int lo = (-Pc.hw > -tq) ? -Pc.hw : -tq, hi_ = (Pc.hw < Pc.LF - 1 - tq) ? Pc.hw : (Pc.LF - 1 - tq); const unsigned span = (unsigned)(hi_ - lo);
#pragma unroll 1
        for (int j = jb; j < je; ++j) {
            const int tt0 = Pc.tt_first + 64 * j; if (tt0 < 0 || tt0 >= Pc.LF) continue;
            int md[2];
#pragma unroll
            for (int h = 0; h < 2; ++h) { const int mn = tt0 + 32 * h - (qw0 + 31), mx = tt0 + 32 * h + 31 - qw0;
                md[h] = (mn > Pc.hw || mx < -Pc.hw) ? 0 : ((mn >= -Pc.hw && mx <= Pc.hw) ? 1 : 2); }
            if ((md[0] | md[1]) == 0) continue;
            tile_step(o0, o1, m, l, negm, first, qr, L + j * TILE_BYTES, L + j * TILE_BYTES + 8192, wsf, lane, r32, hi, md[0], md[1], tt0 + 4 * hi - tq, lo, span);
            first = false;
        }
        { auto rr = __builtin_amdgcn_permlane32_swap(__float_as_uint(l), __float_as_uint(l), false, false); l = __uint_as_float(rr[0]) + __uint_as_float(rr[1]); }
        TSEC_END(21);
        TSEC_BEGIN(22);
        if (Pc.isA) store_out(o0, o1, l, wsf, stg, (h16*)(F.ws + WS_OA) + head * 64, 512, Pc.tokb + qw0, 1, lane, r32, hi);
        else {
            if (hi == 0) ((float*)(F.ws + WS_LSE))[((size_t)Pc.p * M + Pc.tokb + tq * Pc.dil) * 8 + head] = (m + __builtin_amdgcn_logf(l)) * LN2;
            store_out(o0, o1, l, wsf, stg, (h16*)(F.ws + WS_OB) + (size_t)Pc.p * M * 512 + head * 64, 512, Pc.tokb + qw0 * Pc.dil, Pc.dil, lane, r32, hi);
        }
        __syncthreads();
        TSEC_END(22);
    }
}
}

__device__ __forceinline__ void p3_combine(Frame& F) {
    const int gw = F.vcu * NWAVES + F.wave, NGW = F.G * NWAVES, lane = F.lane;
    const h16* OA = (const h16*)(F.ws + WS_OA); const h16* OB = (const h16*)(F.ws + WS_OB); const float* LSE = (const float*)(F.ws + WS_LSE);
    h16* MX = (h16*)(F.ws + WS_MIXED);
    f32x4 ga[2], gb[2];
#pragma unroll
    for (int i = 0; i < 2; ++i) { ga[i] = *(const f32x4*)(F.g_out_a + 8 * lane + 4 * i); gb[i] = *(const f32x4*)(F.g_out_b + 8 * lane + 4 * i); }
    for (int t = gw; t < M; t += NGW) {
        const u32x4 ra = __builtin_nontemporal_load((const u32x4*)(OA + (size_t)t * 512 + 8 * lane));
        u32x4 rb[3]; float ls[3];
#pragma unroll
        for (int p = 0; p < 3; ++p) { rb[p] = __builtin_nontemporal_load((const u32x4*)(OB + ((size_t)p * M + t) * 512 + 8 * lane)); ls[p] = LSE[((size_t)p * M + t) * 8 + (lane >> 3)]; }
        float a[8], bsum[8];
#pragma unroll
        for (int i = 0; i < 4; ++i) { a[2 * i] = h2f((unsigned short)(ra[i] & 0xffffu)); a[2 * i + 1] = h2f((unsigned short)(ra[i] >> 16)); }
        const float mx = fmaxf(ls[0], fmaxf(ls[1], ls[2]));
        float w[3]; float ws_ = 0.f;
#pragma unroll
        for (int p = 0; p < 3; ++p) { w[p] = __expf(ls[p] - mx); ws_ += w[p]; }
        const float inv = 1.0f / ws_;
#pragma unroll
        for (int i = 0; i < 8; ++i) bsum[i] = 0.f;
#pragma unroll
        for (int p = 0; p < 3; ++p) { const float wp = w[p] * inv;
#pragma unroll
            for (int i = 0; i < 4; ++i) { bsum[2 * i] += wp * h2f((unsigned short)(rb[p][i] & 0xffffu)); bsum[2 * i + 1] += wp * h2f((unsigned short)(rb[p][i] >> 16)); } }
        float sa = 0.f, sb = 0.f;
#pragma unroll
        for (int i = 0; i < 8; ++i) { sa += a[i] * a[i]; sb += bsum[i] * bsum[i]; }
        const float rsa = 1.0f / sqrtf(wave_sum(sa) * (1.0f / 512.0f) + NORM_EPS), rsb = 1.0f / sqrtf(wave_sum(sb) * (1.0f / 512.0f) + NORM_EPS);
        u32x4 wa, wb;
#pragma unroll
        for (int i = 0; i < 4; ++i) { wa[i] = pk_h2(a[2 * i] * rsa * ga[i >> 1][(2 * i) & 3], a[2 * i + 1] * rsa * ga[i >> 1][(2 * i + 1) & 3]);
                                      wb[i] = pk_h2(bsum[2 * i] * rsb * gb[i >> 1][(2 * i) & 3], bsum[2 * i + 1] * rsb * gb[i >> 1][(2 * i + 1) & 3]); }
        *(u32x4*)(MX + (size_t)t * DM + 8 * lane) = wa;
        *(u32x4*)(MX + (size_t)t * DM + 512 + 8 * lane) = wb;
    }
}

__device__ __forceinline__ void p5_router(Frame& F) {
    const int gw = F.vcu * NWAVES + F.wave, NGW = F.G * NWAVES, lane = F.lane;
    LAS unsigned char* L = F.lds;
    for (int i = F.tid; i < DM * 4; i += NWAVES * 64) { const int k = i >> 2, c = i & 3; *(LAS f32x4*)(L + k * 64 + (k >> 2) * 16 + c * 16) = *(const f32x4*)(F.w_router + k * 16 + c * 4); }
    __syncthreads();
    const h16* X1 = (const h16*)(F.ws + WS_X1); unsigned char* H2 = F.ws + WS_H2; float* AFF = (float*)(F.ws + WS_AFF);
    f32x4 g[4];
#pragma unroll
    for (int j = 0; j < 4; ++j) g[j] = ((const f32x4*)F.g_ffn)[lane + 64 * j];
    u32x2 vn[4];
    if (gw < M) {
#pragma unroll
        for (int j = 0; j < 4; ++j) vn[j] = __builtin_nontemporal_load((const u32x2*)(X1 + (size_t)gw * DM) + lane + 64 * j);
    }
    LAS float* cscr = (LAS float*)(L + 69632 + F.wave * 8448);
    const float* const wg_ = F.w_gate; const float* const wu_ = F.w_up; const float* const wd_ = F.w_down; unsigned char* const ws_ = F.ws;
    const int JT = (int)((CV_TOTAL + (unsigned)NGW - 1u) / (unsigned)NGW), J1 = (F.G > BATCH * NE) ? JT - JT / 8 : JT;
    int cj = 0; bool cpendA = false, cpendB = false;
    ConvItem citA = conv8_decode(wg_, wu_, wd_, ws_, (unsigned)gw < CV_TOTAL ? (unsigned)gw : 0u), citB = citA; float cregA[32], cregB[32];
#define P5_PUMP1(PEND, ITEM, REG) do { __builtin_amdgcn_sched_barrier(0); if (PEND) conv8_finish(ITEM, REG, cscr, lane); __builtin_amdgcn_sched_barrier(0); \
        { const unsigned it_ = (unsigned)cj * (unsigned)NGW + (unsigned)gw; PEND = (cj < J1) && (it_ < CV_TOTAL); if (PEND) ITEM = conv8_decode(wg_, wu_, wd_, ws_, it_); ++cj; conv8_issue(ITEM, REG, lane); } __builtin_amdgcn_sched_barrier(0); } while (0)
#define P5_PUMP() do { if (cj & 1) P5_PUMP1(cpendB, citB, cregB); else P5_PUMP1(cpendA, citA, cregA); } while (0)
    P5_PUMP();
    P5_PUMP();
    for (int t = gw; t < M; t += NGW) {
        f32x4 v[4]; float s = 0.f;
#pragma unroll
        for (int j = 0; j < 4; ++j) { v[j].x = h2f((unsigned short)(vn[j].x & 0xffffu)); v[j].y = h2f((unsigned short)(vn[j].x >> 16)); v[j].z = h2f((unsigned short)(vn[j].y & 0xffffu)); v[j].w = h2f((unsigned short)(vn[j].y >> 16)); }
        if (t + NGW < M) {
#pragma unroll
            for (int j = 0; j < 4; ++j) vn[j] = __builtin_nontemporal_load((const u32x2*)(X1 + (size_t)(t + NGW) * DM) + lane + 64 * j);
        }
        P5_PUMP();
#pragma unroll
        for (int j = 0; j < 4; ++j) s += (v[j].x * v[j].x + v[j].y * v[j].y) + (v[j].z * v[j].z + v[j].w * v[j].w);
        const float rs = 1.0f / sqrtf(wave_sum(s) * (1.0f / DM) + NORM_EPS);
        unsigned* o4 = (unsigned*)(H2 + (size_t)t * DM) + lane;
        float acc[16];
#pragma unroll
        for (int e = 0; e < 16; ++e) acc[e] = 0.f;
#pragma unroll
        for (int j = 0; j < 4; ++j) {
            const f32x4 y = v[j] * rs * g[j];
            o4[64 * j] = pk_fp8x4(clamp8(y.x * S_H2), clamp8(y.y * S_H2), clamp8(y.z * S_H2), clamp8(y.w * S_H2));
#pragma unroll
            for (int c = 0; c < 4; ++c) {
                const int k = 256 * j + 4 * lane + c; LAS const f32x4* wr = (LAS const f32x4*)(L + k * 64 + (k >> 2) * 16);
#pragma unroll
                for (int q = 0; q < 4; ++q) { const f32x4 wv = wr[q];
#pragma unroll
                    for (int z = 0; z < 4; ++z) acc[4 * q + z] += y[c] * wv[z]; }
                if (c & 1) asm volatile("" ::: "memory");
            }
        }
        { const bool up = (lane & 32) != 0;
#pragma unroll
          for (int i = 0; i < 8; ++i) { const float send = up ? acc[i] : acc[i + 8], keep = up ? acc[i + 8] : acc[i]; acc[i] = keep + __shfl_xor(send, 32); } }
        { const bool up = (lane & 16) != 0;
#pragma unroll
          for (int i = 0; i < 4; ++i) { const float send = up ? acc[i] : acc[i + 4], keep = up ? acc[i + 4] : acc[i]; acc[i] = keep + __shfl_xor(send, 16); } }
        { const bool up = (lane & 8) != 0;
#pragma unroll
          for (int i = 0; i < 2; ++i) { const float send = up ? acc[i] : acc[i + 2], keep = up ? acc[i + 2] : acc[i]; acc[i] = keep + __shfl_xor(send, 8); } }
        float lg;
        { const bool up = (lane & 4) != 0; const float send = up ? acc[0] : acc[1], keep = up ? acc[1] : acc[0]; lg = keep + __shfl_xor(send, 4); }
        lg += __shfl_xor(lg, 2); lg += __shfl_xor(lg, 1);
        float mx = lg;
#pragma unroll
        for (int o = 4; o < 64; o <<= 1) mx = fmaxf(mx, __shfl_xor(mx, o));
        const float ex = __expf(lg - mx); float sm = ex;
#pragma unroll
        for (int o = 4; o < 64; o <<= 1) sm += __shfl_xor(sm, o);
        if ((lane & 3) == 0) { const int e = lane >> 2, b = t >> 12, sidx = t & (SEQ - 1); AFF[((size_t)(b * NE + e)) * SEQ + sidx] = ex / sm; }
        P5_PUMP();
    }
#pragma unroll 1
    while (cpendA || cpendB || cj < J1) P5_PUMP();
#undef P5_PUMP
#undef P5_PUMP1
}

__device__ __forceinline__ void p6_topk(Frame& F) {
    LAS unsigned* cnt = (LAS unsigned*)F.lds;
    const int tid = F.tid, lane = F.lane, wid = F.wave;
    const float* AFF = (const float*)(F.ws + WS_AFF);
    int* TOK = (int*)(F.ws + WS_TOK); float* GATE = (float*)(F.ws + WS_GATE); int* SLOT = (int*)(F.ws + WS_SLOT);
    for (int pair = F.vcu; pair < BATCH * NE; pair += F.G) {
        const int b = pair >> 4, e = pair & 15;
        const float* a = AFF + (size_t)pair * SEQ + 8 * tid;
        const f32x4 a0 = *(const f32x4*)a, a1 = *(const f32x4*)(a + 4);
        unsigned key[8];
#pragma unroll
        for (int j = 0; j < 4; ++j) { key[j] = __float_as_uint(a0[j]); key[4 + j] = __float_as_uint(a1[j]); }
        unsigned prefix = 0u;
        __syncthreads();
#pragma unroll 1
        for (int sft = 28; sft >= 0; sft -= 2) {
            const unsigned c1 = prefix | (1u << sft), c2 = prefix | (2u << sft), c3 = prefix | (3u << sft);
            unsigned n1 = 0, n2 = 0, n3 = 0;
#pragma unroll
            for (int j = 0; j < 8; ++j) { n1 += (unsigned)__popcll(__ballot(key[j] >= c1)); n2 += (unsigned)__popcll(__ballot(key[j] >= c2)); n3 += (unsigned)__popcll(__ballot(key[j] >= c3)); }
            LAS unsigned* cc = cnt + ((sft & 2) ? 24 : 0);
            if (lane == 0) { cc[wid] = n1; cc[8 + wid] = n2; cc[16 + wid] = n3; }
            __syncthreads();
            unsigned t1 = 0, t2 = 0, t3 = 0;
#pragma unroll
            for (int w = 0; w < 8; ++w) { t1 += cc[w]; t2 += cc[8 + w]; t3 += cc[16 + w]; }
            prefix = (t3 >= (unsigned)CAP) ? c3 : ((t2 >= (unsigned)CAP) ? c2 : ((t1 >= (unsigned)CAP) ? c1 : prefix));
        }
        unsigned cg = 0, ce = 0;
#pragma unroll
        for (int j = 0; j < 8; ++j) { cg += key[j] > prefix; ce += key[j] == prefix; }
        unsigned pk = (ce << 16) | cg, inc = pk;
#pragma unroll
        for (int o = 1; o < 64; o <<= 1) { const unsigned n = __shfl_up(inc, o); if (lane >= o) inc += n; }
        __syncthreads();
        LAS unsigned* ws_ = cnt + 48;
        if (lane == 63) ws_[wid] = inc;
        __syncthreads();
        unsigned base = 0, total = 0;
#pragma unroll
        for (int w = 0; w < 8; ++w) { const unsigned x = ws_[w]; if (w < wid) base += x; total += x; }
        const unsigned exc = base + inc - pk;
        unsigned gtb = exc & 0xffffu, eqb = exc >> 16;
        const unsigned need = (unsigned)CAP - (total & 0xffffu);
#pragma unroll
        for (int j = 0; j < 8; ++j) {
            const int sidx = 8 * tid + j; int slot = -1;
            if (key[j] > prefix) { slot = (int)(gtb + (eqb < need ? eqb : need)); ++gtb; }
            else if (key[j] == prefix) { if (eqb < need) slot = (int)(gtb + eqb); ++eqb; }
            SLOT[((size_t)(b * SEQ + sidx)) * NE + e] = slot;
            if (slot >= 0) { TOK[e * EROWS + b * CAP + slot] = b * SEQ + sidx; GATE[e * EROWS + b * CAP + slot] = __uint_as_float(key[j]); }
        }
        __syncthreads();
    }
}

__device__ __forceinline__ void p9_final(Frame& F) {
    const int gw = F.vcu * NWAVES + F.wave, NGW = F.G * NWAVES, lane = F.lane;
    const int* SLOT = (const int*)(F.ws + WS_SLOT); const unsigned char* YE = F.ws + WS_YE;
    f32x4 g[4];
#pragma unroll
    for (int j = 0; j < 4; ++j) g[j] = ((const f32x4*)F.g_final)[lane + 64 * j];
    int myslot = (gw < M) ? SLOT[(size_t)gw * NE + (lane & 15)] : -1;
    for (int t = gw; t < M; t += NGW) {
        f32x4* xr = (f32x4*)(F.out + (size_t)t * DM) + lane;
        const u32x2* xi = (const u32x2*)((const h16*)(F.ws + WS_X1) + (size_t)t * DM) + lane;
        f32x4 v[4];
#pragma unroll
        for (int j = 0; j < 4; ++j) { const u32x2 w = __builtin_nontemporal_load(xi + 64 * j); v[j].x = h2f((unsigned short)(w.x & 0xffffu)); v[j].y = h2f((unsigned short)(w.x >> 16)); v[j].z = h2f((unsigned short)(w.y & 0xffffu)); v[j].w = h2f((unsigned short)(w.y >> 16)); }
        const int slot_cur = myslot;
        const int tn = t + NGW;
        myslot = (tn < M) ? SLOT[(size_t)tn * NE + (lane & 15)] : -1;
        unsigned mask = (unsigned)(__ballot(slot_cur >= 0) & 0xffffull);
        const size_t ebase = (size_t)(t >> 12) * CAP;
        while (mask) {
            int e[4]; float w[4];
#pragma unroll
            for (int q = 0; q < 4; ++q) { const bool has = mask != 0u; e[q] = has ? (int)__builtin_ctz(mask) : e[0]; w[q] = has ? 1.f : 0.f; mask = has ? (mask & (mask - 1u)) : 0u; }
            unsigned y[4][4];
#pragma unroll
            for (int q = 0; q < 4; ++q) { const int sl = __builtin_amdgcn_readlane(slot_cur, e[q]);
                const unsigned* yr = (const unsigned*)(YE + ((size_t)e[q] * EROWS + ebase + sl) * DM) + lane;
#pragma unroll
                for (int j = 0; j < 4; ++j) y[q][j] = __builtin_nontemporal_load(yr + 64 * j); }
#pragma unroll
            for (int q = 0; q < 4; ++q) { const float wq = w[q] * (1.0f / S_YE);
#pragma unroll
                for (int j = 0; j < 4; ++j) { const auto lo2 = __builtin_amdgcn_cvt_pk_f32_fp8((int)y[q][j], false), hi2 = __builtin_amdgcn_cvt_pk_f32_fp8((int)y[q][j], true);
                    v[j].x += wq * lo2[0]; v[j].y += wq * lo2[1]; v[j].z += wq * hi2[0]; v[j].w += wq * hi2[1]; } }
        }
        float s = 0.f;
#pragma unroll
        for (int j = 0; j < 4; ++j) s += (v[j].x * v[j].x + v[j].y * v[j].y) + (v[j].z * v[j].z + v[j].w * v[j].w);
        const float rs = 1.0f / sqrtf(wave_sum(s) * (1.0f / DM) + NORM_EPS);
#pragma unroll
        for (int j = 0; j < 4; ++j) __builtin_nontemporal_store(v[j] * rs * g[j], xr + 64 * j);
    }
}

constexpr int NPHASE = 10;
struct Args { const float* in[13]; float* out; unsigned char* ws; int ph_lo, ph_hi, li, pad; };

__global__ void __launch_bounds__(NWAVES * 64, 2) mk_fwd(Args args) {
    extern __shared__ __attribute__((aligned(16))) unsigned char lds[];
    Frame F;
    F.lds = (LAS unsigned char*)lds;
    F.tid = threadIdx.x; F.lane = F.tid & 63; F.wave = __builtin_amdgcn_readfirstlane(F.tid >> 6);
    F.G = gridDim.x; { const int bx = blockIdx.x; F.vcu = (F.G % 8 == 0) ? (bx % 8) * (F.G / 8) + bx / 8 : bx; }
    F.x = args.in[0]; F.g_mix = args.in[1]; F.w_in = args.in[2]; F.a_sink = args.in[3]; F.g_out_a = args.in[4]; F.g_out_b = args.in[5]; F.w_out = args.in[6];
    F.g_ffn = args.in[7]; F.w_router = args.in[8]; F.w_gate = args.in[9]; F.w_up = args.in[10]; F.w_down = args.in[11]; F.g_final = args.in[12];
    F.out = args.out; F.ws = args.ws; F.tacc = 0;
    volatile LAS unsigned* MISC = (volatile LAS unsigned*)(F.lds + MISC_OFF);
    for (int u = F.tid; u < (LDS_BYTES - LDSCTL_OFF) / 4; u += NWAVES * 64) ((LAS unsigned*)(F.lds + LDSCTL_OFF))[u] = 0u;
    __syncthreads();
    const int lo = args.ph_lo, hi = args.ph_hi;
    const bool multi = (hi - lo) > 1;
    unsigned* barw = (unsigned*)(F.ws + WS_CTL) + CW_BAR + args.li * XCD_BAR_WORDS;
    XcdBarrier bar; bar.bar = barw; bar.x = 0; bar.st = nullptr;
    if (multi) bar = xcd_barrier_post(barw, MISC + 8);
#define IN(k) (((PH_MASK >> (k)) & 1) && lo <= (k) && (k) < hi)
#define SEAM(k) do { if (IN(k) && IN((k) + 1)) xcd_barrier(bar); } while (0)
#define TS0(k) do { if (TIME_PHASE == (k)) ts0_ = __builtin_amdgcn_s_memrealtime(); } while (0)
#define TS1(k) do { if (TIME_PHASE == (k)) ts1_ = __builtin_amdgcn_s_memrealtime(); } while (0)
    unsigned long long ts0_ = 0, ts1_ = 0;
#define REPS(k) for (int rep_ = 0; rep_ < 1 + ((REP_MASK >> (k)) & 1); ++rep_)

    TS0(0);
    if (IN(0)) REPS(0) { p0_prologue(F); SEAM(0); }
    TS1(0);
    TS0(1);
    if (IN(1)) {
        pg8::DenseProb P{(const char*)(F.ws + WS_H), (const char*)(F.ws + WS_WIN), DM * 2};
        pg8::DenseOrder S; S.init(M, NIN, F.G, (int)blockIdx.x, 1 + ((REP_MASK >> 1) & 1));
        pg8::EpiInProj E{(h16*)(F.ws + WS_PROJ), (const float*)(F.ws + WS_ROPE)};
        pg8::gemm_phase<pg8::DenseProb, pg8::EpiInProj, pg8::DenseOrder, true>(F.lds, P, S, E);
        SEAM(1);
    }
    TS1(1);
    TS0(2);
    if (IN(2)) REPS(2) { att::attn_phase(F); SEAM(2); }
    TS1(2);
    TS0(3);
    if (IN(3)) REPS(3) { p3_combine(F); SEAM(3); }
    TS1(3);
    TS0(4);
    if (IN(4)) {
        pg8::DenseProb P{(const char*)(F.ws + WS_MIXED), (const char*)(F.ws + WS_WOUT), DM * 2};
        pg8::DenseOrder S; S.init(M, DM, F.G, (int)blockIdx.x, 1 + ((REP_MASK >> 4) & 1));
        pg8::EpiResidual E{F.x, (h16*)(F.ws + WS_X1)};
        pg8::gemm_phase<pg8::DenseProb, pg8::EpiResidual, pg8::DenseOrder, true>(F.lds, P, S, E);
        SEAM(4);
    }
    TS1(4);
    TS0(5);
    if (IN(5)) REPS(5) { p5_router(F); SEAM(5); }
    TS1(5);
    TS0(6);
    if (IN(6)) REPS(6) {
        p6_topk(F);
        if (F.G > BATCH * NE && F.vcu >= BATCH * NE) {
            const int NGW_ = F.G * NWAVES, JT = (int)((CV_TOTAL + (unsigned)NGW_ - 1u) / (unsigned)NGW_), J1 = JT - JT / 8;
            const unsigned R0 = (unsigned)J1 * (unsigned)NGW_, NCW = (unsigned)(F.G - BATCH * NE) * NWAVES;
            for (unsigned it = R0 + (unsigned)(F.vcu - BATCH * NE) * NWAVES + (unsigned)F.wave; it < CV_TOTAL; it += NCW) conv8_one(F.w_gate, F.w_up, F.w_down, F.ws, it, (LAS float*)(F.lds + F.wave * 16384), F.lane);
        }
        SEAM(6); }
    TS1(6);
    TS0(7);
    if (IN(7)) {
        pg8::Moe1Prob P{(const char*)(F.ws + WS_H2), (const char*)(F.ws + WS_WGU), DM, (const int*)(F.ws + WS_TOK)};
        pg8::GroupOrder S; S.init(EROWS / 256, 4096 / 256, NE, F.G, F.vcu, 1 + ((REP_MASK >> 7) & 1));
        pg8::EpiSwiGLU E{F.ws + WS_HMID};
        pg8::gemm_phase<pg8::Moe1Prob, pg8::EpiSwiGLU, pg8::GroupOrder, true>(F.lds, P, S, E);
        SEAM(7);
    }
    TS1(7);
    TS0(8);
    if (IN(8)) {
        pg8::Moe2Prob P{(const char*)(F.ws + WS_HMID), (const char*)(F.ws + WS_WD), FF};
        pg8::GroupOrder S; S.init(EROWS / 256, DM / 256, NE, F.G, F.vcu, 1 + ((REP_MASK >> 8) & 1));
        pg8::EpiDown E{F.ws + WS_YE, (const float*)(F.ws + WS_GATE)};
        pg8::gemm_phase<pg8::Moe2Prob, pg8::EpiDown, pg8::GroupOrder, true>(F.lds, P, S, E);
        SEAM(8);
    }
    TS1(8);
    TS0(9);
    if (IN(9)) REPS(9) { p9_final(F); if (rep_ == 0 && ((REP_MASK >> 9) & 1)) xcd_barrier(bar); }
    TS1(9);
    if (TIME_PHASE >= 0 && blockIdx.x == 0 && F.tid == 0) { asm volatile("s_waitcnt vmcnt(0)" ::: "memory"); F.out[0] += (float)(TIME_PHASE >= 20 ? F.tacc : (ts1_ - ts0_)) * 0.01f * TIME_SCALE; }
#undef IN
#undef SEAM
}

extern "C" void kernel_launch(void* const* d_in, const int* in_sizes, int n_in, void* d_out, int out_size, void* d_ws, size_t ws_size, hipStream_t stream) {
    static int grid = 0;
    if (grid == 0) {
        if (n_in != 13 || in_sizes[0] != M * DM || out_size != M * DM || ws_size < WS_END) { fprintf(stderr, "kernel_launch: unexpected problem (n_in %d, ws %zu)\n", n_in, ws_size); grid = -1; return; }
        int dev = 0, cus = 0, per_cu = 0;
        if (hipGetDevice(&dev) != hipSuccess || hipDeviceGetAttribute(&cus, hipDeviceAttributeMultiprocessorCount, dev) != hipSuccess) { grid = -1; return; }
        if (hipFuncSetAttribute((const void*)mk_fwd, hipFuncAttributeMaxDynamicSharedMemorySize, LDS_BYTES) != hipSuccess) { fprintf(stderr, "kernel_launch: hipFuncSetAttribute failed\n"); grid = -1; return; }
        if (hipOccupancyMaxActiveBlocksPerMultiprocessor(&per_cu, (const void*)mk_fwd, NWAVES * 64, LDS_BYTES) != hipSuccess || per_cu < 1)
            fprintf(stderr, "kernel_launch: occupancy query reports %d blocks per CU\n", per_cu);
        (void)hipGetLastError();
        grid = cus;
    }
    if (grid < 0) return;
    (void)hipMemsetAsync((char*)d_ws + WS_CTL, 0, CTL_ZERO_BYTES, stream);
    Args a{};
    for (int i = 0; i < 13; ++i) a.in[i] = (const float*)d_in[i];
    a.out = (float*)d_out; a.ws = (unsigned char*)d_ws;
    if (MK_N_LAUNCHES == 1) {
        for (int pass = 0; pass < REP_ALL; ++pass) { a.ph_lo = 0; a.ph_hi = NPHASE; a.li = pass;
        hipLaunchKernelGGL(mk_fwd, dim3(grid), dim3(NWAVES * 64), LDS_BYTES, stream, a); }
    } else {
        for (int li = 0; li < NPHASE; ++li) { a.ph_lo = li; a.ph_hi = li + 1; a.li = 0;
            hipLaunchKernelGGL(mk_fwd, dim3(grid), dim3(NWAVES * 64), LDS_BYTES, stream, a); }
    }
}
```

```cpp
#include <hip/hip_runtime.h>
#include <cstdio>
#include <cstdint>

#ifndef MK_N_LAUNCHES
#define MK_N_LAUNCHES 1
#endif
#ifndef TIME_PHASE
#define TIME_PHASE -1
#endif
#ifndef TIME_SCALE
#define TIME_SCALE 1.0f
#endif
#ifndef PH_MASK
#define PH_MASK 0x3ff
#endif
#ifndef REP_ALL
#define REP_ALL 1
#endif
#ifndef REP_MASK
#define REP_MASK 0
#endif

#define LAS __attribute__((address_space(3)))
#define GAS __attribute__((address_space(1)))
typedef unsigned short h16;
typedef _Float16 half8 __attribute__((ext_vector_type(8)));
typedef _Float16 half2v __attribute__((ext_vector_type(2)));
typedef short s16x4 __attribute__((ext_vector_type(4)));
typedef float f32x4 __attribute__((ext_vector_type(4)));
typedef float f32x16 __attribute__((ext_vector_type(16)));
typedef unsigned u32x2 __attribute__((ext_vector_type(2)));
typedef unsigned u32x4 __attribute__((ext_vector_type(4)));
typedef GAS unsigned gu32;

constexpr int BATCH = 4, SEQ = 4096, DM = 1024, M = BATCH * SEQ;
constexpr int NIN = 2304;
constexpr int OFF_QA = 0, OFF_KA = 512, OFF_VA = 640, OFF_QB = 768, OFF_KB = 1280, OFF_VB = 1792;
constexpr int NE = 16, CAP = 512, FF = 2048, EROWS = BATCH * CAP;
constexpr float NORM_EPS = 1e-6f;
constexpr float LOG2E = 1.4426950408889634f, LN2 = 0.6931471805599453f;
constexpr float QSCALE = 0.18033688011112042f;
constexpr float S_H2 = 4.f, S_W = 32.f, S_HM = 2.f, S_YE = 16.f;

constexpr size_t MiB = 1u << 20;
constexpr size_t WS_CTL = 0, CTL_ZERO_BYTES = 64 * 1024;
constexpr size_t WS_ROPE = 1 * MiB;
constexpr size_t WS_AFF = 2 * MiB;
constexpr size_t WS_TOK = 3 * MiB;
constexpr size_t WS_GATE = 3 * MiB + 256 * 1024;
constexpr size_t WS_SLOT = 4 * MiB;
constexpr size_t WS_LSE = 5 * MiB;
constexpr size_t WS_WIN = 8 * MiB;
constexpr size_t WS_WOUT = 13 * MiB;
constexpr size_t WS_WGU = 16 * MiB;
constexpr size_t WS_WD = 144 * MiB;
constexpr size_t WS_H = 208 * MiB;
constexpr size_t WS_PROJ = 240 * MiB;
constexpr size_t WS_OA = 312 * MiB;
constexpr size_t WS_OB = 328 * MiB;
constexpr size_t WS_HMID = 208 * MiB;
constexpr size_t WS_MIXED = 376 * MiB;
constexpr size_t WS_H2 = 408 * MiB;
constexpr size_t WS_YE = 376 * MiB;
constexpr size_t WS_X1 = 440 * MiB;
constexpr size_t WS_END = 504 * MiB;
constexpr int CW_CONV = 64, CW_P1DONE = 128;
constexpr int CW_BAR = 1024;

constexpr int RING_BYTES = 131072;
constexpr int LDSCTL_OFF = 143360, MISC_OFF = LDSCTL_OFF + 320;
constexpr int LDS_BYTES = 147456;
constexpr int NWAVES = 8;

#define RLX_AGENT __ATOMIC_RELAXED, __HIP_MEMORY_SCOPE_AGENT
#define LDS_WAIT() asm volatile("s_waitcnt lgkmcnt(0)" ::: "memory")
#define VM_WAIT() asm volatile("s_waitcnt vmcnt(0)" ::: "memory")

__device__ __forceinline__ unsigned pk_h2(float lo, float hi) { half2v v = {(_Float16)lo, (_Float16)hi}; return __builtin_bit_cast(unsigned, v); }
__device__ __forceinline__ unsigned pk_h2_rtz(float lo, float hi) { return __builtin_bit_cast(unsigned, __builtin_amdgcn_cvt_pkrtz(lo, hi)); }
__device__ __forceinline__ unsigned pk_fp8x4(float a, float b, float c, float d) {
    int w = __builtin_amdgcn_cvt_pk_fp8_f32(a, b, 0, false); w = __builtin_amdgcn_cvt_pk_fp8_f32(c, d, w, true); return (unsigned)w; }
__device__ __forceinline__ float clamp8(float x) { return fminf(fmaxf(x, -448.f), 448.f); }
__device__ __forceinline__ float h2f(unsigned short b) { return (float)__builtin_bit_cast(_Float16, b); }
__device__ __forceinline__ float wave_sum(float v) {
#pragma unroll
    for (int o = 1; o < 64; o <<= 1) v += __shfl_xor(v, o);
    return v;
}


constexpr unsigned CV_PER = (DM / 64) * (FF / 32);
constexpr unsigned CV_TOTAL = (unsigned)NE * 3u * CV_PER;
struct ConvItem { const float* W; unsigned char* D; int N, K; };
__device__ __forceinline__ ConvItem conv8_decode(const float* wg, const float* wu, const float* wd, unsigned char* ws, unsigned it) {
    ConvItem c;
    if (it < (unsigned)NE * 2u * CV_PER) {
        const unsigned e = it / (2u * CV_PER); unsigned r = it - e * 2u * CV_PER; const unsigned which = r / CV_PER; r -= which * CV_PER;
        const int kb = (int)(r / (FF / 32)), n0 = 32 * (int)(r % (FF / 32));
        c.N = FF; c.K = DM; c.W = (which ? wu : wg) + (size_t)e * DM * FF + (size_t)(64 * kb) * FF + n0;
        c.D = ws + WS_WGU + ((size_t)e * 4096 + (size_t)((n0 >> 7) * 256 + (int)which * 128 + (n0 & 127))) * DM + 64 * kb;
    } else {
        const unsigned r0 = it - (unsigned)NE * 2u * CV_PER, e = r0 / CV_PER, r = r0 - e * CV_PER;
        const int kb = (int)(r / (DM / 32)), n0 = 32 * (int)(r % (DM / 32));
        c.N = DM; c.K = FF; c.W = wd + (size_t)e * FF * DM + (size_t)(64 * kb) * DM + n0;
        c.D = ws + WS_WD + ((size_t)e * DM + n0) * FF + 64 * kb;
    }
    return c;
}
__device__ __forceinline__ void conv8_issue(const ConvItem& c, float (&r)[32], int lane) {
#pragma unroll
    for (int i = 0; i < 32; ++i) r[i] = __builtin_nontemporal_load(c.W + (size_t)(2 * i + (lane >> 5)) * c.N + (lane & 31));
}
__device__ __forceinline__ void conv8_finish(const ConvItem& c, const float (&r)[32], LAS float* scr, int lane) {
#pragma unroll
    for (int i = 0; i < 32; ++i) scr[(2 * i + (lane >> 5)) * 33 + (lane & 31)] = r[i];
    LDS_WAIT(); asm volatile("" ::: "memory");
    const int n = lane >> 1, kh = (lane & 1) * 32; const LAS float* s = scr + kh * 33 + n;
    u32x4 o0, o1;
#pragma unroll
    for (int q = 0; q < 4; ++q) {
        o0[q] = pk_fp8x4(s[(4 * q) * 33] * S_W, s[(4 * q + 1) * 33] * S_W, s[(4 * q + 2) * 33] * S_W, s[(4 * q + 3) * 33] * S_W);
        o1[q] = pk_fp8x4(s[(16 + 4 * q) * 33] * S_W, s[(17 + 4 * q) * 33] * S_W, s[(18 + 4 * q) * 33] * S_W, s[(19 + 4 * q) * 33] * S_W); }
    unsigned char* d = c.D + (size_t)n * c.K + kh;
    *(GAS u32x4*)d = o0; *(GAS u32x4*)(d + 16) = o1;
    LDS_WAIT(); asm volatile("" ::: "memory");
}
__device__ __forceinline__ void conv8_one(const float* wg, const float* wu, const float* wd, unsigned char* ws, unsigned it, LAS float* scr, int lane) {
    const ConvItem c = conv8_decode(wg, wu, wd, ws, it); float r[32]; conv8_issue(c, r, lane); conv8_finish(c, r, scr, lane);
}
constexpr unsigned CV_BATCH = 64;
__device__ __forceinline__ void conv8_dynamic(const float* wg, const float* wu, const float* wd, unsigned char* ws, unsigned* ctr, unsigned* done_ctr, unsigned until_done,
                                              LAS float* scr, volatile LAS unsigned* sh, int tid, int wave, int lane) {
    for (;;) {
        if (tid == 0) { sh[0] = __hip_atomic_fetch_add(ctr, CV_BATCH, __ATOMIC_RELAXED, __HIP_MEMORY_SCOPE_AGENT);
                        sh[1] = until_done ? __hip_atomic_load(done_ctr, __ATOMIC_RELAXED, __HIP_MEMORY_SCOPE_AGENT) : 0u; }
        __syncthreads();
        const unsigned b0 = sh[0]; const bool stop = until_done && sh[1] >= until_done;
        __syncthreads();
        if (b0 >= CV_TOTAL) break;
#pragma unroll 1
        for (unsigned q = 0; q < CV_BATCH / 8; ++q) { const unsigned it = b0 + (unsigned)wave * (CV_BATCH / 8) + q; if (it < CV_TOTAL) conv8_one(wg, wu, wd, ws, it, scr, lane); }
        if (stop) break;
    }
}
struct NoSide { static constexpr bool ON = false; };

namespace pg8 {
constexpr int BM = 256, BK = 64, HALF = 128, HTB = HALF * BK * 2, STAGE_BYTES = 8 * HTB, NXCD = 8, WGM = 8;
__host__ __device__ __forceinline__ int lds_byte(int r, int c) { const int st = (r >> 4) * 2 + (c >> 5), rr = r & 15, cc = c & 31, ob = rr * 64 + cc * 2; return st * 1024 + (ob ^ (((ob >> 9) & 1) << 5)); }
__host__ __device__ __forceinline__ void stage_rc(int b, int& R, int& C) { const int st = b / 1024, sb = b % 1024, swz = sb ^ (((sb >> 9) & 1) << 5); R = (st >> 1) * 16 + swz / 64; C = (st & 1) * 32 + (swz % 64) / 2; }
__host__ __device__ __forceinline__ int perm32(int rho) { const int n = rho >> 4, i = rho & 15; return 8 * (i >> 2) + 4 * n + (i & 3); }

struct Unit { int pm, pn, g; };

struct DenseOrder {
    int nM, nN, nwg, G, c, reps;
    __device__ void init(int M_, int N_, int G_, int c_, int reps_ = 1) { nM = M_ / BM; nN = N_ / BM; nwg = nM * nN; G = G_; c = c_; reps = reps_; }
    __device__ bool next(int i, Unit& u) const {
        const int mine = (nwg - c + G - 1) / G; if (mine <= 0 || i >= mine * reps) return false; i %= mine;
        const long L = (long)i * G + c;
        int wgid = (int)L; { const int q = nwg / NXCD, r = nwg % NXCD, xcd = wgid % NXCD, off = wgid / NXCD; wgid = (xcd < r ? xcd * (q + 1) : r * (q + 1) + (xcd - r) * q) + off; }
        const int nig = WGM * nN, gid = wgid / nig, fm = gid * WGM, gsz = (nM - fm) < WGM ? (nM - fm) : WGM;
        u.pm = fm + ((wgid % nig) % gsz); u.pn = (wgid % nig) / gsz; u.g = 0; return true;
    }
};
struct GroupOrder {
    int nPM, nPN, total, G, c, reps;
    __device__ void init(int nPM_, int nPN_, int groups, int G_, int c_, int reps_ = 1) { nPM = nPM_; nPN = nPN_; total = nPM_ * nPN_ * groups; G = G_; c = c_; reps = reps_; }
    __device__ bool next(int i, Unit& u) const {
        const int mine = (total - c + G - 1) / G; if (mine <= 0 || i >= mine * reps) return false; i %= mine;
        const int L = i * G + c;
        const int per = nPM * nPN; u.g = L / per; const int rem = L % per; u.pn = rem / nPM; u.pm = rem % nPM; return true;
    }
};

struct DenseProb {
    static constexpr bool BKN = false, FP8 = false;
    const char* A; const char* Bt; int KB;
    __device__ __forceinline__ unsigned a_row(const Unit& u, int r) const { return (unsigned)(u.pm * BM + r); }
    __device__ __forceinline__ const char* b_base(const Unit& u, int half) const { return Bt + ((size_t)u.pn * BM + (size_t)half * HALF) * KB; }
    __device__ __forceinline__ size_t b_kstep() const { return (size_t)BK * 2; }
    __device__ __forceinline__ unsigned b_pitch() const { return (unsigned)KB; }
};
struct Moe1Prob {
    static constexpr bool BKN = false, FP8 = true;
    const char* A; const char* Bt; int KB; const int* tok;
    __device__ __forceinline__ unsigned a_row(const Unit& u, int r) const { return (unsigned)tok[u.g * EROWS + u.pm * BM + r]; }
    __device__ __forceinline__ const char* b_base(const Unit& u, int half) const { return Bt + ((size_t)u.g * 4096 + (size_t)u.pn * BM + (size_t)half * HALF) * KB; }
    __device__ __forceinline__ size_t b_kstep() const { return (size_t)BK * 2; }
    __device__ __forceinline__ unsigned b_pitch() const { return (unsigned)KB; }
};
struct Moe2Prob {
    static constexpr bool BKN = false, FP8 = true;
    const char* A; const char* Bt; int KB;
    __device__ __forceinline__ unsigned a_row(const Unit& u, int r) const { return (unsigned)(u.g * EROWS + u.pm * BM + r); }
    __device__ __forceinline__ const char* b_base(const Unit& u, int half) const { return Bt + ((size_t)u.g * DM + (size_t)u.pn * BM + (size_t)half * HALF) * KB; }
    __device__ __forceinline__ size_t b_kstep() const { return (size_t)BK * 2; }
    __device__ __forceinline__ unsigned b_pitch() const { return (unsigned)KB; }
};

struct EpiInProj {
    static constexpr bool PERM = true;
    h16* O; const float* rope;
    __device__ __forceinline__ void operator()(const f32x4 (&acc)[2][2][4][2], const Unit& u, int wr, int wc, int fr, int fq) const {
        const int row0 = u.pm * BM + wr * 64 + fr;
        const int ct0 = u.pn * BM;
        const bool rt0 = (ct0 < OFF_VA) || (ct0 >= OFF_QB && ct0 < OFF_VB), rt1 = (ct0 + HALF < OFF_VA) || (ct0 + HALF >= OFF_QB && ct0 + HALF < OFF_VB);
        const bool any_rope = (rt0 || rt1) && ((wc & 1) == 0);
        float c[8], s[8];
        if (any_rope) { const float* rp = rope + (size_t)(row0 & (SEQ - 1)) * 16;
            const f32x4 c0 = *(const f32x4*)(rp), c1 = *(const f32x4*)(rp + 4), s0 = *(const f32x4*)(rp + 8), s1 = *(const f32x4*)(rp + 12);
#pragma unroll
            for (int j = 0; j < 4; ++j) { c[j] = c0[j]; c[4 + j] = c1[j]; s[j] = s0[j]; s[4 + j] = s1[j]; } }
        else {
#pragma unroll
            for (int j = 0; j < 8; ++j) { c[j] = 1.f; s[j] = 0.f; } }
        const float cd16[8] = {-9.576594803e-01f, -9.992462593e-01f, 8.243765146e-01f, 9.932003012e-01f, 9.997440109e-01f, 9.999903729e-01f, 9.999996380e-01f, 9.999999864e-01f};
        const float sd16[8] = {-2.879033167e-01f, 3.881898152e-02f, 5.660418378e-01f, 1.164180468e-01f, 2.262548617e-02f, 4.387956730e-03f, 8.509272408e-04f, 1.650141653e-04f};
        const float cd80[8] = {-1.103872438e-01f, -9.812132344e-01f, -9.911539132e-01f, 8.345872775e-01f, 9.936068238e-01f, 9.997593311e-01f, 9.999909490e-01f, 9.999996596e-01f};
        const float sd80[8] = {-9.938886539e-01f, 1.929263812e-01f, 1.327174458e-01f, 5.508757358e-01f, 1.128958803e-01f, 2.193809395e-02f, 4.254623881e-03f, 8.250707366e-04f};
        const float sg = (fq == 0) ? -1.f : 1.f;
#pragma unroll
        for (int ai = 0; ai < 2; ++ai)
#pragma unroll
            for (int m = 0; m < 4; ++m) {
                const int row = row0 + ai * HALF + m * 16;
                if (any_rope && (ai | m) != 0) {
#pragma unroll
                    for (int j = 0; j < 8; ++j) { const float cdv = (m == 0) ? cd80[j] : cd16[j], sdv = (m == 0) ? sd80[j] : sd16[j];
                        const float cn = c[j] * cdv - s[j] * sdv, sn = s[j] * cdv + c[j] * sdv; c[j] = cn; s[j] = sn; }
                }
#pragma unroll
                for (int bj = 0; bj < 2; ++bj) {
                    const bool do_rope = (bj ? rt1 : rt0) && ((wc & 1) == 0);
                    const int col0 = ct0 + bj * HALF + wc * 32 + 8 * fq;
                    f32x4 v0 = acc[ai][bj][m][0], v1 = acc[ai][bj][m][1];
                    if (do_rope) {
                        f32x4 p0, p1;
#pragma unroll
                        for (int j = 0; j < 4; ++j) { p0[j] = __shfl_xor(v0[j], 16); p1[j] = __shfl_xor(v1[j], 16); }
                        if (fq < 2) {
#pragma unroll
                            for (int j = 0; j < 4; ++j) { v0[j] = v0[j] * c[j] + (p0[j] * s[j]) * sg; v1[j] = v1[j] * c[4 + j] + (p1[j] * s[4 + j]) * sg; } }
                    }
                    u32x4 w; w.x = pk_h2(v0[0], v0[1]); w.y = pk_h2(v0[2], v0[3]); w.z = pk_h2(v1[0], v1[1]); w.w = pk_h2(v1[2], v1[3]);
                    *(u32x4*)(O + (size_t)row * NIN + col0) = w;
                }
            }
    }
};
struct EpiResidual {
    static constexpr bool PERM = true;
    const float* base; h16* out;
    __device__ __forceinline__ void operator()(const f32x4 (&acc)[2][2][4][2], const Unit& u, int wr, int wc, int fr, int fq) const {
        const int row0 = u.pm * BM + wr * 64 + fr, col0 = u.pn * BM + wc * 32 + 8 * fq;
#pragma unroll
        for (int ai = 0; ai < 2; ++ai) {
            f32x4 xb[4][2][2];
#pragma unroll
            for (int m = 0; m < 4; ++m) { const size_t off = (size_t)(row0 + ai * HALF + m * 16) * DM + col0;
#pragma unroll
                for (int bj = 0; bj < 2; ++bj) { xb[m][bj][0] = __builtin_nontemporal_load((const f32x4*)(base + off + bj * HALF)); xb[m][bj][1] = __builtin_nontemporal_load((const f32x4*)(base + off + bj * HALF + 4)); } }
#pragma unroll
            for (int m = 0; m < 4; ++m) { const size_t off = (size_t)(row0 + ai * HALF + m * 16) * DM + col0;
#pragma unroll
                for (int bj = 0; bj < 2; ++bj) { const f32x4 v0 = xb[m][bj][0] + acc[ai][bj][m][0], v1 = xb[m][bj][1] + acc[ai][bj][m][1];
                    u32x4 w; w.x = pk_h2(v0[0], v0[1]); w.y = pk_h2(v0[2], v0[3]); w.z = pk_h2(v1[0], v1[1]); w.w = pk_h2(v1[2], v1[3]);
                    *(u32x4*)(out + off + bj * HALF) = w; } }
            asm volatile("" ::: "memory");
        }
    }
};
struct EpiSwiGLU {
    static constexpr bool PERM = true;
    unsigned char* O;
    __device__ __forceinline__ void operator()(const f32x4 (&acc)[2][2][4][2], const Unit& u, int wr, int wc, int fr, int fq) const {
        const int row0 = u.g * EROWS + u.pm * BM + wr * 64 + fr, col0 = u.pn * HALF + wc * 32 + 8 * fq;
        constexpr float IS = 1.0f / (S_H2 * S_W);
#pragma unroll
        for (int ai = 0; ai < 2; ++ai)
#pragma unroll
            for (int m = 0; m < 4; ++m) {
                float r[8];
#pragma unroll
                for (int n = 0; n < 2; ++n)
#pragma unroll
                    for (int j = 0; j < 4; ++j) { const float a = acc[ai][0][m][n][j] * IS, up = acc[ai][1][m][n][j] * (IS * S_HM);
                        r[n * 4 + j] = clamp8(a * __builtin_amdgcn_rcpf(1.0f + __builtin_amdgcn_exp2f(-a * LOG2E)) * up); }
                u32x2 w; w.x = pk_fp8x4(r[0], r[1], r[2], r[3]); w.y = pk_fp8x4(r[4], r[5], r[6], r[7]);
                *(u32x2*)(O + (size_t)(row0 + ai * HALF + m * 16) * FF + col0) = w;
            }
    }
};
struct EpiDown {
    static constexpr bool PERM = true;
    unsigned char* O; const float* gate;
    __device__ __forceinline__ void operator()(const f32x4 (&acc)[2][2][4][2], const Unit& u, int wr, int wc, int fr, int fq) const {
        const int row0 = u.g * EROWS + u.pm * BM + wr * 64 + fr, col0 = u.pn * BM + wc * 32 + 8 * fq;
        float gts[2][4];
#pragma unroll
        for (int ai = 0; ai < 2; ++ai)
#pragma unroll
            for (int m = 0; m < 4; ++m) gts[ai][m] = gate[row0 + ai * HALF + m * 16];
#pragma unroll
        for (int ai = 0; ai < 2; ++ai)
#pragma unroll
            for (int m = 0; m < 4; ++m) {
                const int row = row0 + ai * HALF + m * 16; const float gt = gts[ai][m] * (S_YE / (S_HM * S_W));
#pragma unroll
                for (int bj = 0; bj < 2; ++bj) { const f32x4 v0 = acc[ai][bj][m][0] * gt, v1 = acc[ai][bj][m][1] * gt;
                    u32x2 w; w.x = pk_fp8x4(clamp8(v0[0]), clamp8(v0[1]), clamp8(v0[2]), clamp8(v0[3])); w.y = pk_fp8x4(clamp8(v1[0]), clamp8(v1[1]), clamp8(v1[2]), clamp8(v1[3]));
                    *(u32x2*)(O + (size_t)row * DM + col0 + bj * HALF) = w; }
            }
    }
};

template <class Prob, class Epi, class Sched, bool ALIGN_EPI, class Side = NoSide>
__device__ __forceinline__ void gemm_phase(LAS unsigned char* lds, const Prob P, const Sched& S, const Epi& E, const Side SD = Side()) {
    const int tid = threadIdx.x, wid = __builtin_amdgcn_readfirstlane(tid >> 6), lane = tid & 63, wr = wid >> 2, wc = wid & 3, fr = lane & 15, fq = lane >> 4;
    const int KB = P.KB, nt = KB / 128;
    int RA[2]; unsigned CA2[2], voffB[2];
#pragma unroll
    for (int i = 0; i < 2; ++i) { int R, C; stage_rc(tid * 16 + i * 8192, R, C); const int Rb = Epi::PERM ? ((R & ~31) + perm32(R & 31)) : R;
        RA[i] = R; CA2[i] = (unsigned)C * 2u;
        if constexpr (Prob::BKN) {
            static_assert(Epi::PERM, "the [K][N] B path is written for PERM epilogues");
            const int r = 4 * wid + 32 * i + (lane >> 4), g = (r & 3) | (((r >> 3) & 1) << 2), c = (lane & 15) ^ (g << 1);
            voffB[i] = (unsigned)r * P.b_pitch() + (unsigned)c * 16u;
        } else voffB[i] = (unsigned)(Rb * KB) + (unsigned)C * 2u; }
    const unsigned kstep = (unsigned)(BK * 2);
    const size_t kstepB = P.b_kstep();
    int btr[2];
    { const int q = fr >> 2, p = fr & 3, X = ((q | ((fq & 1) << 2)) << 2) | (q & 1);
#pragma unroll
      for (int n = 0; n < 2; ++n) btr[n] = (8 * fq + q) * 256 + (((8 * wc + 2 * p + n) ^ X) * 8); }
    const unsigned lds_u32 = (unsigned)(__UINTPTR_TYPE__)lds;
    unsigned bta[2]; bta[0] = lds_u32 + (unsigned)btr[0]; bta[1] = lds_u32 + (unsigned)btr[1];
    const unsigned rowb = (unsigned)KB;
    const unsigned ldsw = (unsigned)wid * 1024u;
    const int aoff = lds_byte(wr * 64 + fr, fq * 8), boff = lds_byte(wc * 32 + fr, fq * 8);
#define PG8_SA(b, h) (((b) * 2 + (h)) * HTB)
#define PG8_SB(b, h) ((4 + (b) * 2 + (h)) * HTB)
#define PG8_STAGE_B(bufoff, gbase) do { _Pragma("unroll") for (int _i = 0; _i < 2; ++_i) \
        __builtin_amdgcn_global_load_lds((const unsigned*)((const char*)(gbase) + voffB[_i]), (LAS unsigned*)(lds + (bufoff) + ldsw + _i * 8192), 16, 0, 0); } while (0)
#define PG8_STAGE_A(bufoff, kb, offs) do { _Pragma("unroll") for (int _i = 0; _i < 2; ++_i) \
        __builtin_amdgcn_global_load_lds((const unsigned*)(P.A + (size_t)(kb) + (offs)[_i]), (LAS unsigned*)(lds + (bufoff) + ldsw + _i * 8192), 16, 0, 0); } while (0)
#define PG8_LDA(dst, b, h) do { if constexpr (Prob::FP8) { _Pragma("unroll") for (int m = 0; m < 4; ++m) { dst##8[m].lo = *(const LAS v4i_*)(lds + PG8_SA(b, h) + aoff + m * 2048); dst##8[m].hi = *(const LAS v4i_*)(lds + PG8_SA(b, h) + aoff + m * 2048 + 1024); } } \
        else { _Pragma("unroll") for (int m = 0; m < 4; ++m) _Pragma("unroll") for (int k = 0; k < 2; ++k) dst[m][k] = *(const LAS half8*)(lds + PG8_SA(b, h) + aoff + m * 2048 + k * 1024); } } while (0)
#define PG8_LDB(dst, b, h) do { if constexpr (Prob::BKN) { _Pragma("unroll") for (int n = 0; n < 2; ++n) { const unsigned ad_ = bta[n] + (unsigned)PG8_SB(b, h); _Pragma("unroll") for (int k = 0; k < 2; ++k) { \
            asm volatile("ds_read_b64_tr_b16 %0, %1 offset:%c2" : "=&v"(dst##lo[n][k]) : "v"(ad_), "i"(k * 8192) : "memory"); \
            asm volatile("ds_read_b64_tr_b16 %0, %1 offset:%c2" : "=&v"(dst##hi[n][k]) : "v"(ad_), "i"(k * 8192 + 1024) : "memory"); } } } \
        else if constexpr (Prob::FP8) { _Pragma("unroll") for (int n = 0; n < 2; ++n) { dst##8[n].lo = *(const LAS v4i_*)(lds + PG8_SB(b, h) + boff + n * 2048); dst##8[n].hi = *(const LAS v4i_*)(lds + PG8_SB(b, h) + boff + n * 2048 + 1024); } } \
        else { _Pragma("unroll") for (int n = 0; n < 2; ++n) _Pragma("unroll") for (int k = 0; k < 2; ++k) dst[n][k] = *(const LAS half8*)(lds + PG8_SB(b, h) + boff + n * 2048 + k * 1024); } } while (0)
#define PG8_BFIX(dst) do { if constexpr (Prob::BKN) { typedef short s16x8_ __attribute__((ext_vector_type(8))); _Pragma("unroll") for (int n = 0; n < 2; ++n) _Pragma("unroll") for (int k = 0; k < 2; ++k) { \
            const s16x8_ v_ = __builtin_shufflevector(dst##lo[n][k], dst##hi[n][k], 0, 1, 2, 3, 4, 5, 6, 7); dst[n][k] = __builtin_bit_cast(half8, v_); } } } while (0)
#define PG8_MMA(ai, bj, At, Bt) do { __builtin_amdgcn_s_setprio(1); _Pragma("unroll") for (int m = 0; m < 4; ++m) _Pragma("unroll") for (int n = 0; n < 2; ++n) { \
        if constexpr (Prob::FP8) asm volatile("v_mfma_f32_16x16x128_f8f6f4 %0, %1, %2, %0" : "+v"(acc[ai][bj][m][n]) : "v"(Bt##8[n]), "v"(At##8[m])); \
        else { _Pragma("unroll") for (int k = 0; k < 2; ++k) acc[ai][bj][m][n] = __builtin_amdgcn_mfma_f32_16x16x32_f16(Bt[n][k], At[m][k], acc[ai][bj][m][n], 0, 0, 0); } } \
        __builtin_amdgcn_s_setprio(0); } while (0)
#define PG8_WAIT_V(n) asm volatile("s_waitcnt vmcnt(" #n ")" ::: "memory")
#define PG8_WAIT_L(n) asm volatile("s_waitcnt lgkmcnt(" #n ")" ::: "memory")
#define PG8_BAR __builtin_amdgcn_s_barrier()
#define PG8_SCHED __builtin_amdgcn_sched_barrier(0)
#define PG8_SIDE_ISSUE(slot) do { if constexpr (Side::ON) { sfly = SD.L->pending() && (((slot) % SD.every) == 0); \
        if (sfly) { scc = SD.L->chunk(SD.L->done); const float* sp_ = SD.L->src_of(SD.L->wa, SD.L->wb, scc); \
            asm volatile("global_load_dwordx4 %0, %2, off\n\tglobal_load_dwordx4 %1, %2, off offset:16" : "=&v"(sr0), "=&v"(sr1) : "v"(sp_) : "memory"); } } } while (0)
#define PG8_SIDE_FINISH() do { if constexpr (Side::ON) { if (sfly) { asm volatile("" : "+v"(sr0), "+v"(sr1)); SD.L->store(SD.L->da, scc, sr0, sr1); SD.L->done += 1; } PG8_SCHED; } } while (0)
#define PG8_WAIT_VS(extra) do { if constexpr (Side::ON) { if (sfly) { if ((extra) == 2) PG8_WAIT_V(10); else PG8_WAIT_V(9); } else PG8_WAIT_V(8); } else PG8_WAIT_V(8); } while (0)
#define PG8_AOFF(dst, un) do { _Pragma("unroll") for (int _h = 0; _h < 2; ++_h) _Pragma("unroll") for (int _i = 0; _i < 2; ++_i) dst[_h][_i] = P.a_row(un, _h * HALF + RA[_i]) * rowb + CA2[_i]; } while (0)
    Unit cur, nxt; int ui = 0;
    if (!S.next(0, cur)) return;
    bool sfly = false; f32x4 sr0, sr1; unsigned scc = 0;
    f32x4 acc[2][2][4][2];
#pragma unroll
    for (int a = 0; a < 2; ++a)
#pragma unroll
        for (int b = 0; b < 2; ++b)
#pragma unroll
            for (int m = 0; m < 4; ++m)
#pragma unroll
                for (int n = 0; n < 2; ++n) acc[a][b][m][n] = (f32x4){0.f, 0.f, 0.f, 0.f};
    typedef int v4i_ __attribute__((ext_vector_type(4))); typedef int v8i_ __attribute__((ext_vector_type(8)));
    half8 At[4][2], B0[2][2], B1[2][2];
    s16x4 B0lo[2][2], B0hi[2][2], B1lo[2][2], B1hi[2][2];
    v8i_ At8[4], B08[2], B18[2];
    unsigned cuo[2][2], nxo[2][2];
    PG8_AOFF(cuo, cur);
    const char* cB0 = P.b_base(cur, 0); const char* cB1 = P.b_base(cur, 1);
    PG8_STAGE_B(PG8_SB(0, 0), cB0); PG8_STAGE_B(PG8_SB(0, 1), cB1); PG8_STAGE_A(PG8_SA(0, 0), 0, cuo[0]); PG8_STAGE_A(PG8_SA(0, 1), 0, cuo[1]);
    if (wr == 1) PG8_BAR;
    PG8_WAIT_V(2); PG8_BAR;
    PG8_STAGE_B(PG8_SB(1, 0), cB0 + kstepB); PG8_STAGE_A(PG8_SA(1, 0), kstep, cuo[0]); PG8_STAGE_B(PG8_SB(1, 1), cB1 + kstepB);
    PG8_WAIT_V(6); PG8_BAR;
    for (;;) {
        const bool has_next = S.next(ui + 1, nxt);
        if (!has_next) nxt = cur;
        PG8_AOFF(nxo, nxt);
        const char* nB0 = P.b_base(nxt, 0); const char* nB1 = P.b_base(nxt, 1);
        for (int t = 0; t < nt; t += 2) {
            const bool last = (t == nt - 2);
            const unsigned k1 = (unsigned)(t + 1) * kstep;
            const unsigned k2 = last ? 0u : (unsigned)(t + 2) * kstep, k3 = k2 + kstep;
            const char* b20 = last ? nB0 : cB0 + (size_t)(t + 2) * kstepB; const char* b21 = last ? nB1 : cB1 + (size_t)(t + 2) * kstepB;
            const char* b30 = b20 + kstepB; const char* b31 = b21 + kstepB;
            unsigned o20[2], o21[2];
#pragma unroll
            for (int i = 0; i < 2; ++i) { o20[i] = last ? nxo[0][i] : cuo[0][i]; o21[i] = last ? nxo[1][i] : cuo[1][i]; }
            PG8_LDB(B0, 0, 0); PG8_LDB(B1, 0, 1); PG8_SCHED; PG8_LDA(At, 0, 0); PG8_STAGE_A(PG8_SA(1, 1), k1, cuo[1]); PG8_SIDE_ISSUE((ui * nt + t) >> 1);
            PG8_WAIT_VS(2);
            PG8_WAIT_L(0); PG8_SCHED; PG8_BFIX(B0); PG8_BFIX(B1); PG8_BAR; PG8_MMA(0, 0, At, B0); PG8_MMA(0, 1, At, B1); PG8_BAR; PG8_SCHED;
            PG8_LDA(At, 0, 1); PG8_STAGE_B(PG8_SB(0, 0), b20); PG8_STAGE_B(PG8_SB(0, 1), b21); PG8_STAGE_A(PG8_SA(0, 0), k2, o20);
            PG8_WAIT_VS(2); PG8_WAIT_L(0); PG8_BAR; PG8_MMA(1, 0, At, B0); PG8_MMA(1, 1, At, B1); PG8_BAR; PG8_SCHED;
            PG8_LDB(B0, 1, 0); PG8_LDB(B1, 1, 1); PG8_SCHED; PG8_LDA(At, 1, 0); PG8_STAGE_A(PG8_SA(0, 1), k2, o21);
            PG8_WAIT_V(8);
            PG8_WAIT_L(0); PG8_SCHED; PG8_BFIX(B0); PG8_BFIX(B1); PG8_BAR; PG8_MMA(0, 0, At, B0); PG8_MMA(0, 1, At, B1); PG8_BAR; PG8_SCHED;
            PG8_SIDE_FINISH();
            PG8_LDA(At, 1, 1); PG8_STAGE_B(PG8_SB(1, 0), b30); PG8_STAGE_B(PG8_SB(1, 1), b31); PG8_STAGE_A(PG8_SA(1, 0), k3, o20);
            PG8_WAIT_VS(1); PG8_WAIT_L(0); PG8_BAR; PG8_MMA(1, 0, At, B0); PG8_MMA(1, 1, At, B1); PG8_BAR; PG8_SCHED;
            if constexpr (Side::ON) sfly = false;
        }
        if constexpr (ALIGN_EPI) { if (wr == 0) PG8_BAR; }
        if constexpr (Prob::FP8) asm volatile("s_nop 15\n\ts_nop 15" ::: "memory");
        E(acc, cur, wr, wc, fr, fq);
        if (!has_next) break;
#pragma unroll
        for (int a = 0; a < 2; ++a)
#pragma unroll
            for (int b = 0; b < 2; ++b)
#pragma unroll
                for (int m = 0; m < 4; ++m)
#pragma unroll
                    for (int n = 0; n < 2; ++n) acc[a][b][m][n] = (f32x4){0.f, 0.f, 0.f, 0.f};
        cur = nxt; cB0 = nB0; cB1 = nB1; ++ui;
#pragma unroll
        for (int h = 0; h < 2; ++h)
#pragma unroll
            for (int i = 0; i < 2; ++i) cuo[h][i] = nxo[h][i];
        if constexpr (ALIGN_EPI) { if (wr == 1) PG8_BAR; }
    }
    PG8_WAIT_V(0);
    if constexpr (!ALIGN_EPI) { if (wr == 0) PG8_BAR; }
    PG8_BAR;
#undef PG8_SA
#undef PG8_SB
#undef PG8_STAGE_A
#undef PG8_STAGE_B
#undef PG8_LDA
#undef PG8_LDB
#undef PG8_BFIX
#undef PG8_MMA
#undef PG8_WAIT_V
#undef PG8_WAIT_L
#undef PG8_BAR
#undef PG8_SCHED
#undef PG8_AOFF
#undef PG8_SIDE_ISSUE
#undef PG8_SIDE_FINISH
#undef PG8_WAIT_VS
}

__device__ __forceinline__ void tail_quarter(LAS unsigned char* lds, const char* A, const char* Bt, h16* O, int unit) {
    const int tid = threadIdx.x, wid = __builtin_amdgcn_readfirstlane(tid >> 6), lane = tid & 63, wr = wid >> 2, wc = wid & 3, fr = lane & 15, fq = lane >> 4;
    const int pm = unit >> 2, ai = (unit >> 1) & 1, bj = unit & 1;
    constexpr unsigned KB = DM * 2; constexpr int NT = DM * 2 / 128, SB = 2 * HTB, C0 = NIN - BM;
    unsigned oa[2], ob[2];
#pragma unroll
    for (int i = 0; i < 2; ++i) { int R, C; stage_rc(tid * 16 + i * 8192, R, C); const int Rb = (R & ~31) + perm32(R & 31);
        oa[i] = (unsigned)(pm * BM + ai * HALF + R) * KB + (unsigned)C * 2u; ob[i] = (unsigned)(C0 + bj * HALF + Rb) * KB + (unsigned)C * 2u; }
    const unsigned ldsw = (unsigned)wid * 1024u;
    const int aoff = lds_byte(wr * 64 + fr, fq * 8), boff = HTB + lds_byte(wc * 32 + fr, fq * 8);
#define TQ_STAGE(t) do { const int s_ = ((t) & 3) * SB; _Pragma("unroll") for (int _i = 0; _i < 2; ++_i) { \
        __builtin_amdgcn_global_load_lds((const unsigned*)(A + oa[_i] + (t) * 128), (LAS unsigned*)(lds + s_ + ldsw + _i * 8192), 16, 0, 0); \
        __builtin_amdgcn_global_load_lds((const unsigned*)(Bt + ob[_i] + (t) * 128), (LAS unsigned*)(lds + s_ + HTB + ldsw + _i * 8192), 16, 0, 0); } } while (0)
    f32x4 acc[4][2];
#pragma unroll
    for (int m = 0; m < 4; ++m)
#pragma unroll
        for (int n = 0; n < 2; ++n) acc[m][n] = (f32x4){0.f, 0.f, 0.f, 0.f};
    TQ_STAGE(0); TQ_STAGE(1); TQ_STAGE(2);
#pragma unroll
    for (int t = 0; t < NT; ++t) {
        if (t < NT - 2) asm volatile("s_waitcnt vmcnt(8)" ::: "memory"); else if (t == NT - 2) asm volatile("s_waitcnt vmcnt(4)" ::: "memory"); else asm volatile("s_waitcnt vmcnt(0)" ::: "memory");
        __builtin_amdgcn_s_barrier();
        __builtin_amdgcn_sched_barrier(0);
        if (t + 3 < NT) TQ_STAGE(t + 3);
        const int s = (t & 3) * SB;
        half8 a[4][2], b[2][2];
#pragma unroll
        for (int n = 0; n < 2; ++n)
#pragma unroll
            for (int k = 0; k < 2; ++k) b[n][k] = *(const LAS half8*)(lds + s + boff + n * 2048 + k * 1024);
#pragma unroll
        for (int m = 0; m < 4; ++m)
#pragma unroll
            for (int k = 0; k < 2; ++k) a[m][k] = *(const LAS half8*)(lds + s + aoff + m * 2048 + k * 1024);
        asm volatile("s_waitcnt lgkmcnt(0)" ::: "memory");
        __builtin_amdgcn_sched_barrier(0);
#pragma unroll
        for (int m = 0; m < 4; ++m)
#pragma unroll
            for (int n = 0; n < 2; ++n)
#pragma unroll
                for (int k = 0; k < 2; ++k) acc[m][n] = __builtin_amdgcn_mfma_f32_16x16x32_f16(b[n][k], a[m][k], acc[m][n], 0, 0, 0);
        __builtin_amdgcn_sched_barrier(0);
    }
#undef TQ_STAGE
    const int row0 = pm * BM + ai * HALF + wr * 64 + fr, col0 = C0 + bj * HALF + wc * 32 + 8 * fq;
#pragma unroll
    for (int m = 0; m < 4; ++m) { const f32x4 v0 = acc[m][0], v1 = acc[m][1];
        u32x4 w; w.x = pk_h2(v0[0], v0[1]); w.y = pk_h2(v0[2], v0[3]); w.z = pk_h2(v1[0], v1[1]); w.w = pk_h2(v1[2], v1[3]);
        *(u32x4*)(O + (size_t)(row0 + m * 16) * NIN + col0) = w; }
    __builtin_amdgcn_s_barrier();
}
}

#define XB_TMO      128
#define XB_XCNT(j)  (256  + 64 * (j))
#define XB_XSUB(j)  (1280 + 64 * (j))
#define XB_XGEN(j)  (2304 + 64 * (j))
#define XB_TOP      3328
#define XB_TOPGEN   3392
#define XCD_BAR_WORDS 3456
#define XB_SPIN_CAP (1u << 18)
__device__ __forceinline__ unsigned xb_ld(unsigned* p)              { return __hip_atomic_load(p, __ATOMIC_RELAXED, __HIP_MEMORY_SCOPE_AGENT); }
__device__ __forceinline__ unsigned xb_add(unsigned* p, unsigned v) { return __hip_atomic_fetch_add(p, v, __ATOMIC_RELAXED, __HIP_MEMORY_SCOPE_AGENT); }
__device__ __forceinline__ unsigned xb_xcc_id() { return (unsigned)__builtin_amdgcn_s_getreg((3 << 11) | 20) & 0xFu; }
#define XB_SPIN(cond, bar) do { unsigned _sp = 0; while (cond) { __builtin_amdgcn_s_sleep(1); \
    if ((++_sp & 255u) == 0u) { if (xb_ld(&(bar)[XB_TMO])) break; if (_sp > XB_SPIN_CAP) { atomicAdd(&(bar)[XB_TMO], 1u); break; } } } } while (0)
struct XcdBarrier { unsigned* bar; unsigned x; volatile LAS unsigned* st; };
__device__ __forceinline__ XcdBarrier xcd_barrier_post(unsigned* bar, volatile LAS unsigned* st) {
    XcdBarrier b; b.bar = bar; b.x = xb_xcc_id(); b.st = st;
    if (threadIdx.x == 0) (void)xb_add(&bar[XB_XCNT(b.x)], 1u);
    return b;
}
__device__ __forceinline__ void xcd_barrier_complete(unsigned* bar, unsigned x, unsigned& nloc, unsigned& nx) {
    const unsigned G = gridDim.x * gridDim.y * gridDim.z;
    unsigned sum, cnt, mine, sp = 0u;
    for (;;) {
        sum = 0u; cnt = 0u; mine = 0u;
#pragma unroll
        for (unsigned j = 0; j < 16; ++j) { const unsigned c = xb_ld(&bar[XB_XCNT(j)]); sum += c; cnt += (c > 0u) ? 1u : 0u; mine = (j == x) ? c : mine; }
        if (sum == G) break;
        __builtin_amdgcn_s_sleep(1);
        if ((++sp & 255u) == 0u) { if (xb_ld(&bar[XB_TMO])) break; if (sp > XB_SPIN_CAP) { atomicAdd(&bar[XB_TMO], 1u); break; } }
    }
    nloc = mine > 0u ? mine : 1u; nx = cnt > 0u ? cnt : 1u;
}
__device__ __forceinline__ void xcd_barrier(const XcdBarrier& b) {
    asm volatile("s_waitcnt vmcnt(0)" ::: "memory");
    __syncthreads();
    if (threadIdx.x == 0) {
        unsigned* bar = b.bar;
        __builtin_amdgcn_s_waitcnt(0);
        unsigned nloc = b.st[0], nx = b.st[1];
        if (nloc == 0u) { xcd_barrier_complete(bar, b.x, nloc, nx); b.st[0] = nloc; b.st[1] = nx; }
        const unsigned old = xb_add(&bar[XB_XSUB(b.x)], 1u);
        const unsigned gen = old / nloc;
        if (old + 1u == (gen + 1u) * nloc) {
            __builtin_amdgcn_fence(__ATOMIC_RELEASE, "agent");
            asm volatile("s_waitcnt vmcnt(0)" ::: "memory");
            const unsigned og = xb_add(&bar[XB_TOP], 1u);
            const unsigned tg = og / nx;
            if (og + 1u == (tg + 1u) * nx) xb_add(&bar[XB_TOPGEN], 1u);
            else XB_SPIN(xb_ld(&bar[XB_TOPGEN]) == tg, bar);
            __builtin_amdgcn_fence(__ATOMIC_ACQUIRE, "agent");
            xb_add(&bar[XB_XGEN(b.x)], 1u);
            asm volatile("s_waitcnt vmcnt(0)" ::: "memory");
        } else {
            XB_SPIN(xb_ld(&bar[XB_XGEN(b.x)]) == gen, bar);
            __builtin_amdgcn_fence(__ATOMIC_ACQUIRE, "agent");
            asm volatile("s_waitcnt vmcnt(0)" ::: "memory");
        }
    }
    __syncthreads();
}

struct Frame {
    LAS unsigned char* lds;
    int tid, lane, wave, vcu, G;
    const float *x, *g_mix, *w_in, *a_sink, *g_out_a, *g_out_b, *w_out, *g_ffn, *w_router, *w_gate, *w_up, *w_down, *g_final;
    float* out; unsigned char* ws;
    unsigned long long tacc;
};

__device__ __forceinline__ void p0_transpose_item(const float* W, int K, int N, h16* WT, int k0, int n0, int drow0, float sc, LAS float* scr, int lane) {
#pragma unroll 8
    for (int i = 0; i < 32; ++i) { const int kk = 2 * i + (lane >> 5); scr[kk * 33 + (lane & 31)] = W[(size_t)(k0 + kk) * N + n0 + (lane & 31)]; }
    LDS_WAIT(); asm volatile("" ::: "memory");
    const int c = lane & 7;
#pragma unroll
    for (int j = 0; j < 4; ++j) { const int n = (lane >> 3) + 8 * j; const LAS float* s = scr + (8 * c) * 33 + n;
        u32x4 o; o.x = pk_h2(s[0 * 33] * sc, s[1 * 33] * sc); o.y = pk_h2(s[2 * 33] * sc, s[3 * 33] * sc); o.z = pk_h2(s[4 * 33] * sc, s[5 * 33] * sc); o.w = pk_h2(s[6 * 33] * sc, s[7 * 33] * sc);
        *(GAS u32x4*)(WT + (size_t)(drow0 + n) * K + k0 + 8 * c) = o; }
    LDS_WAIT(); asm volatile("" ::: "memory");
}
__device__ __forceinline__ void sincos_d(double a, float& s, float& c) {
    const double q = __builtin_rint(a * 0.63661977236758134308);
    double r = __builtin_fma(-q, 1.570796325802803, a); r = __builtin_fma(-q, 9.920935796805404e-10, r);
    const double r2 = r * r;
    double sp = -7.6471637318198164759e-13;
    sp = sp * r2 + 1.6059043836821614599e-10; sp = sp * r2 - 2.5052108385441718775e-08; sp = sp * r2 + 2.7557319223985890653e-06;
    sp = sp * r2 - 1.9841269841269841270e-04; sp = sp * r2 + 8.3333333333333333333e-03; sp = sp * r2 - 1.6666666666666666667e-01;
    const double sn = r + r * r2 * sp;
    double cp = 4.7794773323873852974e-14;
    cp = cp * r2 - 1.1470745597729724714e-11; cp = cp * r2 + 2.0876756987868098979e-09; cp = cp * r2 - 2.7557319223985890653e-07;
    cp = cp * r2 + 2.4801587301587301587e-05; cp = cp * r2 - 1.3888888888888888889e-03; cp = cp * r2 + 4.1666666666666666667e-02; cp = cp * r2 - 0.5;
    const double cs = 1.0 + r2 * cp;
    const int qi = (int)q & 3;
    const double ss = (qi & 1) ? cs : sn, cc = (qi & 1) ? sn : cs;
    s = (float)((qi & 2) ? -ss : ss); c = (float)(((qi + 1) & 2) ? -cc : cc);
}

__device__ __forceinline__ void p0_prologue(Frame& F) {
    LAS float* scr = (LAS float*)(F.lds + F.wave * 16384);
    const int gw = F.vcu * NWAVES + F.wave, NGW = F.G * NWAVES;
    {
        const double invf[8] = {1.0, 0.19392274474868576, 0.03760603093086393, 0.007292664737217109, 0.001414213562373095, 0.0002742481756762073, 5.318295896944988e-05, 1.031338537721246e-05};
        float* rope = (float*)(F.ws + WS_ROPE);
        for (int idx = F.vcu * 512 + F.tid; idx < SEQ * 8; idx += F.G * 512) {
            const int pos = idx >> 3, i = idx & 7;
            double f = invf[0];
#pragma unroll
            for (int j = 1; j < 8; ++j) f = (i == j) ? invf[j] : f;
            float s, c; sincos_d((double)pos * f, s, c);
            rope[pos * 16 + i] = c; rope[pos * 16 + 8 + i] = s;
        }
    }
    {
        h16* H = (h16*)(F.ws + WS_H);
        for (int m = gw; m < M; m += NGW) {
            const GAS f32x4* xr = (const GAS f32x4*)(F.x + (size_t)m * DM) + F.lane;
            f32x4 v[4]; float s = 0.f;
#pragma unroll
            for (int j = 0; j < 4; ++j) { v[j] = __builtin_nontemporal_load(xr + 64 * j); s += (v[j].x * v[j].x + v[j].y * v[j].y) + (v[j].z * v[j].z + v[j].w * v[j].w); }
            const float rs = 1.0f / sqrtf(wave_sum(s) * (1.0f / DM) + NORM_EPS);
            GAS u32x2* o8 = (GAS u32x2*)(H + (size_t)m * DM) + F.lane;
#pragma unroll
            for (int j = 0; j < 4; ++j) { const f32x4 g = ((const GAS f32x4*)F.g_mix)[F.lane + 64 * j]; const f32x4 y = v[j] * rs * g;
                u32x2 w; w.x = pk_h2(y.x, y.y); w.y = pk_h2(y.z, y.w); o8[64 * j] = w; }
        }
    }
    {
        constexpr int I_IN = (DM / 64) * (NIN / 32), I_OUT = (DM / 64) * (DM / 32);
        constexpr int NITEMS = I_IN + I_OUT;
        for (int it = gw; it < NITEMS; it += NGW) {
            int r = it;
            if (r < I_IN) { const int nblk = NIN / 32, kb = r / nblk, nb = r % nblk, n0 = 32 * nb;
                const float sc = (n0 < OFF_KA || (n0 >= OFF_QB && n0 < OFF_KB)) ? QSCALE : 1.0f;
                p0_transpose_item(F.w_in, DM, NIN, (h16*)(F.ws + WS_WIN), 64 * kb, n0, n0, sc, scr, F.lane); continue; }
            r -= I_IN;
            { const int nblk = DM / 32, kb = r / nblk, nb = r % nblk, n0 = 32 * nb;
              p0_transpose_item(F.w_out, DM, DM, (h16*)(F.ws + WS_WOUT), 64 * kb, n0, n0, 1.0f, scr, F.lane); }
        }
    }
}

#define TSEC_BEGIN(code) unsigned long long tsec_##code = 0; if (TIME_PHASE == (code)) tsec_##code = __builtin_amdgcn_s_memrealtime()
#define TSEC_END(code) do { if (TIME_PHASE == (code)) F.tacc += __builtin_amdgcn_s_memrealtime() - tsec_##code; } while (0)
namespace att {
__device__ __forceinline__ int crow(int r, int hi) { return (r & 3) + 8 * (r >> 2) + 4 * hi; }
constexpr float THR = 8.0f;
constexpr int ATT_SIDE = 0;
constexpr int TILE_BYTES = 16384;
constexpr int WSF_OFF = 98304, STG_OFF = 100352;

__device__ __forceinline__ float max3f(float a, float b, float c) { float r; asm("v_max3_f32 %0, %1, %2, %3" : "=v"(r) : "v"(a), "v"(b), "v"(c)); return r; }
__device__ __forceinline__ float max16(const f32x16& p) {
    float a = max3f(p[0], p[1], p[2]), b = max3f(p[3], p[4], p[5]); a = max3f(a, p[6], p[7]); b = max3f(b, p[8], p[9]); a = max3f(a, p[10], p[11]); b = max3f(b, p[12], p[13]);
    return max3f(a, b, max3f(p[14], p[15], p[15])); }
__device__ __forceinline__ void tile_step(f32x16& o0, f32x16& o1, float& m, float& l, f32x16& negm, bool first, const half8 (&qr)[4],
                                          LAS const unsigned char* kt, LAS const unsigned char* vt, LAS float* wsf, int lane, int r32, int hi,
                                          int mode0, int mode1, int rel0, int lo, unsigned span) {
    f32x16 p0 = negm, p1 = negm;
    LAS const unsigned char* kb = kt + hi * 1024 + r32 * 16;
    const float NINF = -__builtin_inff();
    float rm = NINF;
    if (mode0) {
#pragma unroll
        for (int d0 = 0; d0 < 4; ++d0) p0 = __builtin_amdgcn_mfma_f32_32x32x16_f16(*(LAS const half8*)(kb + d0 * 2048), qr[d0], p0, 0, 0, 0);
        asm volatile("s_nop 15\n\ts_nop 7" : "+v"(p0));
        if (mode0 == 2) {
#pragma unroll
            for (int r = 0; r < 16; ++r) { const int rel = rel0 + (r & 3) + 8 * (r >> 2); if ((unsigned)(rel - lo) > span) p0[r] = NINF; }
        }
        rm = max16(p0);
    }
    if (mode1) {
#pragma unroll
        for (int d0 = 0; d0 < 4; ++d0) p1 = __builtin_amdgcn_mfma_f32_32x32x16_f16(*(LAS const half8*)(kb + d0 * 2048 + 512), qr[d0], p1, 0, 0, 0);
        asm volatile("s_nop 15\n\ts_nop 7" : "+v"(p1));
        if (mode1 == 2) {
#pragma unroll
            for (int r = 0; r < 16; ++r) { const int rel = rel0 + 32 + (r & 3) + 8 * (r >> 2); if ((unsigned)(rel - lo) > span) p1[r] = NINF; }
        }
        rm = fmaxf(rm, max16(p1));
    }
    { auto rr = __builtin_amdgcn_permlane32_swap(__float_as_uint(rm), __float_as_uint(rm), false, false); rm = fmaxf(__uint_as_float(rr[0]), __uint_as_float(rr[1])); }
    if (first || __any(rm > THR)) {
        const float dl = first ? fmaxf(rm, -100.f) : fmaxf(rm, 0.f); m += dl;
#pragma unroll
        for (int r = 0; r < 16; ++r) { p0[r] -= dl; p1[r] -= dl; negm[r] = -m; }
        if (!first) {
            const float f = __builtin_amdgcn_exp2f(-dl); l *= f;
            if (hi == 0) wsf[r32] = f;
            LDS_WAIT();
#pragma unroll
            for (int r = 0; r < 16; ++r) { const float fr_ = wsf[crow(r, hi)]; o0[r] *= fr_; o1[r] *= fr_; }
        }
    }
    LAS const unsigned char* vb = vt + (4 * hi + ((lane & 15) >> 2)) * 64 + ((lane >> 4) & 1) * 32 + (lane & 3) * 8;
    typedef short s16x8 __attribute__((ext_vector_type(8)));
    float s = 0.f;
#define ATT_HALF(P, KS0) do { \
        _Pragma("unroll") for (int r = 0; r < 16; ++r) { P[r] = __builtin_amdgcn_exp2f(P[r]); s += P[r]; } \
        u32x4 pwa, pwb; \
        _Pragma("unroll") for (int j = 0; j < 4; ++j) { pwa[j] = pk_h2_rtz(P[2 * j], P[2 * j + 1]); pwb[j] = pk_h2_rtz(P[8 + 2 * j], P[9 + 2 * j]); } \
        _Pragma("unroll") for (int kk = 0; kk < 2; ++kk) { const half8 pa = __builtin_bit_cast(half8, kk ? pwb : pwa); \
            _Pragma("unroll") for (int d0 = 0; d0 < 2; ++d0) { \
                const s16x4 vlo = __builtin_amdgcn_ds_read_tr16_b64_v4i16((LAS s16x4*)(vb + d0 * 4096 + ((KS0) + kk) * 1024)); \
                const s16x4 vhi = __builtin_amdgcn_ds_read_tr16_b64_v4i16((LAS s16x4*)(vb + d0 * 4096 + ((KS0) + kk) * 1024 + 512)); \
                const s16x8 vv = {vlo[0], vlo[1], vlo[2], vlo[3], vhi[0], vhi[1], vhi[2], vhi[3]}; \
                const half8 vf = __builtin_bit_cast(half8, vv); \
                if (d0 == 0) o0 = __builtin_amdgcn_mfma_f32_32x32x16_f16(pa, vf, o0, 0, 0, 0); \
                else         o1 = __builtin_amdgcn_mfma_f32_32x32x16_f16(pa, vf, o1, 0, 0, 0); } } } while (0)
    if (mode0) ATT_HALF(p0, 0);
    if (mode1) ATT_HALF(p1, 2);
#undef ATT_HALF
    l += s;
}

__device__ __forceinline__ void load_tile_regs(u32x4& kreg, u32x4& vreg, const h16* proj, int tokb, int dil, int LF, int tt0, int kcol, int vcol, int wid, int lane) {
    int tk = tt0 + lane; tk = tk < 0 ? 0 : (tk >= LF ? LF - 1 : tk);
    kreg = *(const u32x4*)(proj + (size_t)(tokb + tk * dil) * NIN + kcol + wid * 8);
    int tv = tt0 + (wid & 3) * 16 + (lane >> 2); tv = tv < 0 ? 0 : (tv >= LF ? LF - 1 : tv);
    vreg = *(const u32x4*)(proj + (size_t)(tokb + tv * dil) * NIN + vcol + (wid >> 2) * 32 + (lane & 3) * 8);
}

__device__ __forceinline__ void store_out(const f32x16& o0, const f32x16& o1, float l_tot, LAS float* wsf, LAS h16* stg, h16* dst, size_t pitch, int tok0, int dil, int lane, int r32, int hi) {
    if (hi == 0) wsf[32 + r32] = l_tot;
    LDS_WAIT();
#pragma unroll
    for (int r = 0; r < 16; ++r) { const int orow = crow(r, hi); const float rl = __builtin_amdgcn_rcpf(wsf[32 + orow]);
        stg[orow * 64 + r32] = __builtin_bit_cast(h16, (_Float16)(o0[r] * rl)); stg[orow * 64 + 32 + r32] = __builtin_bit_cast(h16, (_Float16)(o1[r] * rl)); }
    LDS_WAIT();
#pragma unroll
    for (int i = 0; i < 4; ++i) { const int row = i * 8 + (lane >> 3), ch = lane & 7; const u32x4 v = *(LAS const u32x4*)(stg + row * 64 + ch * 8);
        *(u32x4*)(dst + (size_t)(tok0 + row * dil) * pitch + ch * 8) = v; }
    LDS_WAIT();
}

struct UnitP { int isA, ntile, tt_first, dil, LF, tokb, kcol, vcol, hw, q0, g, h, p; };
__device__ __forceinline__ UnitP decode_unit(int u) {
    UnitP P;
    if (u < 512) { const int qb = u & 63, g = (u >> 6) & 1, b = u >> 7;
        P.isA = 1; P.ntile = 5; P.q0 = qb * 64; P.tt_first = P.q0 - 128; P.dil = 1; P.LF = SEQ; P.tokb = b * SEQ; P.kcol = OFF_KA + g * 64; P.vcol = OFF_VA + g * 64; P.hw = 128; P.g = g; P.h = 0; P.p = 0; }
    else { const int v = u - 512, u16 = v & 15, p = (v >> 4) % 3, bh = v / 48, h = bh & 7, b = bh >> 3, sh = 2 * p, dil = 1 << sh, res = u16 & (dil - 1), qb = u16 >> sh;
        P.isA = 0; P.ntile = 6; P.q0 = 256 * qb; P.tt_first = P.q0 - 64; P.dil = dil; P.LF = SEQ >> sh; P.tokb = b * SEQ + res; P.kcol = OFF_KB + h * 64; P.vcol = OFF_VB + h * 64; P.hw = 64; P.g = 0; P.h = h; P.p = p; }
    return P;
}
__device__ __forceinline__ void issue_tiles(u32x4 (&kr)[6], u32x4 (&vr)[6], const UnitP& P, const h16* proj, int wid, int lane) {
#pragma unroll
    for (int j = 0; j < 6; ++j) { const int tt0 = P.tt_first + 64 * j; if (j < P.ntile && tt0 >= 0 && tt0 < P.LF) load_tile_regs(kr[j], vr[j], proj, P.tokb, P.dil, P.LF, tt0, P.kcol, P.vcol, wid, lane); }
}
__device__ __forceinline__ void write_tiles(LAS unsigned char* L, const u32x4 (&kr)[6], const u32x4 (&vr)[6], const UnitP& P, int wid, int lane) {
#pragma unroll
    for (int j = 0; j < 6; ++j) { const int tt0 = P.tt_first + 64 * j; if (j < P.ntile && tt0 >= 0 && tt0 < P.LF) {
        *(LAS u32x4*)(L + j * TILE_BYTES + wid * 1024 + lane * 16) = kr[j];
        *(LAS u32x4*)(L + j * TILE_BYTES + 8192 + wid * 1024 + lane * 16) = vr[j]; } }
}

__device__ __forceinline__ void attn_phase(Frame& F) {
    const int lane = F.lane, wid = F.wave, r32 = lane & 31, hi = lane >> 5;
    LAS unsigned char* L = F.lds;
    LAS float* wsf = (LAS float*)(L + WSF_OFF) + wid * 64;
    LAS h16* stg = (LAS h16*)(L + STG_OFF + wid * 4096);
    const h16* proj = (const h16*)(F.ws + WS_PROJ);
    int u = F.vcu;
    if (u >= 2048) return;
    UnitP P = decode_unit(u);
    u32x4 kr[6], vr[6];
    issue_tiles(kr, vr, P, proj, wid, lane);
    half8 qn[4];
#define ATT_QLOAD(PP) do { const int qw_ = (PP).isA ? (PP).q0 + 32 * (wid >> 2) : (PP).q0 + 32 * wid, qc_ = (PP).isA ? OFF_QA + (4 * (PP).g + (wid & 3)) * 64 : OFF_QB + (PP).h * 64; \
        const h16* qp_ = proj + (size_t)((PP).tokb + (qw_ + r32) * (PP).dil) * NIN + qc_ + hi * 8; _Pragma("unroll") for (int d0 = 0; d0 < 4; ++d0) qn[d0] = *(const half8*)(qp_ + d0 * 16); } while (0)
    ATT_QLOAD(P);
#pragma unroll 1
    for (; u < 2048; u += F.G) {
        TSEC_BEGIN(20);
        write_tiles(L, kr, vr, P, wid, lane);
        int head, tq, qcol, jb, je, qw0;
        if (P.isA) { head = 4 * P.g + (wid & 3); qw0 = P.q0 + 32 * (wid >> 2); qcol = OFF_QA + head * 64; jb = 0; je = 5; }
        else       { head = P.h; qw0 = P.q0 + 32 * wid; qcol = OFF_QB + head * 64; jb = wid >> 1; je = jb + 3; }
        tq = qw0 + r32; (void)qcol;
        half8 qr[4];
#pragma unroll
        for (int d0 = 0; d0 < 4; ++d0) qr[d0] = qn[d0];
        float m = P.isA ? F.a_sink[head] * LOG2E : 0.f, l = (P.isA && hi == 0) ? 1.0f : 0.0f;
        bool first = !P.isA;
        asm volatile("" ::: "memory");
        __syncthreads();
#pragma unroll
        for (int d0 = 0; d0 < 4; ++d0) asm volatile("" : "+v"(qr[d0]));
        TSEC_END(20);
        TSEC_BEGIN(21);
        const UnitP Pc = P;
        if (u + F.G < 2048) { P = decode_unit(u + F.G); issue_tiles(kr, vr, P, proj, wid, lane); ATT_QLOAD(P); }
        asm volatile("" ::: "memory");
        f32x16 o0, o1, negm;
#pragma unroll
        for (int r = 0; r < 16; ++r) { o0[r] = 0.f; o1[r] = 0.f; negm[r] = -m; }
        const int lo = (-Pc.hw > -tq) ? -Pc.hw : -tq, hi_ = (Pc.hw < Pc.LF - 1 - tq) ? Pc.hw : (Pc.LF - 1 - tq); const unsigned span = (unsigned)(hi_ - lo);
#pragma unroll 1
        for (int j = jb; j < je; ++j) {
            const int tt0 = Pc.tt_first + 64 * j; if (tt0 < 0 || tt0 >= Pc.LF) continue;
            int md[2];
#pragma unroll
            for (int h = 0; h < 2; ++h) { const int mn = tt0 + 32 * h - (qw0 + 31), mx = tt0 + 32 * h + 31 - qw0;
                md[h] = (mn > Pc.hw || mx < -Pc.hw) ? 0 : ((mn >= -Pc.hw && mx <= Pc.hw) ? 1 : 2); }
            if ((md[0] | md[1]) == 0) continue;
            tile_step(o0, o1, m, l, negm, first, qr, L + j * TILE_BYTES, L + j * TILE_BYTES + 8192, wsf, lane, r32, hi, md[0], md[1], tt0 + 4 * hi - tq, lo, span);
            first = false;
        }
        { auto rr = __builtin_amdgcn_permlane32_swap(__float_as_uint(l), __float_as_uint(l), false, false); l = __uint_as_float(rr[0]) + __uint_as_float(rr[1]); }
        TSEC_END(21);
        TSEC_BEGIN(22);
        if (Pc.isA) store_out(o0, o1, l, wsf, stg, (h16*)(F.ws + WS_OA) + head * 64, 512, Pc.tokb + qw0, 1, lane, r32, hi);
        else {
            if (hi == 0) ((float*)(F.ws + WS_LSE))[((size_t)Pc.p * M + Pc.tokb + tq * Pc.dil) * 8 + head] = (m + __builtin_amdgcn_logf(l)) * LN2;
            store_out(o0, o1, l, wsf, stg, (h16*)(F.ws + WS_OB) + (size_t)Pc.p * M * 512 + head * 64, 512, Pc.tokb + qw0 * Pc.dil, Pc.dil, lane, r32, hi);
        }
        __syncthreads();
        TSEC_END(22);
    }
}
}

__device__ __forceinline__ void p3_combine(Frame& F) {
    const int gw = F.vcu * NWAVES + F.wave, NGW = F.G * NWAVES, lane = F.lane;
    const h16* OA = (const h16*)(F.ws + WS_OA); const h16* OB = (const h16*)(F.ws + WS_OB); const float* LSE = (const float*)(F.ws + WS_LSE);
    h16* MX = (h16*)(F.ws + WS_MIXED);
    f32x4 ga[2], gb[2];
#pragma unroll
    for (int i = 0; i < 2; ++i) { ga[i] = *(const f32x4*)(F.g_out_a + 8 * lane + 4 * i); gb[i] = *(const f32x4*)(F.g_out_b + 8 * lane + 4 * i); }
    for (int t = gw; t < M; t += NGW) {
        const u32x4 ra = __builtin_nontemporal_load((const u32x4*)(OA + (size_t)t * 512 + 8 * lane));
        u32x4 rb[3]; float ls[3];
#pragma unroll
        for (int p = 0; p < 3; ++p) { rb[p] = __builtin_nontemporal_load((const u32x4*)(OB + ((size_t)p * M + t) * 512 + 8 * lane)); ls[p] = LSE[((size_t)p * M + t) * 8 + (lane >> 3)]; }
        float a[8], bsum[8];
#pragma unroll
        for (int i = 0; i < 4; ++i) { a[2 * i] = h2f((unsigned short)(ra[i] & 0xffffu)); a[2 * i + 1] = h2f((unsigned short)(ra[i] >> 16)); }
        const float mx = fmaxf(ls[0], fmaxf(ls[1], ls[2]));
        float w[3]; float ws_ = 0.f;
#pragma unroll
        for (int p = 0; p < 3; ++p) { w[p] = __expf(ls[p] - mx); ws_ += w[p]; }
        const float inv = 1.0f / ws_;
#pragma unroll
        for (int i = 0; i < 8; ++i) bsum[i] = 0.f;
#pragma unroll
        for (int p = 0; p < 3; ++p) { const float wp = w[p] * inv;
#pragma unroll
            for (int i = 0; i < 4; ++i) { bsum[2 * i] += wp * h2f((unsigned short)(rb[p][i] & 0xffffu)); bsum[2 * i + 1] += wp * h2f((unsigned short)(rb[p][i] >> 16)); } }
        float sa = 0.f, sb = 0.f;
#pragma unroll
        for (int i = 0; i < 8; ++i) { sa += a[i] * a[i]; sb += bsum[i] * bsum[i]; }
        const float rsa = 1.0f / sqrtf(wave_sum(sa) * (1.0f / 512.0f) + NORM_EPS), rsb = 1.0f / sqrtf(wave_sum(sb) * (1.0f / 512.0f) + NORM_EPS);
        u32x4 wa, wb;
#pragma unroll
        for (int i = 0; i < 4; ++i) { wa[i] = pk_h2(a[2 * i] * rsa * ga[i >> 1][(2 * i) & 3], a[2 * i + 1] * rsa * ga[i >> 1][(2 * i + 1) & 3]);
                                      wb[i] = pk_h2(bsum[2 * i] * rsb * gb[i >> 1][(2 * i) & 3], bsum[2 * i + 1] * rsb * gb[i >> 1][(2 * i + 1) & 3]); }
        *(u32x4*)(MX + (size_t)t * DM + 8 * lane) = wa;
        *(u32x4*)(MX + (size_t)t * DM + 512 + 8 * lane) = wb;
    }
}

__device__ __forceinline__ void p5_router(Frame& F) {
    const int gw = F.vcu * NWAVES + F.wave, NGW = F.G * NWAVES, lane = F.lane;
    LAS unsigned char* L = F.lds;
    for (int i = F.tid; i < DM * 4; i += NWAVES * 64) { const int k = i >> 2, c = i & 3; *(LAS f32x4*)(L + k * 64 + (k >> 2) * 16 + c * 16) = *(const f32x4*)(F.w_router + k * 16 + c * 4); }
    __syncthreads();
    const h16* X1 = (const h16*)(F.ws + WS_X1); unsigned char* H2 = F.ws + WS_H2; float* AFF = (float*)(F.ws + WS_AFF);
    f32x4 g[4];
#pragma unroll
    for (int j = 0; j < 4; ++j) g[j] = ((const f32x4*)F.g_ffn)[lane + 64 * j];
    u32x2 vn[4];
    if (gw < M) {
#pragma unroll
        for (int j = 0; j < 4; ++j) vn[j] = __builtin_nontemporal_load((const u32x2*)(X1 + (size_t)gw * DM) + lane + 64 * j);
    }
    LAS float* cscr = (LAS float*)(L + 69632 + F.wave * 8448);
    const float* const wg_ = F.w_gate; const float* const wu_ = F.w_up; const float* const wd_ = F.w_down; unsigned char* const ws_ = F.ws;
    const int JT = (int)((CV_TOTAL + (unsigned)NGW - 1u) / (unsigned)NGW), J1 = (F.G > BATCH * NE) ? JT - JT / 8 : JT;
    int cj = 0; bool cpendA = false, cpendB = false;
    ConvItem citA = conv8_decode(wg_, wu_, wd_, ws_, (unsigned)gw < CV_TOTAL ? (unsigned)gw : 0u), citB = citA; float cregA[32], cregB[32];
#define P5_PUMP1(PEND, ITEM, REG) do { __builtin_amdgcn_sched_barrier(0); if (PEND) conv8_finish(ITEM, REG, cscr, lane); __builtin_amdgcn_sched_barrier(0); \
        { const unsigned it_ = (unsigned)cj * (unsigned)NGW + (unsigned)gw; PEND = (cj < J1) && (it_ < CV_TOTAL); if (PEND) ITEM = conv8_decode(wg_, wu_, wd_, ws_, it_); ++cj; conv8_issue(ITEM, REG, lane); } __builtin_amdgcn_sched_barrier(0); } while (0)
#define P5_PUMP() do { if (cj & 1) P5_PUMP1(cpendB, citB, cregB); else P5_PUMP1(cpendA, citA, cregA); } while (0)
    P5_PUMP();
    P5_PUMP();
    for (int t = gw; t < M; t += NGW) {
        f32x4 v[4]; float s = 0.f;
#pragma unroll
        for (int j = 0; j < 4; ++j) { v[j].x = h2f((unsigned short)(vn[j].x & 0xffffu)); v[j].y = h2f((unsigned short)(vn[j].x >> 16)); v[j].z = h2f((unsigned short)(vn[j].y & 0xffffu)); v[j].w = h2f((unsigned short)(vn[j].y >> 16)); }
        if (t + NGW < M) {
#pragma unroll
            for (int j = 0; j < 4; ++j) vn[j] = __builtin_nontemporal_load((const u32x2*)(X1 + (size_t)(t + NGW) * DM) + lane + 64 * j);
        }
        P5_PUMP();
#pragma unroll
        for (int j = 0; j < 4; ++j) s += (v[j].x * v[j].x + v[j].y * v[j].y) + (v[j].z * v[j].z + v[j].w * v[j].w);
        const float rs = 1.0f / sqrtf(wave_sum(s) * (1.0f / DM) + NORM_EPS);
        unsigned* o4 = (unsigned*)(H2 + (size_t)t * DM) + lane;
        float acc[16];
#pragma unroll
        for (int e = 0; e < 16; ++e) acc[e] = 0.f;
#pragma unroll
        for (int j = 0; j < 4; ++j) {
            const f32x4 y = v[j] * rs * g[j];
            o4[64 * j] = pk_fp8x4(clamp8(y.x * S_H2), clamp8(y.y * S_H2), clamp8(y.z * S_H2), clamp8(y.w * S_H2));
#pragma unroll
            for (int c = 0; c < 4; ++c) {
                const int k = 256 * j + 4 * lane + c; LAS const f32x4* wr = (LAS const f32x4*)(L + k * 64 + (k >> 2) * 16);
#pragma unroll
                for (int q = 0; q < 4; ++q) { const f32x4 wv = wr[q];
#pragma unroll
                    for (int z = 0; z < 4; ++z) acc[4 * q + z] += y[c] * wv[z]; }
                if (c & 1) asm volatile("" ::: "memory");
            }
        }
        { const bool up = (lane & 32) != 0;
#pragma unroll
          for (int i = 0; i < 8; ++i) { const float send = up ? acc[i] : acc[i + 8], keep = up ? acc[i + 8] : acc[i]; acc[i] = keep + __shfl_xor(send, 32); } }
        { const bool up = (lane & 16) != 0;
#pragma unroll
          for (int i = 0; i < 4; ++i) { const float send = up ? acc[i] : acc[i + 4], keep = up ? acc[i + 4] : acc[i]; acc[i] = keep + __shfl_xor(send, 16); } }
        { const bool up = (lane & 8) != 0;
#pragma unroll
          for (int i = 0; i < 2; ++i) { const float send = up ? acc[i] : acc[i + 2], keep = up ? acc[i + 2] : acc[i]; acc[i] = keep + __shfl_xor(send, 8); } }
        float lg;
        { const bool up = (lane & 4) != 0; const float send = up ? acc[0] : acc[1], keep = up ? acc[1] : acc[0]; lg = keep + __shfl_xor(send, 4); }
        lg += __shfl_xor(lg, 2); lg += __shfl_xor(lg, 1);
        float mx = lg;
#pragma unroll
        for (int o = 4; o < 64; o <<= 1) mx = fmaxf(mx, __shfl_xor(mx, o));
        const float ex = __expf(lg - mx); float sm = ex;
#pragma unroll
        for (int o = 4; o < 64; o <<= 1) sm += __shfl_xor(sm, o);
        if ((lane & 3) == 0) { const int e = lane >> 2, b = t >> 12, sidx = t & (SEQ - 1); AFF[((size_t)(b * NE + e)) * SEQ + sidx] = ex / sm; }
        P5_PUMP();
    }
#pragma unroll 1
    while (cpendA || cpendB || cj < J1) P5_PUMP();
#undef P5_PUMP
#undef P5_PUMP1
}

__device__ __forceinline__ void p6_topk(Frame& F) {
    LAS unsigned* cnt = (LAS unsigned*)F.lds;
    const int tid = F.tid, lane = F.lane, wid = F.wave;
    const float* AFF = (const float*)(F.ws + WS_AFF);
    int* TOK = (int*)(F.ws + WS_TOK); float* GATE = (float*)(F.ws + WS_GATE); int* SLOT = (int*)(F.ws + WS_SLOT);
    for (int pair = F.vcu; pair < BATCH * NE; pair += F.G) {
        const int b = pair >> 4, e = pair & 15;
        const float* a = AFF + (size_t)pair * SEQ + 8 * tid;
        const f32x4 a0 = *(const f32x4*)a, a1 = *(const f32x4*)(a + 4);
        unsigned key[8];
#pragma unroll
        for (int j = 0; j < 4; ++j) { key[j] = __float_as_uint(a0[j]); key[4 + j] = __float_as_uint(a1[j]); }
        unsigned prefix = 0u;
        __syncthreads();
#pragma unroll 1
        for (int sft = 28; sft >= 0; sft -= 2) {
            const unsigned c1 = prefix | (1u << sft), c2 = prefix | (2u << sft), c3 = prefix | (3u << sft);
            unsigned n1 = 0, n2 = 0, n3 = 0;
#pragma unroll
            for (int j = 0; j < 8; ++j) { n1 += (unsigned)__popcll(__ballot(key[j] >= c1)); n2 += (unsigned)__popcll(__ballot(key[j] >= c2)); n3 += (unsigned)__popcll(__ballot(key[j] >= c3)); }
            LAS unsigned* cc = cnt + ((sft & 2) ? 24 : 0);
            if (lane == 0) { cc[wid] = n1; cc[8 + wid] = n2; cc[16 + wid] = n3; }
            __syncthreads();
            unsigned t1 = 0, t2 = 0, t3 = 0;
#pragma unroll
            for (int w = 0; w < 8; ++w) { t1 += cc[w]; t2 += cc[8 + w]; t3 += cc[16 + w]; }
            prefix = (t3 >= (unsigned)CAP) ? c3 : ((t2 >= (unsigned)CAP) ? c2 : ((t1 >= (unsigned)CAP) ? c1 : prefix));
        }
        unsigned cg = 0, ce = 0;
#pragma unroll
        for (int j = 0; j < 8; ++j) { cg += key[j] > prefix; ce += key[j] == prefix; }
        unsigned pk = (ce << 16) | cg, inc = pk;
#pragma unroll
        for (int o = 1; o < 64; o <<= 1) { const unsigned n = __shfl_up(inc, o); if (lane >= o) inc += n; }
        __syncthreads();
        LAS unsigned* ws_ = cnt + 48;
        if (lane == 63) ws_[wid] = inc;
        __syncthreads();
        unsigned base = 0, total = 0;
#pragma unroll
        for (int w = 0; w < 8; ++w) { const unsigned x = ws_[w]; if (w < wid) base += x; total += x; }
        const unsigned exc = base + inc - pk;
        unsigned gtb = exc & 0xffffu, eqb = exc >> 16;
        const unsigned need = (unsigned)CAP - (total & 0xffffu);
#pragma unroll
        for (int j = 0; j < 8; ++j) {
            const int sidx = 8 * tid + j; int slot = -1;
            if (key[j] > prefix) { slot = (int)(gtb + (eqb < need ? eqb : need)); ++gtb; }
            else if (key[j] == prefix) { if (eqb < need) slot = (int)(gtb + eqb); ++eqb; }
            SLOT[((size_t)(b * SEQ + sidx)) * NE + e] = slot;
            if (slot >= 0) { TOK[e * EROWS + b * CAP + slot] = b * SEQ + sidx; GATE[e * EROWS + b * CAP + slot] = __uint_as_float(key[j]); }
        }
        __syncthreads();
    }
}

__device__ __forceinline__ void p9_final(Frame& F) {
    const int gw = F.vcu * NWAVES + F.wave, NGW = F.G * NWAVES, lane = F.lane;
    const int* SLOT = (const int*)(F.ws + WS_SLOT); const unsigned char* YE = F.ws + WS_YE;
    f32x4 g[4];
#pragma unroll
    for (int j = 0; j < 4; ++j) g[j] = ((const f32x4*)F.g_final)[lane + 64 * j];
    int myslot = (gw < M) ? SLOT[(size_t)gw * NE + (lane & 15)] : -1;
    for (int t = gw; t < M; t += NGW) {
        f32x4* xr = (f32x4*)(F.out + (size_t)t * DM) + lane;
        const u32x2* xi = (const u32x2*)((const h16*)(F.ws + WS_X1) + (size_t)t * DM) + lane;
        f32x4 v[4];
#pragma unroll
        for (int j = 0; j < 4; ++j) { const u32x2 w = __builtin_nontemporal_load(xi + 64 * j); v[j].x = h2f((unsigned short)(w.x & 0xffffu)); v[j].y = h2f((unsigned short)(w.x >> 16)); v[j].z = h2f((unsigned short)(w.y & 0xffffu)); v[j].w = h2f((unsigned short)(w.y >> 16)); }
        const int slot_cur = myslot;
        const int tn = t + NGW;
        myslot = (tn < M) ? SLOT[(size_t)tn * NE + (lane & 15)] : -1;
        unsigned mask = (unsigned)(__ballot(slot_cur >= 0) & 0xffffull);
        const size_t ebase = (size_t)(t >> 12) * CAP;
        while (mask) {
            int e[4]; float w[4];
#pragma unroll
            for (int q = 0; q < 4; ++q) { const bool has = mask != 0u; e[q] = has ? (int)__builtin_ctz(mask) : e[0]; w[q] = has ? 1.f : 0.f; mask = has ? (mask & (mask - 1u)) : 0u; }
            unsigned y[4][4];
#pragma unroll
            for (int q = 0; q < 4; ++q) { const int sl = __builtin_amdgcn_readlane(slot_cur, e[q]);
                const unsigned* yr = (const unsigned*)(YE + ((size_t)e[q] * EROWS + ebase + sl) * DM) + lane;
#pragma unroll
                for (int j = 0; j < 4; ++j) y[q][j] = __builtin_nontemporal_load(yr + 64 * j); }
#pragma unroll
            for (int q = 0; q < 4; ++q) { const float wq = w[q] * (1.0f / S_YE);
#pragma unroll
                for (int j = 0; j < 4; ++j) { const auto lo2 = __builtin_amdgcn_cvt_pk_f32_fp8((int)y[q][j], false), hi2 = __builtin_amdgcn_cvt_pk_f32_fp8((int)y[q][j], true);
                    v[j].x += wq * lo2[0]; v[j].y += wq * lo2[1]; v[j].z += wq * hi2[0]; v[j].w += wq * hi2[1]; } }
        }
        float s = 0.f;
#pragma unroll
        for (int j = 0; j < 4; ++j) s += (v[j].x * v[j].x + v[j].y * v[j].y) + (v[j].z * v[j].z + v[j].w * v[j].w);
        const float rs = 1.0f / sqrtf(wave_sum(s) * (1.0f / DM) + NORM_EPS);
#pragma unroll
        for (int j = 0; j < 4; ++j) __builtin_nontemporal_store(v[j] * rs * g[j], xr + 64 * j);
    }
}

constexpr int NPHASE = 10;
struct Args { const float* in[13]; float* out; unsigned char* ws; int ph_lo, ph_hi, li, pad; };

__global__ void __launch_bounds__(NWAVES * 64, 2) mk_fwd(Args args) {
    extern __shared__ __attribute__((aligned(16))) unsigned char lds[];
    Frame F;
    F.lds = (LAS unsigned char*)lds;
    F.tid = threadIdx.x; F.lane = F.tid & 63; F.wave = __builtin_amdgcn_readfirstlane(F.tid >> 6);
    F.G = gridDim.x; { const int bx = blockIdx.x; F.vcu = (F.G % 8 == 0) ? (bx % 8) * (F.G / 8) + bx / 8 : bx; }
    F.x = args.in[0]; F.g_mix = args.in[1]; F.w_in = args.in[2]; F.a_sink = args.in[3]; F.g_out_a = args.in[4]; F.g_out_b = args.in[5]; F.w_out = args.in[6];
    F.g_ffn = args.in[7]; F.w_router = args.in[8]; F.w_gate = args.in[9]; F.w_up = args.in[10]; F.w_down = args.in[11]; F.g_final = args.in[12];
    F.out = args.out; F.ws = args.ws; F.tacc = 0;
    volatile LAS unsigned* MISC = (volatile LAS unsigned*)(F.lds + MISC_OFF);
    for (int u = F.tid; u < (LDS_BYTES - LDSCTL_OFF) / 4; u += NWAVES * 64) ((LAS unsigned*)(F.lds + LDSCTL_OFF))[u] = 0u;
    __syncthreads();
    const int lo = args.ph_lo, hi = args.ph_hi;
    const bool multi = (hi - lo) > 1;
    unsigned* barw = (unsigned*)(F.ws + WS_CTL) + CW_BAR + args.li * XCD_BAR_WORDS;
    XcdBarrier bar; bar.bar = barw; bar.x = 0; bar.st = nullptr;
    if (multi) bar = xcd_barrier_post(barw, MISC + 8);
#define IN(k) (((PH_MASK >> (k)) & 1) && lo <= (k) && (k) < hi)
#define SEAM(k) do { if (IN(k) && IN((k) + 1)) xcd_barrier(bar); } while (0)
#define TS0(k) do { if (TIME_PHASE == (k)) ts0_ = __builtin_amdgcn_s_memrealtime(); } while (0)
#define TS1(k) do { if (TIME_PHASE == (k)) ts1_ = __builtin_amdgcn_s_memrealtime(); } while (0)
    unsigned long long ts0_ = 0, ts1_ = 0;
#define REPS(k) for (int rep_ = 0; rep_ < 1 + ((REP_MASK >> (k)) & 1); ++rep_)

    TS0(0);
    if (IN(0)) REPS(0) { p0_prologue(F); SEAM(0); }
    TS1(0);
    TS0(1);
    if (IN(1)) {
        pg8::DenseProb P{(const char*)(F.ws + WS_H), (const char*)(F.ws + WS_WIN), DM * 2};
        pg8::DenseOrder S; S.init(M, NIN - pg8::BM, F.G, (int)blockIdx.x, 1 + ((REP_MASK >> 1) & 1));
        pg8::EpiInProj E{(h16*)(F.ws + WS_PROJ), (const float*)(F.ws + WS_ROPE)};
        pg8::gemm_phase<pg8::DenseProb, pg8::EpiInProj, pg8::DenseOrder, true>(F.lds, P, S, E);
        for (int u = F.vcu; u < (M / pg8::BM) * 4; u += F.G) pg8::tail_quarter(F.lds, P.A, P.Bt, E.O, u);
        SEAM(1);
    }
    TS1(1);
    TS0(2);
    if (IN(2)) REPS(2) { att::attn_phase(F); SEAM(2); }
    TS1(2);
    TS0(3);
    if (IN(3)) REPS(3) { p3_combine(F); SEAM(3); }
    TS1(3);
    TS0(4);
    if (IN(4)) {
        pg8::DenseProb P{(const char*)(F.ws + WS_MIXED), (const char*)(F.ws + WS_WOUT), DM * 2};
        pg8::DenseOrder S; S.init(M, DM, F.G, (int)blockIdx.x, 1 + ((REP_MASK >> 4) & 1));
        pg8::EpiResidual E{F.x, (h16*)(F.ws + WS_X1)};
        pg8::gemm_phase<pg8::DenseProb, pg8::EpiResidual, pg8::DenseOrder, true>(F.lds, P, S, E);
        SEAM(4);
    }
    TS1(4);
    TS0(5);
    if (IN(5)) REPS(5) { p5_router(F); SEAM(5); }
    TS1(5);
    TS0(6);
    if (IN(6)) REPS(6) {
        p6_topk(F);
        if (F.G > BATCH * NE && F.vcu >= BATCH * NE) {
            const int NGW_ = F.G * NWAVES, JT = (int)((CV_TOTAL + (unsigned)NGW_ - 1u) / (unsigned)NGW_), J1 = JT - JT / 8;
            const unsigned R0 = (unsigned)J1 * (unsigned)NGW_, NCW = (unsigned)(F.G - BATCH * NE) * NWAVES;
            for (unsigned it = R0 + (unsigned)(F.vcu - BATCH * NE) * NWAVES + (unsigned)F.wave; it < CV_TOTAL; it += NCW) conv8_one(F.w_gate, F.w_up, F.w_down, F.ws, it, (LAS float*)(F.lds + F.wave * 16384), F.lane);
        }
        SEAM(6); }
    TS1(6);
    TS0(7);
    if (IN(7)) {
        pg8::Moe1Prob P{(const char*)(F.ws + WS_H2), (const char*)(F.ws + WS_WGU), DM, (const int*)(F.ws + WS_TOK)};
        pg8::GroupOrder S; S.init(EROWS / 256, 4096 / 256, NE, F.G, F.vcu, 1 + ((REP_MASK >> 7) & 1));
        pg8::EpiSwiGLU E{F.ws + WS_HMID};
        pg8::gemm_phase<pg8::Moe1Prob, pg8::EpiSwiGLU, pg8::GroupOrder, true>(F.lds, P, S, E);
        SEAM(7);
    }
    TS1(7);
    TS0(8);
    if (IN(8)) {
        pg8::Moe2Prob P{(const char*)(F.ws + WS_HMID), (const char*)(F.ws + WS_WD), FF};
        pg8::GroupOrder S; S.init(EROWS / 256, DM / 256, NE, F.G, F.vcu, 1 + ((REP_MASK >> 8) & 1));
        pg8::EpiDown E{F.ws + WS_YE, (const float*)(F.ws + WS_GATE)};
        pg8::gemm_phase<pg8::Moe2Prob, pg8::EpiDown, pg8::GroupOrder, true>(F.lds, P, S, E);
        SEAM(8);
    }
    TS1(8);
    TS0(9);
    if (IN(9)) REPS(9) { p9_final(F); if (rep_ == 0 && ((REP_MASK >> 9) & 1)) xcd_barrier(bar); }
    TS1(9);
    if (TIME_PHASE >= 0 && blockIdx.x == 0 && F.tid == 0) { asm volatile("s_waitcnt vmcnt(0)" ::: "memory"); F.out[0] += (float)(TIME_PHASE >= 20 ? F.tacc : (ts1_ - ts0_)) * 0.01f * TIME_SCALE; }
#undef IN
#undef SEAM
}

extern "C" void kernel_launch(void* const* d_in, const int* in_sizes, int n_in, void* d_out, int out_size, void* d_ws, size_t ws_size, hipStream_t stream) {
    static int grid = 0;
    if (grid == 0) {
        if (n_in != 13 || in_sizes[0] != M * DM || out_size != M * DM || ws_size < WS_END) { fprintf(stderr, "kernel_launch: unexpected problem (n_in %d, ws %zu)\n", n_in, ws_size); grid = -1; return; }
        int dev = 0, cus = 0, per_cu = 0;
        if (hipGetDevice(&dev) != hipSuccess || hipDeviceGetAttribute(&cus, hipDeviceAttributeMultiprocessorCount, dev) != hipSuccess) { grid = -1; return; }
        if (hipFuncSetAttribute((const void*)mk_fwd, hipFuncAttributeMaxDynamicSharedMemorySize, LDS_BYTES) != hipSuccess) { fprintf(stderr, "kernel_launch: hipFuncSetAttribute failed\n"); grid = -1; return; }
        if (hipOccupancyMaxActiveBlocksPerMultiprocessor(&per_cu, (const void*)mk_fwd, NWAVES * 64, LDS_BYTES) != hipSuccess || per_cu < 1)
            fprintf(stderr, "kernel_launch: occupancy query reports %d blocks per CU\n", per_cu);
        (void)hipGetLastError();
        grid = cus;
    }
    if (grid < 0) return;
    (void)hipMemsetAsync((char*)d_ws + WS_CTL, 0, CTL_ZERO_BYTES, stream);
    Args a{};
    for (int i = 0; i < 13; ++i) a.in[i] = (const float*)d_in[i];
    a.out = (float*)d_out; a.ws = (unsigned char*)d_ws;
    if (MK_N_LAUNCHES == 1) {
        for (int pass = 0; pass < REP_ALL; ++pass) { a.ph_lo = 0; a.ph_hi = NPHASE; a.li = pass;
        hipLaunchKernelGGL(mk_fwd, dim3(grid), dim3(NWAVES * 64), LDS_BYTES, stream, a); }
    } else {
        for (int li = 0; li < NPHASE; ++li) { a.ph_lo = li; a.ph_hi = li + 1; a.li = 0;
            hipLaunchKernelGGL(mk_fwd, dim3(grid), dim3(NWAVES * 64), LDS_BYTES, stream, a); }
    }
}
```

```cpp
#include <hip/hip_runtime.h>
#include <cstdio>
#include <cstdint>

#ifndef MK_N_LAUNCHES
#define MK_N_LAUNCHES 1
#endif
#ifndef TIME_PHASE
#define TIME_PHASE -1
#endif
#ifndef TIME_SCALE
#define TIME_SCALE 1.0f
#endif
#ifndef PH_MASK
#define PH_MASK 0x3ff
#endif
#ifndef REP_ALL
#define REP_ALL 1
#endif
#ifndef REP_MASK
#define REP_MASK 0
#endif

#define LAS __attribute__((address_space(3)))
#define GAS __attribute__((address_space(1)))
typedef unsigned short h16;
typedef _Float16 half8 __attribute__((ext_vector_type(8)));
typedef _Float16 half2v __attribute__((ext_vector_type(2)));
typedef short s16x4 __attribute__((ext_vector_type(4)));
typedef float f32x4 __attribute__((ext_vector_type(4)));
typedef float f32x16 __attribute__((ext_vector_type(16)));
typedef unsigned u32x2 __attribute__((ext_vector_type(2)));
typedef unsigned u32x4 __attribute__((ext_vector_type(4)));
typedef GAS unsigned gu32;

constexpr int BATCH = 4, SEQ = 4096, DM = 1024, M = BATCH * SEQ;
constexpr int NIN = 2304;
constexpr int OFF_QA = 0, OFF_KA = 512, OFF_VA = 640, OFF_QB = 768, OFF_KB = 1280, OFF_VB = 1792;
constexpr int NE = 16, CAP = 512, FF = 2048, EROWS = BATCH * CAP;
constexpr float NORM_EPS = 1e-6f;
constexpr float LOG2E = 1.4426950408889634f, LN2 = 0.6931471805599453f;
constexpr float QSCALE = 0.18033688011112042f;
constexpr float S_H2 = 4.f, S_W = 32.f, S_HM = 2.f, S_YE = 16.f;

constexpr size_t MiB = 1u << 20;
constexpr size_t WS_CTL = 0, CTL_ZERO_BYTES = 128 * 1024;
constexpr size_t WS_ROPE = 1 * MiB;
constexpr size_t WS_AFF = 2 * MiB;
constexpr size_t WS_TOK = 3 * MiB;
constexpr size_t WS_GATE = 3 * MiB + 256 * 1024;
constexpr size_t WS_SLOT = 4 * MiB;
constexpr size_t WS_LSE = 5 * MiB;
constexpr size_t WS_RS = 7 * MiB;
constexpr size_t WS_WIN = 8 * MiB;
constexpr size_t WS_WOUT = 13 * MiB;
constexpr size_t WS_WGU = 16 * MiB;
constexpr size_t WS_WD = 144 * MiB;
constexpr size_t WS_H = 208 * MiB;
constexpr size_t WS_PROJ = 240 * MiB;
constexpr size_t WS_OA = 312 * MiB;
constexpr size_t WS_OB = 328 * MiB;
constexpr size_t WS_HMID = 208 * MiB;
constexpr size_t WS_MIXED = 376 * MiB;
constexpr size_t WS_H2 = 408 * MiB;
constexpr size_t WS_YE = 376 * MiB;
constexpr size_t WS_X1 = 440 * MiB;
constexpr size_t WS_END = 504 * MiB;
constexpr int CW_CONV = 64, CW_P1DONE = 128;
constexpr int CW_ARR_X = 8192, CW_ARR_TOP = 8192 + 64 * 16;
constexpr int CW_ARR2_X = 10240, CW_ARR2_TOP = 10240 + 64 * 16;
constexpr int CW_SEAM = 12288;
constexpr int CW_BAR = 1024;

constexpr int RING_BYTES = 131072;
constexpr int LDSCTL_OFF = 143360, MISC_OFF = LDSCTL_OFF + 320;
constexpr int LDS_BYTES = 147456;
constexpr int NWAVES = 8;

#define RLX_AGENT __ATOMIC_RELAXED, __HIP_MEMORY_SCOPE_AGENT
#define LDS_WAIT() asm volatile("s_waitcnt lgkmcnt(0)" ::: "memory")
#define VM_WAIT() asm volatile("s_waitcnt vmcnt(0)" ::: "memory")

__device__ __forceinline__ unsigned pk_h2(float lo, float hi) { half2v v = {(_Float16)lo, (_Float16)hi}; return __builtin_bit_cast(unsigned, v); }
__device__ __forceinline__ unsigned pk_h2_rtz(float lo, float hi) { return __builtin_bit_cast(unsigned, __builtin_amdgcn_cvt_pkrtz(lo, hi)); }
__device__ __forceinline__ unsigned pk_fp8x4(float a, float b, float c, float d) {
    int w = __builtin_amdgcn_cvt_pk_fp8_f32(a, b, 0, false); w = __builtin_amdgcn_cvt_pk_fp8_f32(c, d, w, true); return (unsigned)w; }
__device__ __forceinline__ float clamp8(float x) { return __builtin_amdgcn_fmed3f(x, -448.f, 448.f); }
__device__ __forceinline__ float h2f(unsigned short b) { return (float)__builtin_bit_cast(_Float16, b); }
__device__ __forceinline__ float wave_sum(float v) {
#pragma unroll
    for (int o = 1; o < 64; o <<= 1) v += __shfl_xor(v, o);
    return v;
}


constexpr unsigned CV_PER = (DM / 64) * (FF / 32);
constexpr unsigned CV_TOTAL = (unsigned)NE * 3u * CV_PER;
struct ConvItem { const float* W; unsigned char* D; int N, K; };
__device__ __forceinline__ ConvItem conv8_decode(const float* wg, const float* wu, const float* wd, unsigned char* ws, unsigned it) {
    ConvItem c;
    if (it < (unsigned)NE * 2u * CV_PER) {
        const unsigned e = it / (2u * CV_PER); unsigned r = it - e * 2u * CV_PER; const unsigned which = r / CV_PER; r -= which * CV_PER;
        const int kb = (int)(r / (FF / 128)), nb = (int)(r % (FF / 128));
        c.N = FF; c.K = DM; c.W = (which ? wu : wg) + (size_t)e * DM * FF + (size_t)(16 * kb) * FF + 128 * nb;
        c.D = ws + WS_WGU + (size_t)e * 4096 * DM + ((size_t)kb * 4096 + (size_t)(nb * 256 + (int)which * 128)) * 16;
    } else {
        const unsigned r0 = it - (unsigned)NE * 2u * CV_PER, e = r0 / CV_PER, r = r0 - e * CV_PER;
        const int kb = (int)(r / (DM / 128)), nb = (int)(r % (DM / 128));
        c.N = DM; c.K = FF; c.W = wd + (size_t)e * FF * DM + (size_t)(16 * kb) * DM + 128 * nb;
        c.D = ws + WS_WD + (size_t)e * DM * FF + ((size_t)kb * DM + (size_t)(128 * nb)) * 16;
    }
    return c;
}
constexpr int CV_SCR_BYTES = 64 * 36 * 4;
__device__ __forceinline__ void conv8_issue(const ConvItem& c, f32x4 (&r)[8], int lane) {
#pragma unroll
    for (int i = 0; i < 8; ++i) r[i] = __builtin_nontemporal_load((const f32x4*)(c.W + (size_t)(2 * i + (lane >> 5)) * c.N) + (lane & 31));
}
__device__ __forceinline__ void conv8_finish(const ConvItem& c, const f32x4 (&r)[8], LAS float* scr, int lane) {
#pragma unroll
    for (int i = 0; i < 8; ++i) *(LAS f32x4*)(scr + (2 * i + (lane >> 5)) * 132 + 4 * (lane & 31)) = r[i];
    LDS_WAIT(); asm volatile("" ::: "memory");
#pragma unroll
    for (int h = 0; h < 2; ++h) { const LAS float* s = scr + lane + 64 * h;
        u32x4 o;
#pragma unroll
        for (int q = 0; q < 4; ++q) o[q] = pk_fp8x4(s[(4 * q) * 132] * S_W, s[(4 * q + 1) * 132] * S_W, s[(4 * q + 2) * 132] * S_W, s[(4 * q + 3) * 132] * S_W);
        *(GAS u32x4*)(c.D + (size_t)(lane + 64 * h) * 16) = o; }
    LDS_WAIT(); asm volatile("" ::: "memory");
}
__device__ __forceinline__ void conv8_wg_issue(const float* W0, int N, f32x4 (&r)[8], int wave, int lane) {
#pragma unroll
    for (int i = 0; i < 8; ++i) r[i] = __builtin_nontemporal_load((const f32x4*)(W0 + (size_t)(8 * wave + i) * N) + lane);
}
__device__ __forceinline__ void conv8_wg_finish(unsigned char* D, int K, const f32x4 (&r)[8], LAS float* tile, int wave, int lane) {
    __syncthreads();
#pragma unroll
    for (int i = 0; i < 8; ++i) *(LAS f32x4*)(tile + (8 * wave + i) * 256 + 4 * lane) = r[i];
    __syncthreads();
    const int nl = lane & 31, kh = (lane >> 5) * 32; const LAS float* s = tile + kh * 256 + 32 * wave + nl;
    u32x4 o0, o1;
#pragma unroll
    for (int q = 0; q < 4; ++q) {
        o0[q] = pk_fp8x4(s[(4 * q) * 256] * S_W, s[(4 * q + 1) * 256] * S_W, s[(4 * q + 2) * 256] * S_W, s[(4 * q + 3) * 256] * S_W);
        o1[q] = pk_fp8x4(s[(16 + 4 * q) * 256] * S_W, s[(17 + 4 * q) * 256] * S_W, s[(18 + 4 * q) * 256] * S_W, s[(19 + 4 * q) * 256] * S_W); }
    unsigned char* d = D + (size_t)nl * K + kh;
    *(GAS u32x4*)d = o0; *(GAS u32x4*)(d + 16) = o1;
}
struct NoSide { static constexpr bool ON = false; };

namespace pg8 {
constexpr int BM = 256, BK = 64, HALF = 128, HTB = HALF * BK * 2, STAGE_BYTES = 8 * HTB, NXCD = 8, WGM = 8;
__host__ __device__ __forceinline__ int lds_byte(int r, int c) { const int st = (r >> 4) * 2 + (c >> 5), rr = r & 15, cc = c & 31, ob = rr * 64 + cc * 2; return st * 1024 + (ob ^ (((ob >> 9) & 1) << 5)); }
__host__ __device__ __forceinline__ void stage_rc(int b, int& R, int& C) { const int st = b / 1024, sb = b % 1024, swz = sb ^ (((sb >> 9) & 1) << 5); R = (st >> 1) * 16 + swz / 64; C = (st & 1) * 32 + (swz % 64) / 2; }
__host__ __device__ __forceinline__ int perm32(int rho) { const int n = rho >> 4, i = rho & 15; return 8 * (i >> 2) + 4 * n + (i & 3); }

struct Unit { int pm, pn, g; };

struct DenseOrder {
    int nM, nN, nwg, G, c, reps;
    __device__ void init(int M_, int N_, int G_, int c_, int reps_ = 1) { nM = M_ / BM; nN = N_ / BM; nwg = nM * nN; G = G_; c = c_; reps = reps_; }
    __device__ bool next(int i, Unit& u) const {
        const int mine = (nwg - c + G - 1) / G; if (mine <= 0 || i >= mine * reps) return false; i %= mine;
        const long L = (long)i * G + c;
        int wgid = (int)L; { const int q = nwg / NXCD, r = nwg % NXCD, xcd = wgid % NXCD, off = wgid / NXCD; wgid = (xcd < r ? xcd * (q + 1) : r * (q + 1) + (xcd - r) * q) + off; }
        const int nig = WGM * nN, gid = wgid / nig, fm = gid * WGM, gsz = (nM - fm) < WGM ? (nM - fm) : WGM;
        u.pm = fm + ((wgid % nig) % gsz); u.pn = (wgid % nig) / gsz; u.g = 0; return true;
    }
};
struct GroupOrder {
    int nPM, nPN, total, G, c, reps;
    __device__ void init(int nPM_, int nPN_, int groups, int G_, int c_, int reps_ = 1) { nPM = nPM_; nPN = nPN_; total = nPM_ * nPN_ * groups; G = G_; c = c_; reps = reps_; }
    __device__ bool next(int i, Unit& u) const {
        const int mine = (total - c + G - 1) / G; if (mine <= 0 || i >= mine * reps) return false; i %= mine;
        const int L = i * G + c;
        const int per = nPM * nPN; u.g = L / per; const int rem = L % per; u.pn = rem / nPM; u.pm = rem % nPM; return true;
    }
};

struct DenseProb {
    static constexpr bool BKN = false, FP8 = false;
    const char* A; const char* Bt; int KB;
    __device__ __forceinline__ unsigned a_row(const Unit& u, int r) const { return (unsigned)(u.pm * BM + r); }
    __device__ __forceinline__ const char* b_base(const Unit& u, int half) const { return Bt + ((size_t)u.pn * BM + (size_t)half * HALF) * KB; }
    __device__ __forceinline__ unsigned b_voff(int Rb, int Cb) const { return (unsigned)(Rb * KB) + (unsigned)Cb; }
    __device__ __forceinline__ size_t b_kstep() const { return (size_t)BK * 2; }
    __device__ __forceinline__ unsigned b_pitch() const { return (unsigned)KB; }
};
struct Moe1Prob {
    static constexpr bool BKN = false, FP8 = true;
    const char* A; const char* Bt; int KB; const int* tok;
    __device__ __forceinline__ unsigned a_row(const Unit& u, int r) const { return (unsigned)tok[u.g * EROWS + u.pm * BM + r]; }
    __device__ __forceinline__ const char* b_base(const Unit& u, int half) const { return Bt + (size_t)u.g * 4096 * KB + ((size_t)u.pn * BM + (size_t)half * HALF) * 16; }
    __device__ __forceinline__ unsigned b_voff(int Rb, int Cb) const { return ((unsigned)(Cb >> 4) * 4096u + (unsigned)Rb) * 16u; }
    __device__ __forceinline__ size_t b_kstep() const { return (size_t)8 * 4096 * 16; }
    __device__ __forceinline__ unsigned b_pitch() const { return (unsigned)KB; }
};
struct Moe2Prob {
    static constexpr bool BKN = false, FP8 = true;
    const char* A; const char* Bt; int KB;
    __device__ __forceinline__ unsigned a_row(const Unit& u, int r) const { return (unsigned)(u.g * EROWS + u.pm * BM + r); }
    __device__ __forceinline__ const char* b_base(const Unit& u, int half) const { return Bt + (size_t)u.g * DM * KB + ((size_t)u.pn * BM + (size_t)half * HALF) * 16; }
    __device__ __forceinline__ unsigned b_voff(int Rb, int Cb) const { return ((unsigned)(Cb >> 4) * (unsigned)DM + (unsigned)Rb) * 16u; }
    __device__ __forceinline__ size_t b_kstep() const { return (size_t)8 * DM * 16; }
    __device__ __forceinline__ unsigned b_pitch() const { return (unsigned)KB; }
};

struct EpiInProj {
    static constexpr bool PERM = true;
    h16* O; const float* rope; const float* rs;
    __device__ __forceinline__ void operator()(const f32x4 (&acc)[2][2][4][2], const Unit& u, int wr, int wc, int fr, int fq) const {
        const int row0 = u.pm * BM + wr * 64 + fr;
        const int ct0 = u.pn * BM;
        const bool rt0 = (ct0 < OFF_VA) || (ct0 >= OFF_QB && ct0 < OFF_VB), rt1 = (ct0 + HALF < OFF_VA) || (ct0 + HALF >= OFF_QB && ct0 + HALF < OFF_VB);
        const bool any_rope = (rt0 || rt1) && ((wc & 1) == 0);
        float c[8], s[8];
        if (any_rope) { const float* rp = rope + (size_t)(row0 & (SEQ - 1)) * 16;
            const f32x4 c0 = *(const f32x4*)(rp), c1 = *(const f32x4*)(rp + 4), s0 = *(const f32x4*)(rp + 8), s1 = *(const f32x4*)(rp + 12);
#pragma unroll
            for (int j = 0; j < 4; ++j) { c[j] = c0[j]; c[4 + j] = c1[j]; s[j] = s0[j]; s[4 + j] = s1[j]; } }
        else {
#pragma unroll
            for (int j = 0; j < 8; ++j) { c[j] = 1.f; s[j] = 0.f; } }
        const float cd16[8] = {-9.576594803e-01f, -9.992462593e-01f, 8.243765146e-01f, 9.932003012e-01f, 9.997440109e-01f, 9.999903729e-01f, 9.999996380e-01f, 9.999999864e-01f};
        const float sd16[8] = {-2.879033167e-01f, 3.881898152e-02f, 5.660418378e-01f, 1.164180468e-01f, 2.262548617e-02f, 4.387956730e-03f, 8.509272408e-04f, 1.650141653e-04f};
        const float cd80[8] = {-1.103872438e-01f, -9.812132344e-01f, -9.911539132e-01f, 8.345872775e-01f, 9.936068238e-01f, 9.997593311e-01f, 9.999909490e-01f, 9.999996596e-01f};
        const float sd80[8] = {-9.938886539e-01f, 1.929263812e-01f, 1.327174458e-01f, 5.508757358e-01f, 1.128958803e-01f, 2.193809395e-02f, 4.254623881e-03f, 8.250707366e-04f};
        const float sg = (fq == 0) ? -1.f : 1.f;
        float rsv[2][4];
#pragma unroll
        for (int ai = 0; ai < 2; ++ai)
#pragma unroll
            for (int m = 0; m < 4; ++m) rsv[ai][m] = rs[row0 + ai * HALF + m * 16];
#pragma unroll
        for (int ai = 0; ai < 2; ++ai)
#pragma unroll
            for (int m = 0; m < 4; ++m) {
                const int row = row0 + ai * HALF + m * 16;
                if (any_rope && (ai | m) != 0) {
#pragma unroll
                    for (int j = 0; j < 8; ++j) { const float cdv = (m == 0) ? cd80[j] : cd16[j], sdv = (m == 0) ? sd80[j] : sd16[j];
                        const float cn = c[j] * cdv - s[j] * sdv, sn = s[j] * cdv + c[j] * sdv; c[j] = cn; s[j] = sn; }
                }
#pragma unroll
                for (int bj = 0; bj < 2; ++bj) {
                    const bool do_rope = (bj ? rt1 : rt0) && ((wc & 1) == 0);
                    const int col0 = ct0 + bj * HALF + wc * 32 + 8 * fq;
                    f32x4 v0 = acc[ai][bj][m][0] * rsv[ai][m], v1 = acc[ai][bj][m][1] * rsv[ai][m];
                    if (do_rope) {
                        f32x4 p0, p1;
#pragma unroll
                        for (int j = 0; j < 4; ++j) { p0[j] = __shfl_xor(v0[j], 16); p1[j] = __shfl_xor(v1[j], 16); }
                        if (fq < 2) {
#pragma unroll
                            for (int j = 0; j < 4; ++j) { v0[j] = v0[j] * c[j] + (p0[j] * s[j]) * sg; v1[j] = v1[j] * c[4 + j] + (p1[j] * s[4 + j]) * sg; } }
                    }
                    u32x4 w; w.x = pk_h2(v0[0], v0[1]); w.y = pk_h2(v0[2], v0[3]); w.z = pk_h2(v1[0], v1[1]); w.w = pk_h2(v1[2], v1[3]);
                    *(u32x4*)(O + (size_t)row * NIN + col0) = w;
                }
            }
    }
};
struct EpiResidual {
    static constexpr bool PERM = true;
    const h16* base; h16* out;
    __device__ __forceinline__ void operator()(const f32x4 (&acc)[2][2][4][2], const Unit& u, int wr, int wc, int fr, int fq) const {
        const int row0 = u.pm * BM + wr * 64 + fr, col0 = u.pn * BM + wc * 32 + 8 * fq;
        u32x4 xb[2][4][2];
#pragma unroll
        for (int ai = 0; ai < 2; ++ai)
#pragma unroll
            for (int m = 0; m < 4; ++m) { const size_t off = (size_t)(row0 + ai * HALF + m * 16) * DM + col0;
#pragma unroll
                for (int bj = 0; bj < 2; ++bj) xb[ai][m][bj] = __builtin_nontemporal_load((const u32x4*)(base + off + bj * HALF)); }
#pragma unroll
        for (int ai = 0; ai < 2; ++ai)
#pragma unroll
            for (int m = 0; m < 4; ++m) { const size_t off = (size_t)(row0 + ai * HALF + m * 16) * DM + col0;
#pragma unroll
                for (int bj = 0; bj < 2; ++bj) { const u32x4 x = xb[ai][m][bj]; const f32x4 a0 = acc[ai][bj][m][0], a1 = acc[ai][bj][m][1];
                    u32x4 w;
                    w.x = pk_h2(a0[0] + h2f((unsigned short)(x.x & 0xffffu)), a0[1] + h2f((unsigned short)(x.x >> 16)));
                    w.y = pk_h2(a0[2] + h2f((unsigned short)(x.y & 0xffffu)), a0[3] + h2f((unsigned short)(x.y >> 16)));
                    w.z = pk_h2(a1[0] + h2f((unsigned short)(x.z & 0xffffu)), a1[1] + h2f((unsigned short)(x.z >> 16)));
                    w.w = pk_h2(a1[2] + h2f((unsigned short)(x.w & 0xffffu)), a1[3] + h2f((unsigned short)(x.w >> 16)));
                    *(u32x4*)(out + off + bj * HALF) = w; } }
    }
};
struct EpiSwiGLU {
    static constexpr bool PERM = true;
    unsigned char* O;
    __device__ __forceinline__ void operator()(const f32x4 (&acc)[2][2][4][2], const Unit& u, int wr, int wc, int fr, int fq) const {
        const int row0 = u.g * EROWS + u.pm * BM + wr * 64 + fr, col0 = u.pn * HALF + wc * 32 + 8 * fq;
        constexpr float IS = 1.0f / (S_H2 * S_W), KE = -IS * LOG2E, C3 = 1.0f / (S_HM * IS * IS);
        typedef float f32x2_ __attribute__((ext_vector_type(2)));
#pragma unroll
        for (int ai = 0; ai < 2; ++ai)
#pragma unroll
            for (int m = 0; m < 4; ++m) {
                float r[8];
#pragma unroll
                for (int n = 0; n < 2; ++n)
#pragma unroll
                    for (int j = 0; j < 4; j += 2) { const f32x2_ g2 = {acc[ai][0][m][n][j], acc[ai][0][m][n][j + 1]}, u2 = {acc[ai][1][m][n][j], acc[ai][1][m][n][j + 1]};
                        const f32x2_ ar = g2 * KE; const f32x2_ t2 = {__builtin_amdgcn_exp2f(ar.x), __builtin_amdgcn_exp2f(ar.y)};
                        const f32x2_ den = t2 * C3 + C3; const f32x2_ sg = {__builtin_amdgcn_rcpf(den.x), __builtin_amdgcn_rcpf(den.y)};
                        const f32x2_ pr = (g2 * u2) * sg;
                        r[n * 4 + j] = clamp8(pr.x); r[n * 4 + j + 1] = clamp8(pr.y); }
                u32x2 w; w.x = pk_fp8x4(r[0], r[1], r[2], r[3]); w.y = pk_fp8x4(r[4], r[5], r[6], r[7]);
                *(u32x2*)(O + (size_t)(row0 + ai * HALF + m * 16) * FF + col0) = w;
            }
    }
};
struct EpiDown {
    static constexpr bool PERM = true;
    unsigned char* O; const float* gate;
    __device__ __forceinline__ void operator()(const f32x4 (&acc)[2][2][4][2], const Unit& u, int wr, int wc, int fr, int fq) const {
        const int row0 = u.g * EROWS + u.pm * BM + wr * 64 + fr, col0 = u.pn * BM + wc * 32 + 8 * fq;
        float gts[2][4];
#pragma unroll
        for (int ai = 0; ai < 2; ++ai)
#pragma unroll
            for (int m = 0; m < 4; ++m) gts[ai][m] = gate[row0 + ai * HALF + m * 16];
#pragma unroll
        for (int ai = 0; ai < 2; ++ai)
#pragma unroll
            for (int m = 0; m < 4; ++m) {
                const int row = row0 + ai * HALF + m * 16; const float gt = gts[ai][m] * (S_YE / (S_HM * S_W));
#pragma unroll
                for (int bj = 0; bj < 2; ++bj) { const f32x4 v0 = acc[ai][bj][m][0] * gt, v1 = acc[ai][bj][m][1] * gt;
                    u32x2 w; w.x = pk_fp8x4(clamp8(v0[0]), clamp8(v0[1]), clamp8(v0[2]), clamp8(v0[3])); w.y = pk_fp8x4(clamp8(v1[0]), clamp8(v1[1]), clamp8(v1[2]), clamp8(v1[3]));
                    *(u32x2*)(O + (size_t)row * DM + col0 + bj * HALF) = w; }
            }
    }
};

template <class Prob, class Epi, class Sched, bool ALIGN_EPI, class Side = NoSide>
__device__ __forceinline__ void gemm_phase(LAS unsigned char* lds, const Prob P, const Sched& S, const Epi& E, const Side SD = Side()) {
    const int tid = threadIdx.x, wid = __builtin_amdgcn_readfirstlane(tid >> 6), lane = tid & 63, wr = wid >> 2, wc = wid & 3, fr = lane & 15, fq = lane >> 4;
    const int KB = P.KB, nt = KB / 128;
    int RA[2]; unsigned CA2[2], voffB[2];
#pragma unroll
    for (int i = 0; i < 2; ++i) { int R, C; stage_rc(tid * 16 + i * 8192, R, C); const int Rb = Epi::PERM ? ((R & ~31) + perm32(R & 31)) : R;
        RA[i] = R; CA2[i] = (unsigned)C * 2u;
        if constexpr (Prob::BKN) {
            static_assert(Epi::PERM, "the [K][N] B path is written for PERM epilogues");
            const int r = 4 * wid + 32 * i + (lane >> 4), g = (r & 3) | (((r >> 3) & 1) << 2), c = (lane & 15) ^ (g << 1);
            voffB[i] = (unsigned)r * P.b_pitch() + (unsigned)c * 16u;
        } else if constexpr (Prob::FP8) {
            const int b_ = tid * 16 + i * 8192, RB = (b_ / 2048) * 16 + (b_ % 256) / 16, CB = ((b_ % 2048) / 256) * 16;
            const int RbB = Epi::PERM ? ((RB & ~31) + perm32(RB & 31)) : RB;
            voffB[i] = P.b_voff(RbB, CB);
        } else voffB[i] = P.b_voff(Rb, C * 2); }
    const unsigned kstep = (unsigned)(BK * 2);
    const size_t kstepB = P.b_kstep();
    int btr[2];
    { const int q = fr >> 2, p = fr & 3, X = ((q | ((fq & 1) << 2)) << 2) | (q & 1);
#pragma unroll
      for (int n = 0; n < 2; ++n) btr[n] = (8 * fq + q) * 256 + (((8 * wc + 2 * p + n) ^ X) * 8); }
    const unsigned lds_u32 = (unsigned)(__UINTPTR_TYPE__)lds;
    unsigned bta[2]; bta[0] = lds_u32 + (unsigned)btr[0]; bta[1] = lds_u32 + (unsigned)btr[1];
    const unsigned rowb = (unsigned)KB;
    const unsigned ldsw = (unsigned)wid * 1024u;
    const int aoff = lds_byte(wr * 64 + fr, fq * 8), boff = Prob::FP8 ? ((2 * wc) * 2048 + fq * 256 + fr * 16) : lds_byte(wc * 32 + fr, fq * 8);
#define PG8_SA(b, h) (((b) * 2 + (h)) * HTB)
#define PG8_SB(b, h) ((4 + (b) * 2 + (h)) * HTB)
#define PG8_STAGE_B(bufoff, gbase) do { _Pragma("unroll") for (int _i = 0; _i < 2; ++_i) \
        __builtin_amdgcn_global_load_lds((const unsigned*)((const char*)(gbase) + voffB[_i]), (LAS unsigned*)(lds + (bufoff) + ldsw + _i * 8192), 16, 0, 0); } while (0)
#define PG8_STAGE_A(bufoff, kb, offs) do { _Pragma("unroll") for (int _i = 0; _i < 2; ++_i) \
        __builtin_amdgcn_global_load_lds((const unsigned*)(P.A + (size_t)(kb) + (offs)[_i]), (LAS unsigned*)(lds + (bufoff) + ldsw + _i * 8192), 16, 0, 0); } while (0)
#define PG8_LDA(dst, b, h) do { if constexpr (Prob::FP8) { _Pragma("unroll") for (int m = 0; m < 4; ++m) { dst##8[m].lo = *(const LAS v4i_*)(lds + PG8_SA(b, h) + aoff + m * 2048); dst##8[m].hi = *(const LAS v4i_*)(lds + PG8_SA(b, h) + aoff + m * 2048 + 1024); } } \
        else { _Pragma("unroll") for (int m = 0; m < 4; ++m) _Pragma("unroll") for (int k = 0; k < 2; ++k) dst[m][k] = *(const LAS half8*)(lds + PG8_SA(b, h) + aoff + m * 2048 + k * 1024); } } while (0)
#define PG8_LDB(dst, b, h) do { if constexpr (Prob::BKN) { _Pragma("unroll") for (int n = 0; n < 2; ++n) { const unsigned ad_ = bta[n] + (unsigned)PG8_SB(b, h); _Pragma("unroll") for (int k = 0; k < 2; ++k) { \
            asm volatile("ds_read_b64_tr_b16 %0, %1 offset:%c2" : "=&v"(dst##lo[n][k]) : "v"(ad_), "i"(k * 8192) : "memory"); \
            asm volatile("ds_read_b64_tr_b16 %0, %1 offset:%c2" : "=&v"(dst##hi[n][k]) : "v"(ad_), "i"(k * 8192 + 1024) : "memory"); } } } \
        else if constexpr (Prob::FP8) { _Pragma("unroll") for (int n = 0; n < 2; ++n) { dst##8[n].lo = *(const LAS v4i_*)(lds + PG8_SB(b, h) + boff + n * 2048); dst##8[n].hi = *(const LAS v4i_*)(lds + PG8_SB(b, h) + boff + n * 2048 + 1024); } } \
        else { _Pragma("unroll") for (int n = 0; n < 2; ++n) _Pragma("unroll") for (int k = 0; k < 2; ++k) dst[n][k] = *(const LAS half8*)(lds + PG8_SB(b, h) + boff + n * 2048 + k * 1024); } } while (0)
#define PG8_BFIX(dst) do { if constexpr (Prob::BKN) { typedef short s16x8_ __attribute__((ext_vector_type(8))); _Pragma("unroll") for (int n = 0; n < 2; ++n) _Pragma("unroll") for (int k = 0; k < 2; ++k) { \
            const s16x8_ v_ = __builtin_shufflevector(dst##lo[n][k], dst##hi[n][k], 0, 1, 2, 3, 4, 5, 6, 7); dst[n][k] = __builtin_bit_cast(half8, v_); } } } while (0)
#define PG8_MMA(ai, bj, At, Bt) do { __builtin_amdgcn_s_setprio(1); _Pragma("unroll") for (int m = 0; m < 4; ++m) _Pragma("unroll") for (int n = 0; n < 2; ++n) { \
        if constexpr (Prob::FP8) asm volatile("v_mfma_f32_16x16x128_f8f6f4 %0, %1, %2, %0" : "+v"(acc[ai][bj][m][n]) : "v"(Bt##8[n]), "v"(At##8[m])); \
        else { _Pragma("unroll") for (int k = 0; k < 2; ++k) acc[ai][bj][m][n] = __builtin_amdgcn_mfma_f32_16x16x32_f16(Bt[n][k], At[m][k], acc[ai][bj][m][n], 0, 0, 0); } } \
        __builtin_amdgcn_s_setprio(0); } while (0)
#define PG8_WAIT_V(n) asm volatile("s_waitcnt vmcnt(" #n ")" ::: "memory")
#define PG8_WAIT_L(n) asm volatile("s_waitcnt lgkmcnt(" #n ")" ::: "memory")
#define PG8_BAR __builtin_amdgcn_s_barrier()
#define PG8_SCHED __builtin_amdgcn_sched_barrier(0)
#define PG8_SIDE_ISSUE(slot) do { if constexpr (Side::ON) { sfly = SD.L->pending() && (((slot) % SD.every) == 0); \
        if (sfly) { scc = SD.L->chunk(SD.L->done); const float* sp_ = SD.L->src_of(SD.L->wa, SD.L->wb, scc); \
            asm volatile("global_load_dwordx4 %0, %2, off\n\tglobal_load_dwordx4 %1, %2, off offset:16" : "=&v"(sr0), "=&v"(sr1) : "v"(sp_) : "memory"); } } } while (0)
#define PG8_SIDE_FINISH() do { if constexpr (Side::ON) { if (sfly) { asm volatile("" : "+v"(sr0), "+v"(sr1)); SD.L->store(SD.L->da, scc, sr0, sr1); SD.L->done += 1; } PG8_SCHED; } } while (0)
#define PG8_WAIT_VS(extra) do { if constexpr (Side::ON) { if (sfly) { if ((extra) == 2) PG8_WAIT_V(10); else PG8_WAIT_V(9); } else PG8_WAIT_V(8); } else PG8_WAIT_V(8); } while (0)
#define PG8_AOFF(dst, un) do { _Pragma("unroll") for (int _h = 0; _h < 2; ++_h) _Pragma("unroll") for (int _i = 0; _i < 2; ++_i) dst[_h][_i] = P.a_row(un, _h * HALF + RA[_i]) * rowb + CA2[_i]; } while (0)
    Unit cur, nxt; int ui = 0;
    if (!S.next(0, cur)) return;
    bool sfly = false; f32x4 sr0, sr1; unsigned scc = 0;
    f32x4 acc[2][2][4][2];
#pragma unroll
    for (int a = 0; a < 2; ++a)
#pragma unroll
        for (int b = 0; b < 2; ++b)
#pragma unroll
            for (int m = 0; m < 4; ++m)
#pragma unroll
                for (int n = 0; n < 2; ++n) acc[a][b][m][n] = (f32x4){0.f, 0.f, 0.f, 0.f};
    typedef int v4i_ __attribute__((ext_vector_type(4))); typedef int v8i_ __attribute__((ext_vector_type(8)));
    half8 At[4][2], B0[2][2], B1[2][2];
    s16x4 B0lo[2][2], B0hi[2][2], B1lo[2][2], B1hi[2][2];
    v8i_ At8[4], B08[2], B18[2];
    unsigned cuo[2][2], nxo[2][2];
    PG8_AOFF(cuo, cur);
    const char* cB0 = P.b_base(cur, 0); const char* cB1 = P.b_base(cur, 1);
    PG8_STAGE_B(PG8_SB(0, 0), cB0); PG8_STAGE_B(PG8_SB(0, 1), cB1); PG8_STAGE_A(PG8_SA(0, 0), 0, cuo[0]); PG8_STAGE_A(PG8_SA(0, 1), 0, cuo[1]);
    if (wr == 1) PG8_BAR;
    PG8_WAIT_V(2); PG8_BAR;
    PG8_STAGE_B(PG8_SB(1, 0), cB0 + kstepB); PG8_STAGE_A(PG8_SA(1, 0), kstep, cuo[0]); PG8_STAGE_B(PG8_SB(1, 1), cB1 + kstepB);
    PG8_WAIT_V(6); PG8_BAR;
    for (;;) {
        const bool has_next = S.next(ui + 1, nxt);
        if (!has_next) nxt = cur;
        PG8_AOFF(nxo, nxt);
        const char* nB0 = P.b_base(nxt, 0); const char* nB1 = P.b_base(nxt, 1);
        for (int t = 0; t < nt; t += 2) {
            const bool last = (t == nt - 2);
            const unsigned k1 = (unsigned)(t + 1) * kstep;
            const unsigned k2 = last ? 0u : (unsigned)(t + 2) * kstep, k3 = k2 + kstep;
            const char* b20 = last ? nB0 : cB0 + (size_t)(t + 2) * kstepB; const char* b21 = last ? nB1 : cB1 + (size_t)(t + 2) * kstepB;
            const char* b30 = b20 + kstepB; const char* b31 = b21 + kstepB;
            unsigned o20[2], o21[2];
#pragma unroll
            for (int i = 0; i < 2; ++i) { o20[i] = last ? nxo[0][i] : cuo[0][i]; o21[i] = last ? nxo[1][i] : cuo[1][i]; }
            PG8_LDB(B0, 0, 0); PG8_LDB(B1, 0, 1); PG8_SCHED; PG8_LDA(At, 0, 0); PG8_STAGE_A(PG8_SA(1, 1), k1, cuo[1]); PG8_SIDE_ISSUE((ui * nt + t) >> 1);
            PG8_WAIT_VS(2);
            PG8_WAIT_L(0); PG8_SCHED; PG8_BFIX(B0); PG8_BFIX(B1); PG8_BAR; PG8_MMA(0, 0, At, B0); PG8_MMA(0, 1, At, B1); PG8_BAR; PG8_SCHED;
            PG8_LDA(At, 0, 1); PG8_STAGE_B(PG8_SB(0, 0), b20); PG8_STAGE_B(PG8_SB(0, 1), b21); PG8_STAGE_A(PG8_SA(0, 0), k2, o20);
            PG8_WAIT_VS(2); PG8_WAIT_L(0); PG8_BAR; PG8_MMA(1, 0, At, B0); PG8_MMA(1, 1, At, B1); PG8_BAR; PG8_SCHED;
            PG8_LDB(B0, 1, 0); PG8_LDB(B1, 1, 1); PG8_SCHED; PG8_LDA(At, 1, 0); PG8_STAGE_A(PG8_SA(0, 1), k2, o21);
            PG8_WAIT_V(8);
            PG8_WAIT_L(0); PG8_SCHED; PG8_BFIX(B0); PG8_BFIX(B1); PG8_BAR; PG8_MMA(0, 0, At, B0); PG8_MMA(0, 1, At, B1); PG8_BAR; PG8_SCHED;
            PG8_SIDE_FINISH();
            PG8_LDA(At, 1, 1); PG8_STAGE_B(PG8_SB(1, 0), b30); PG8_STAGE_B(PG8_SB(1, 1), b31); PG8_STAGE_A(PG8_SA(1, 0), k3, o20);
            PG8_WAIT_VS(1); PG8_WAIT_L(0); PG8_BAR; PG8_MMA(1, 0, At, B0); PG8_MMA(1, 1, At, B1); PG8_BAR; PG8_SCHED;
            if constexpr (Side::ON) sfly = false;
        }
        if constexpr (ALIGN_EPI) { if (wr == 0) PG8_BAR; }
        if constexpr (Prob::FP8) asm volatile("s_nop 15\n\ts_nop 15" ::: "memory");
        E(acc, cur, wr, wc, fr, fq);
        if (!has_next) break;
#pragma unroll
        for (int a = 0; a < 2; ++a)
#pragma unroll
            for (int b = 0; b < 2; ++b)
#pragma unroll
                for (int m = 0; m < 4; ++m)
#pragma unroll
                    for (int n = 0; n < 2; ++n) acc[a][b][m][n] = (f32x4){0.f, 0.f, 0.f, 0.f};
        cur = nxt; cB0 = nB0; cB1 = nB1; ++ui;
#pragma unroll
        for (int h = 0; h < 2; ++h)
#pragma unroll
            for (int i = 0; i < 2; ++i) cuo[h][i] = nxo[h][i];
        if constexpr (ALIGN_EPI) { if (wr == 1) PG8_BAR; }
    }
    PG8_WAIT_V(0);
    if constexpr (!ALIGN_EPI) { if (wr == 0) PG8_BAR; }
    PG8_BAR;
#undef PG8_SA
#undef PG8_SB
#undef PG8_STAGE_A
#undef PG8_STAGE_B
#undef PG8_LDA
#undef PG8_LDB
#undef PG8_BFIX
#undef PG8_MMA
#undef PG8_WAIT_V
#undef PG8_WAIT_L
#undef PG8_BAR
#undef PG8_SCHED
#undef PG8_AOFF
#undef PG8_SIDE_ISSUE
#undef PG8_SIDE_FINISH
#undef PG8_WAIT_VS
}

__device__ __forceinline__ void tail_quarter(LAS unsigned char* lds, const char* A, const char* Bt, h16* O, const float* rs, int unit) {
    const int tid = threadIdx.x, wid = __builtin_amdgcn_readfirstlane(tid >> 6), lane = tid & 63, wr = wid >> 2, wc = wid & 3, fr = lane & 15, fq = lane >> 4;
    const int pm = unit >> 2, ai = (unit >> 1) & 1, bj = unit & 1;
    constexpr unsigned KB = DM * 2; constexpr int NT = DM * 2 / 128, SB = 2 * HTB, C0 = NIN - BM;
    unsigned oa[2], ob[2];
#pragma unroll
    for (int i = 0; i < 2; ++i) { int R, C; stage_rc(tid * 16 + i * 8192, R, C); const int Rb = (R & ~31) + perm32(R & 31);
        oa[i] = (unsigned)(pm * BM + ai * HALF + R) * KB + (unsigned)C * 2u; ob[i] = (unsigned)(C0 + bj * HALF + Rb) * KB + (unsigned)C * 2u; }
    const unsigned ldsw = (unsigned)wid * 1024u;
    const int aoff = lds_byte(wr * 64 + fr, fq * 8), boff = HTB + lds_byte(wc * 32 + fr, fq * 8);
#define TQ_STAGE(t) do { const int s_ = ((t) & 3) * SB; _Pragma("unroll") for (int _i = 0; _i < 2; ++_i) { \
        __builtin_amdgcn_global_load_lds((const unsigned*)(A + oa[_i] + (t) * 128), (LAS unsigned*)(lds + s_ + ldsw + _i * 8192), 16, 0, 0); \
        __builtin_amdgcn_global_load_lds((const unsigned*)(Bt + ob[_i] + (t) * 128), (LAS unsigned*)(lds + s_ + HTB + ldsw + _i * 8192), 16, 0, 0); } } while (0)
    f32x4 acc[4][2];
#pragma unroll
    for (int m = 0; m < 4; ++m)
#pragma unroll
        for (int n = 0; n < 2; ++n) acc[m][n] = (f32x4){0.f, 0.f, 0.f, 0.f};
    TQ_STAGE(0); TQ_STAGE(1); TQ_STAGE(2);
#pragma unroll
    for (int t = 0; t < NT; ++t) {
        if (t < NT - 2) asm volatile("s_waitcnt vmcnt(8)" ::: "memory"); else if (t == NT - 2) asm volatile("s_waitcnt vmcnt(4)" ::: "memory"); else asm volatile("s_waitcnt vmcnt(0)" ::: "memory");
        __builtin_amdgcn_s_barrier();
        __builtin_amdgcn_sched_barrier(0);
        if (t + 3 < NT) TQ_STAGE(t + 3);
        const int s = (t & 3) * SB;
        half8 a[4][2], b[2][2];
#pragma unroll
        for (int n = 0; n < 2; ++n)
#pragma unroll
            for (int k = 0; k < 2; ++k) b[n][k] = *(const LAS half8*)(lds + s + boff + n * 2048 + k * 1024);
#pragma unroll
        for (int m = 0; m < 4; ++m)
#pragma unroll
            for (int k = 0; k < 2; ++k) a[m][k] = *(const LAS half8*)(lds + s + aoff + m * 2048 + k * 1024);
        asm volatile("s_waitcnt lgkmcnt(0)" ::: "memory");
        __builtin_amdgcn_sched_barrier(0);
#pragma unroll
        for (int m = 0; m < 4; ++m)
#pragma unroll
            for (int n = 0; n < 2; ++n)
#pragma unroll
                for (int k = 0; k < 2; ++k) acc[m][n] = __builtin_amdgcn_mfma_f32_16x16x32_f16(b[n][k], a[m][k], acc[m][n], 0, 0, 0);
        __builtin_amdgcn_sched_barrier(0);
    }
#undef TQ_STAGE
    const int row0 = pm * BM + ai * HALF + wr * 64 + fr, col0 = C0 + bj * HALF + wc * 32 + 8 * fq;
#pragma unroll
    for (int m = 0; m < 4; ++m) { const float r_ = rs[row0 + m * 16]; const f32x4 v0 = acc[m][0] * r_, v1 = acc[m][1] * r_;
        u32x4 w; w.x = pk_h2(v0[0], v0[1]); w.y = pk_h2(v0[2], v0[3]); w.z = pk_h2(v1[0], v1[1]); w.w = pk_h2(v1[2], v1[3]);
        *(u32x4*)(O + (size_t)(row0 + m * 16) * NIN + col0) = w; }
    __builtin_amdgcn_s_barrier();
}
}

#define XB_TMO      128
#define XB_XCNT(j)  (256  + 64 * (j))
#define XB_XSUB(j)  (1280 + 64 * (j))
#define XB_XGEN(j)  (2304 + 64 * (j))
#define XB_TOP      3328
#define XB_TOPGEN   3392
#define XCD_BAR_WORDS 3456
#define XB_SPIN_CAP (1u << 18)
__device__ __forceinline__ unsigned xb_ld(unsigned* p)              { return __hip_atomic_load(p, __ATOMIC_RELAXED, __HIP_MEMORY_SCOPE_AGENT); }
__device__ __forceinline__ unsigned xb_add(unsigned* p, unsigned v) { return __hip_atomic_fetch_add(p, v, __ATOMIC_RELAXED, __HIP_MEMORY_SCOPE_AGENT); }
__device__ __forceinline__ unsigned xb_xcc_id() { return (unsigned)__builtin_amdgcn_s_getreg((3 << 11) | 20) & 0xFu; }
#define XB_SPIN(cond, bar) do { unsigned _sp = 0; while (cond) { __builtin_amdgcn_s_sleep(1); \
    if ((++_sp & 255u) == 0u) { if (xb_ld(&(bar)[XB_TMO])) break; if (_sp > XB_SPIN_CAP) { atomicAdd(&(bar)[XB_TMO], 1u); break; } } } } while (0)
struct XcdBarrier { unsigned* bar; unsigned x; volatile LAS unsigned* st; };
__device__ __forceinline__ XcdBarrier xcd_barrier_post(unsigned* bar, volatile LAS unsigned* st) {
    XcdBarrier b; b.bar = bar; b.x = xb_xcc_id(); b.st = st;
    if (threadIdx.x == 0) (void)xb_add(&bar[XB_XCNT(b.x)], 1u);
    return b;
}
__device__ __forceinline__ void xcd_barrier_complete(unsigned* bar, unsigned x, unsigned& nloc, unsigned& nx) {
    const unsigned G = gridDim.x * gridDim.y * gridDim.z;
    unsigned sum, cnt, mine, sp = 0u;
    for (;;) {
        sum = 0u; cnt = 0u; mine = 0u;
#pragma unroll
        for (unsigned j = 0; j < 16; ++j) { const unsigned c = xb_ld(&bar[XB_XCNT(j)]); sum += c; cnt += (c > 0u) ? 1u : 0u; mine = (j == x) ? c : mine; }
        if (sum == G) break;
        __builtin_amdgcn_s_sleep(1);
        if ((++sp & 255u) == 0u) { if (xb_ld(&bar[XB_TMO])) break; if (sp > XB_SPIN_CAP) { atomicAdd(&bar[XB_TMO], 1u); break; } }
    }
    nloc = mine > 0u ? mine : 1u; nx = cnt > 0u ? cnt : 1u;
}
__device__ __forceinline__ void xcd_barrier(const XcdBarrier& b) {
    asm volatile("s_waitcnt vmcnt(0)" ::: "memory");
    __syncthreads();
    if (threadIdx.x == 0) {
        unsigned* bar = b.bar;
        __builtin_amdgcn_s_waitcnt(0);
        unsigned nloc = b.st[0], nx = b.st[1];
        if (nloc == 0u) { xcd_barrier_complete(bar, b.x, nloc, nx); b.st[0] = nloc; b.st[1] = nx; }
        const unsigned old = xb_add(&bar[XB_XSUB(b.x)], 1u);
        const unsigned gen = old / nloc;
        if (old + 1u == (gen + 1u) * nloc) {
            __builtin_amdgcn_fence(__ATOMIC_RELEASE, "agent");
            asm volatile("s_waitcnt vmcnt(0)" ::: "memory");
            const unsigned og = xb_add(&bar[XB_TOP], 1u);
            const unsigned tg = og / nx;
            if (og + 1u == (tg + 1u) * nx) xb_add(&bar[XB_TOPGEN], 1u);
            else XB_SPIN(xb_ld(&bar[XB_TOPGEN]) == tg, bar);
            __builtin_amdgcn_fence(__ATOMIC_ACQUIRE, "agent");
            xb_add(&bar[XB_XGEN(b.x)], 1u);
            asm volatile("s_waitcnt vmcnt(0)" ::: "memory");
        } else {
            XB_SPIN(xb_ld(&bar[XB_XGEN(b.x)]) == gen, bar);
            __builtin_amdgcn_fence(__ATOMIC_ACQUIRE, "agent");
            asm volatile("s_waitcnt vmcnt(0)" ::: "memory");
        }
    }
    __syncthreads();
}

__device__ __forceinline__ void xcd_arrive(const XcdBarrier& b, unsigned* ctl, int cwx, int cwtop) {
    asm volatile("s_waitcnt vmcnt(0)" ::: "memory");
    __syncthreads();
    if (threadIdx.x == 0) {
        unsigned nloc = b.st[0], nx = b.st[1];
        if (nloc == 0u) { xcd_barrier_complete(b.bar, b.x, nloc, nx); b.st[0] = nloc; b.st[1] = nx; }
        const unsigned old = xb_add(&ctl[cwx + 64 * (int)b.x], 1u);
        if (old + 1u == nloc) { __builtin_amdgcn_fence(__ATOMIC_RELEASE, "agent"); asm volatile("s_waitcnt vmcnt(0)" ::: "memory"); xb_add(&ctl[cwtop], 1u); }
    }
}
__device__ __forceinline__ void xcd_wait(const XcdBarrier& b, unsigned* ctl, int cwtop) {
    if (threadIdx.x == 0) { const unsigned nx = b.st[1]; XB_SPIN(xb_ld(&ctl[cwtop]) != nx, b.bar); __builtin_amdgcn_fence(__ATOMIC_ACQUIRE, "agent"); asm volatile("s_waitcnt vmcnt(0)" ::: "memory"); }
    asm volatile("s_waitcnt lgkmcnt(0)" ::: "memory"); __builtin_amdgcn_s_barrier();
}

struct Frame {
    LAS unsigned char* lds;
    int tid, lane, wave, vcu, G;
    const float *x, *g_mix, *w_in, *a_sink, *g_out_a, *g_out_b, *w_out, *g_ffn, *w_router, *w_gate, *w_up, *w_down, *g_final;
    float* out; unsigned char* ws;
    unsigned long long tacc;
};

constexpr unsigned POOL0_STATIC = 12u * 2048u;
__device__ __forceinline__ void seam_work(Frame& F, const XcdBarrier& bar, int k) {
    unsigned* ctl = (unsigned*)(F.ws + WS_CTL); const int cwx = CW_SEAM + 1088 * k, cwtop = cwx + 1024;
    volatile LAS unsigned* sh = (volatile LAS unsigned*)(F.lds + MISC_OFF);
    xcd_arrive(bar, ctl, cwx, cwtop);
    if (F.G * NWAVES != 2048) { xcd_wait(bar, ctl, cwtop); return; }
    LAS float* scr = (LAS float*)(F.lds + F.wave * CV_SCR_BYTES);
    const unsigned nx = bar.st[1];
#pragma unroll 1
    for (unsigned par = 0;; par ^= 1u) {
        if (F.tid == 0) { const unsigned tp = xb_ld(&ctl[cwtop]); sh[par] = (tp == nx) ? 0xffffffffu : ((tp + 1u >= nx) ? 0xfffffffeu : POOL0_STATIC + __hip_atomic_fetch_add(ctl + CW_CONV, 8u, __ATOMIC_RELAXED, __HIP_MEMORY_SCOPE_AGENT)); }
        LDS_WAIT(); __builtin_amdgcn_s_barrier();
        const unsigned b_ = sh[par];
        if (b_ == 0xffffffffu) break;
        if (b_ == 0xfffffffeu) { __builtin_amdgcn_s_sleep(2); continue; }
        if (b_ + (unsigned)F.wave < CV_TOTAL) { const ConvItem c = conv8_decode(F.w_gate, F.w_up, F.w_down, F.ws, b_ + (unsigned)F.wave); f32x4 r[8]; conv8_issue(c, r, F.lane); conv8_finish(c, r, scr, F.lane); }
        else __builtin_amdgcn_s_sleep(8);
    }
    if (F.tid == 0) { __builtin_amdgcn_fence(__ATOMIC_ACQUIRE, "agent"); asm volatile("s_waitcnt vmcnt(0)" ::: "memory"); }
    __syncthreads();
}

__device__ __forceinline__ void p0_transpose_item(const float* W, int K, int N, h16* WT, int k0, int n0, int drow0, float sc, const float* gk, LAS float* scr, int lane) {
    float w[32];
#pragma unroll
    for (int i = 0; i < 32; ++i) w[i] = W[(size_t)(k0 + 2 * i + (lane >> 5)) * N + n0 + (lane & 31)];
    const int c = lane & 7;
    f32x4 g0 = {sc, sc, sc, sc}, g1 = g0;
    if (gk) { g0 = *(const f32x4*)(gk + k0 + 8 * c) * sc; g1 = *(const f32x4*)(gk + k0 + 8 * c + 4) * sc; }
#pragma unroll
    for (int i = 0; i < 32; ++i) scr[(2 * i + (lane >> 5)) * 33 + (lane & 31)] = w[i];
    LDS_WAIT(); asm volatile("" ::: "memory");
#pragma unroll
    for (int j = 0; j < 4; ++j) { const int n = (lane >> 3) + 8 * j; const LAS float* s = scr + (8 * c) * 33 + n;
        u32x4 o; o.x = pk_h2(s[0 * 33] * g0.x, s[1 * 33] * g0.y); o.y = pk_h2(s[2 * 33] * g0.z, s[3 * 33] * g0.w); o.z = pk_h2(s[4 * 33] * g1.x, s[5 * 33] * g1.y); o.w = pk_h2(s[6 * 33] * g1.z, s[7 * 33] * g1.w);
        *(GAS u32x4*)(WT + (size_t)(drow0 + n) * K + k0 + 8 * c) = o; }
    LDS_WAIT(); asm volatile("" ::: "memory");
}
__device__ __forceinline__ void sincos_d(double a, float& s, float& c) {
    const double q = __builtin_rint(a * 0.63661977236758134308);
    double r = __builtin_fma(-q, 1.570796325802803, a); r = __builtin_fma(-q, 9.920935796805404e-10, r);
    const double r2 = r * r;
    double sp = -7.6471637318198164759e-13;
    sp = sp * r2 + 1.6059043836821614599e-10; sp = sp * r2 - 2.5052108385441718775e-08; sp = sp * r2 + 2.7557319223985890653e-06;
    sp = sp * r2 - 1.9841269841269841270e-04; sp = sp * r2 + 8.3333333333333333333e-03; sp = sp * r2 - 1.6666666666666666667e-01;
    const double sn = r + r * r2 * sp;
    double cp = 4.7794773323873852974e-14;
    cp = cp * r2 - 1.1470745597729724714e-11; cp = cp * r2 + 2.0876756987868098979e-09; cp = cp * r2 - 2.7557319223985890653e-07;
    cp = cp * r2 + 2.4801587301587301587e-05; cp = cp * r2 - 1.3888888888888888889e-03; cp = cp * r2 + 4.1666666666666666667e-02; cp = cp * r2 - 0.5;
    const double cs = 1.0 + r2 * cp;
    const int qi = (int)q & 3;
    const double ss = (qi & 1) ? cs : sn, cc = (qi & 1) ? sn : cs;
    s = (float)((qi & 2) ? -ss : ss); c = (float)(((qi + 1) & 2) ? -cc : cc);
}

__device__ __forceinline__ void p0_prologue(Frame& F) {
    LAS float* scr = (LAS float*)(F.lds + F.wave * 16384);
    const int gw = F.vcu * NWAVES + F.wave, NGW = F.G * NWAVES;
    f32x4 vn[4];
    if (gw < M) {
#pragma unroll
        for (int j = 0; j < 4; ++j) vn[j] = __builtin_nontemporal_load((const GAS f32x4*)(F.x + (size_t)gw * DM) + F.lane + 64 * j);
    }
    {
        const double invf[8] = {1.0, 0.19392274474868576, 0.03760603093086393, 0.007292664737217109, 0.001414213562373095, 0.0002742481756762073, 5.318295896944988e-05, 1.031338537721246e-05};
        float* rope = (float*)(F.ws + WS_ROPE);
        for (int idx = F.vcu * 512 + F.tid; idx < SEQ * 8; idx += F.G * 512) {
            const int pos = idx >> 3, i = idx & 7;
            double f = invf[0];
#pragma unroll
            for (int j = 1; j < 8; ++j) f = (i == j) ? invf[j] : f;
            float s, c; sincos_d((double)pos * f, s, c);
            rope[pos * 16 + i] = c; rope[pos * 16 + 8 + i] = s;
        }
    }
    {
        constexpr int I_IN = (DM / 64) * (NIN / 32), I_OUT = (DM / 64) * (DM / 32);
        constexpr int NITEMS = I_IN + I_OUT;
        for (int it = gw; it < NITEMS; it += NGW) {
            int r = it;
            if (r < I_IN) { const int nblk = NIN / 32, kb = r / nblk, nb = r % nblk, n0 = 32 * nb;
                const float sc = (n0 < OFF_KA || (n0 >= OFF_QB && n0 < OFF_KB)) ? QSCALE : 1.0f;
                p0_transpose_item(F.w_in, DM, NIN, (h16*)(F.ws + WS_WIN), 64 * kb, n0, n0, sc, F.g_mix, scr, F.lane); continue; }
            r -= I_IN;
            { const int nblk = DM / 32, kb = r / nblk, nb = r % nblk, n0 = 32 * nb;
              p0_transpose_item(F.w_out, DM, DM, (h16*)(F.ws + WS_WOUT), 64 * kb, n0, n0, 1.0f, nullptr, scr, F.lane); }
        }
    }
    {
        h16* H = (h16*)(F.ws + WS_H); float* RS = (float*)(F.ws + WS_RS);
        for (int m = gw; m < M; m += NGW) {
            f32x4 v[4]; float s = 0.f;
#pragma unroll
            for (int j = 0; j < 4; ++j) { v[j] = vn[j]; s += (v[j].x * v[j].x + v[j].y * v[j].y) + (v[j].z * v[j].z + v[j].w * v[j].w); }
            if (m + NGW < M) {
#pragma unroll
                for (int j = 0; j < 4; ++j) vn[j] = __builtin_nontemporal_load((const GAS f32x4*)(F.x + (size_t)(m + NGW) * DM) + F.lane + 64 * j);
            }
            const float rs = 1.0f / sqrtf(wave_sum(s) * (1.0f / DM) + NORM_EPS);
            GAS u32x2* o8 = (GAS u32x2*)(H + (size_t)m * DM) + F.lane;
#pragma unroll
            for (int j = 0; j < 4; ++j) { const f32x4 y = v[j];
                u32x2 w; w.x = pk_h2(y.x, y.y); w.y = pk_h2(y.z, y.w); o8[64 * j] = w; }
            if (F.lane == 0) RS[m] = rs;
        }
    }
}

#define TSEC_BEGIN(code) unsigned long long tsec_##code = 0; if (TIME_PHASE == (code)) tsec_##code = __builtin_amdgcn_s_memrealtime()
#define TSEC_END(code) do { if (TIME_PHASE == (code)) F.tacc += __builtin_amdgcn_s_memrealtime() - tsec_##code; } while (0)
namespace att {
__device__ __forceinline__ int crow(int r, int hi) { return (r & 3) + 8 * (r >> 2) + 4 * hi; }
constexpr float THR = 8.0f;
constexpr int ATT_SIDE = 0;
constexpr int TILE_BYTES = 16384;
constexpr int WSF_OFF = 98304, STG_OFF = 100352;

__device__ __forceinline__ float max3f(float a, float b, float c) { float r; asm("v_max3_f32 %0, %1, %2, %3" : "=v"(r) : "v"(a), "v"(b), "v"(c)); return r; }
__device__ __forceinline__ float max16(const f32x16& p) {
    float a = max3f(p[0], p[1], p[2]), b = max3f(p[3], p[4], p[5]); a = max3f(a, p[6], p[7]); b = max3f(b, p[8], p[9]); a = max3f(a, p[10], p[11]); b = max3f(b, p[12], p[13]);
    return max3f(a, b, max3f(p[14], p[15], p[15])); }
__device__ __forceinline__ void tile_step(f32x16& o0, f32x16& o1, float& m, float& l, f32x16& negm, bool first, const half8 (&qr)[4],
                                          LAS const unsigned char* kt, LAS const unsigned char* vt, LAS float* wsf, int lane, int r32, int hi,
                                          int mode0, int mode1, int rel0, int lo, unsigned span) {
    f32x16 p0 = negm, p1 = negm;
    unsigned kba[4];
#pragma unroll
    for (int d0 = 0; d0 < 4; ++d0) kba[d0] = (unsigned)(__UINTPTR_TYPE__)(kt + hi * 1024 + ((r32 & ~7) | ((r32 ^ hi ^ (2 * d0)) & 7)) * 16);
    const float NINF = -__builtin_inff();
    float rm = NINF;
    half8 kf0[4], kf1[4];
    if (mode0) {
#pragma unroll
        for (int d0 = 0; d0 < 4; ++d0) asm volatile("ds_read_b128 %0, %1 offset:%c2" : "=v"(kf0[d0]) : "v"(kba[d0]), "i"(d0 * 2048) : "memory");
    }
    if (mode1) {
#pragma unroll
        for (int d0 = 0; d0 < 4; ++d0) asm volatile("ds_read_b128 %0, %1 offset:%c2" : "=v"(kf1[d0]) : "v"(kba[d0]), "i"(d0 * 2048 + 512) : "memory");
    }
    asm volatile("s_waitcnt lgkmcnt(0)" ::: "memory");
    __builtin_amdgcn_sched_barrier(0);
    if (mode0) {
#pragma unroll
        for (int d0 = 0; d0 < 4; ++d0) p0 = __builtin_amdgcn_mfma_f32_32x32x16_f16(kf0[d0], qr[d0], p0, 0, 0, 0);
    }
    if (mode1) {
#pragma unroll
        for (int d0 = 0; d0 < 4; ++d0) p1 = __builtin_amdgcn_mfma_f32_32x32x16_f16(kf1[d0], qr[d0], p1, 0, 0, 0);
    }
    asm volatile("s_nop 15\n\ts_nop 7" : "+v"(p0), "+v"(p1));
    if (mode0) {
        if (mode0 == 2) {
#pragma unroll
            for (int r = 0; r < 16; ++r) { const int rel = rel0 + (r & 3) + 8 * (r >> 2); if ((unsigned)(rel - lo) > span) p0[r] = NINF; }
        }
        rm = max16(p0);
    }
    if (mode1) {
        if (mode1 == 2) {
#pragma unroll
            for (int r = 0; r < 16; ++r) { const int rel = rel0 + 32 + (r & 3) + 8 * (r >> 2); if ((unsigned)(rel - lo) > span) p1[r] = NINF; }
        }
        rm = fmaxf(rm, max16(p1));
    }
    { auto rr = __builtin_amdgcn_permlane32_swap(__float_as_uint(rm), __float_as_uint(rm), false, false); rm = fmaxf(__uint_as_float(rr[0]), __uint_as_float(rr[1])); }
    if (first || __any(rm > THR)) {
        const float dl = first ? fmaxf(rm, -100.f) : fmaxf(rm, 0.f); m += dl;
#pragma unroll
        for (int r = 0; r < 16; ++r) { p0[r] -= dl; p1[r] -= dl; negm[r] = -m; }
        if (!first) {
            const float f = __builtin_amdgcn_exp2f(-dl); l *= f;
            if (hi == 0) wsf[r32] = f;
            LDS_WAIT();
#pragma unroll
            for (int r = 0; r < 16; ++r) { const float fr_ = wsf[crow(r, hi)]; o0[r] *= fr_; o1[r] *= fr_; }
        }
    }
    LAS const unsigned char* vb = vt + (4 * hi + ((lane & 15) >> 2)) * 64 + ((lane >> 4) & 1) * 32 + (lane & 3) * 8;
    typedef short s16x8 __attribute__((ext_vector_type(8)));
    float s = 0.f;
#define ATT_HALF(P, KS0) do { \
        _Pragma("unroll") for (int r = 0; r < 16; ++r) { P[r] = __builtin_amdgcn_exp2f(P[r]); s += P[r]; } \
        u32x4 pwa, pwb; \
        _Pragma("unroll") for (int j = 0; j < 4; ++j) { pwa[j] = pk_h2_rtz(P[2 * j], P[2 * j + 1]); pwb[j] = pk_h2_rtz(P[8 + 2 * j], P[9 + 2 * j]); } \
        _Pragma("unroll") for (int kk = 0; kk < 2; ++kk) { const half8 pa = __builtin_bit_cast(half8, kk ? pwb : pwa); \
            _Pragma("unroll") for (int d0 = 0; d0 < 2; ++d0) { \
                const s16x4 vlo = __builtin_amdgcn_ds_read_tr16_b64_v4i16((LAS s16x4*)(vb + d0 * 4096 + ((KS0) + kk) * 1024)); \
                const s16x4 vhi = __builtin_amdgcn_ds_read_tr16_b64_v4i16((LAS s16x4*)(vb + d0 * 4096 + ((KS0) + kk) * 1024 + 512)); \
                const s16x8 vv = {vlo[0], vlo[1], vlo[2], vlo[3], vhi[0], vhi[1], vhi[2], vhi[3]}; \
                const half8 vf = __builtin_bit_cast(half8, vv); \
                if (d0 == 0) o0 = __builtin_amdgcn_mfma_f32_32x32x16_f16(pa, vf, o0, 0, 0, 0); \
                else         o1 = __builtin_amdgcn_mfma_f32_32x32x16_f16(pa, vf, o1, 0, 0, 0); } } } while (0)
    if (mode0) ATT_HALF(p0, 0);
    if (mode1) ATT_HALF(p1, 2);
#undef ATT_HALF
    l += s;
}

__device__ __forceinline__ void load_tile_regs(u32x4& kreg, u32x4& vreg, const h16* proj, int tokb, int dil, int LF, int tt0, int kcol, int vcol, int wid, int lane) {
    const int tk_raw = tt0 + 8 * wid + (lane >> 3);
    int tk = tk_raw; tk = tk < 0 ? 0 : (tk >= LF ? LF - 1 : tk);
    kreg = *(const u32x4*)(proj + (size_t)(tokb + tk * dil) * NIN + kcol + (lane & 7) * 8);
    int tv = tk_raw; tv = tv < 0 ? 0 : (tv >= LF ? LF - 1 : tv);
    vreg = *(const u32x4*)(proj + (size_t)(tokb + tv * dil) * NIN + vcol + (lane & 7) * 8);
}

__device__ __forceinline__ void store_out(const f32x16& o0, const f32x16& o1, float l_tot, LAS float* wsf, LAS h16* stg, h16* dst, size_t pitch, int tok0, int dil, int lane, int r32, int hi) {
    if (hi == 0) wsf[32 + r32] = l_tot;
    LDS_WAIT();
#pragma unroll
    for (int r = 0; r < 16; ++r) { const int orow = crow(r, hi); const float rl = __builtin_amdgcn_rcpf(wsf[32 + orow]);
        stg[orow * 64 + r32] = __builtin_bit_cast(h16, (_Float16)(o0[r] * rl)); stg[orow * 64 + 32 + r32] = __builtin_bit_cast(h16, (_Float16)(o1[r] * rl)); }
    LDS_WAIT();
#pragma unroll
    for (int i = 0; i < 4; ++i) { const int row = i * 8 + (lane >> 3), ch = lane & 7; const u32x4 v = *(LAS const u32x4*)(stg + row * 64 + ch * 8);
        *(u32x4*)(dst + (size_t)(tok0 + row * dil) * pitch + ch * 8) = v; }
    LDS_WAIT();
}

struct UnitP { int isA, ntile, tt_first, dil, LF, tokb, kcol, vcol, hw, q0, g, h, p; };
__device__ __forceinline__ UnitP decode_unit(int u) {
    UnitP P;
    if (u < 512) { const int qb = u & 63, g = (u >> 6) & 1, b = u >> 7;
        P.isA = 1; P.ntile = 5; P.q0 = qb * 64; P.tt_first = P.q0 - 128; P.dil = 1; P.LF = SEQ; P.tokb = b * SEQ; P.kcol = OFF_KA + g * 64; P.vcol = OFF_VA + g * 64; P.hw = 128; P.g = g; P.h = 0; P.p = 0; }
    else { const int v = u - 512, u16 = v & 15, p = (v >> 4) % 3, bh = v / 48, h = bh & 7, b = bh >> 3, sh = 2 * p, dil = 1 << sh, res = u16 & (dil - 1), qb = u16 >> sh;
        P.isA = 0; P.ntile = 6; P.q0 = 256 * qb; P.tt_first = P.q0 - 64; P.dil = dil; P.LF = SEQ >> sh; P.tokb = b * SEQ + res; P.kcol = OFF_KB + h * 64; P.vcol = OFF_VB + h * 64; P.hw = 64; P.g = 0; P.h = h; P.p = p; }
    return P;
}
__device__ __forceinline__ void issue_tiles(u32x4 (&kr)[6], u32x4 (&vr)[6], const UnitP& P, const h16* proj, int wid, int lane) {
#pragma unroll
    for (int j = 0; j < 6; ++j) { const int tt0 = P.tt_first + 64 * j; if (j < P.ntile && tt0 >= 0 && tt0 < P.LF) load_tile_regs(kr[j], vr[j], proj, P.tokb, P.dil, P.LF, tt0, P.kcol, P.vcol, wid, lane); }
}
__device__ __forceinline__ void write_tiles(LAS unsigned char* L, const u32x4 (&kr)[6], const u32x4 (&vr)[6], const UnitP& P, int wid, int lane) {
#pragma unroll
    for (int j = 0; j < 6; ++j) { const int tt0 = P.tt_first + 64 * j; if (j < P.ntile && tt0 >= 0 && tt0 < P.LF) {
        *(LAS u32x4*)(L + j * TILE_BYTES + (lane & 7) * 1024 + (8 * wid + (((lane >> 3) ^ lane) & 7)) * 16) = kr[j];
        { const int key_ = 8 * wid + (lane >> 3); *(LAS u32x4*)(L + j * TILE_BYTES + 8192 + ((lane & 7) >> 2) * 4096 + (key_ >> 4) * 1024 + (key_ & 15) * 64 + (lane & 3) * 16) = vr[j]; } } }
}

__device__ __forceinline__ void attn_phase(Frame& F) {
    const int lane = F.lane, wid = F.wave, r32 = lane & 31, hi = lane >> 5;
    LAS unsigned char* L = F.lds;
    LAS float* wsf = (LAS float*)(L + WSF_OFF) + wid * 64;
    LAS h16* stg = (LAS h16*)(L + STG_OFF + wid * 4096);
    const h16* proj = (const h16*)(F.ws + WS_PROJ);
    int u = F.vcu;
    if (u >= 2048) return;
    UnitP P = decode_unit(u);
    u32x4 kr[6], vr[6];
    issue_tiles(kr, vr, P, proj, wid, lane);
    half8 qn[4];
#define ATT_QLOAD(PP) do { const int qw_ = (PP).isA ? (PP).q0 + 32 * (wid >> 2) : (PP).q0 + 32 * wid, qc_ = (PP).isA ? OFF_QA + (4 * (PP).g + (wid & 3)) * 64 : OFF_QB + (PP).h * 64; \
        const h16* qp_ = proj + (size_t)((PP).tokb + (qw_ + r32) * (PP).dil) * NIN + qc_ + hi * 8; _Pragma("unroll") for (int d0 = 0; d0 < 4; ++d0) qn[d0] = *(const half8*)(qp_ + d0 * 16); } while (0)
    ATT_QLOAD(P);
#pragma unroll 1
    for (; u < 2048; u += F.G) {
        TSEC_BEGIN(20);
        write_tiles(L, kr, vr, P, wid, lane);
        int head, tq, qcol, jb, je, qw0;
        if (P.isA) { head = 4 * P.g + (wid & 3); qw0 = P.q0 + 32 * (wid >> 2); qcol = OFF_QA + head * 64; jb = 0; je = 5; }
        else       { head = P.h; qw0 = P.q0 + 32 * wid; qcol = OFF_QB + head * 64; jb = wid >> 1; je = jb + 3; }
        tq = qw0 + r32; (void)qcol;
        half8 qr[4];
#pragma unroll
        for (int d0 = 0; d0 < 4; ++d0) qr[d0] = qn[d0];
        float m = P.isA ? F.a_sink[head] * LOG2E : 0.f, l = (P.isA && hi == 0) ? 1.0f : 0.0f;
        bool first = !P.isA;
        asm volatile("" ::: "memory");
        __syncthreads();
#pragma unroll
        for (int d0 = 0; d0 < 4; ++d0) asm volatile("" : "+v"(qr[d0]));
        TSEC_END(20);
        TSEC_BEGIN(21);
        const UnitP Pc = P;
        if (u + F.G < 2048) { P = decode_unit(u + F.G); issue_tiles(kr, vr, P, proj, wid, lane); ATT_QLOAD(P); }
        asm volatile("" ::: "memory");
        f32x16 o0, o1, negm;
#pragma unroll
        for (int r = 0; r < 16; ++r) { o0[r] = 0.f; o1[r] = 0.f; negm[r] = -m; }
        const int lo = (-Pc.hw > -tq) ? -Pc.hw : -tq, hi_ = (Pc.hw < Pc.LF - 1 - tq) ? Pc.hw : (Pc.LF - 1 - tq); const unsigned span = (unsigned)(hi_ - lo);
#pragma unroll 1
        for (int j = jb; j < je; ++j) {
            const int tt0 = Pc.tt_first + 64 * j; if (tt0 < 0 || tt0 >= Pc.LF) continue;
            int md[2];
#pragma unroll
            for (int h = 0; h < 2; ++h) { const int mn = tt0 + 32 * h - (qw0 + 31), mx = tt0 + 32 * h + 31 - qw0;
                md[h] = (mn > Pc.hw || mx < -Pc.hw) ? 0 : ((mn >= -Pc.hw && mx <= Pc.hw) ? 1 : 2); }
            if ((md[0] | md[1]) == 0) continue;
            tile_step(o0, o1, m, l, negm, first, qr, L + j * TILE_BYTES, L + j * TILE_BYTES + 8192, wsf, lane, r32, hi, md[0], md[1], tt0 + 4 * hi - tq, lo, span);
            first = false;
        }
        { auto rr = __builtin_amdgcn_permlane32_swap(__float_as_uint(l), __float_as_uint(l), false, false); l = __uint_as_float(rr[0]) + __uint_as_float(rr[1]); }
        TSEC_END(21);
        TSEC_BEGIN(22);
        if (Pc.isA) store_out(o0, o1, l, wsf, stg, (h16*)(F.ws + WS_OA) + head * 64, 512, Pc.tokb + qw0, 1, lane, r32, hi);
        else {
            if (hi == 0) ((float*)(F.ws + WS_LSE))[((size_t)Pc.p * M + Pc.tokb + tq * Pc.dil) * 8 + head] = (m + __builtin_amdgcn_logf(l)) * LN2;
            store_out(o0, o1, l, wsf, stg, (h16*)(F.ws + WS_OB) + (size_t)Pc.p * M * 512 + head * 64, 512, Pc.tokb + qw0 * Pc.dil, Pc.dil, lane, r32, hi);
        }
        __syncthreads();
        TSEC_END(22);
    }
}
}

__device__ __forceinline__ void p3_combine(Frame& F) {
    const int gw = F.vcu * NWAVES + F.wave, NGW = F.G * NWAVES, lane = F.lane;
    const h16* OA = (const h16*)(F.ws + WS_OA); const h16* OB = (const h16*)(F.ws + WS_OB); const float* LSE = (const float*)(F.ws + WS_LSE);
    h16* MX = (h16*)(F.ws + WS_MIXED);
    f32x4 ga[2], gb[2];
#pragma unroll
    for (int i = 0; i < 2; ++i) { ga[i] = *(const f32x4*)(F.g_out_a + 8 * lane + 4 * i); gb[i] = *(const f32x4*)(F.g_out_b + 8 * lane + 4 * i); }
    u32x4 ran, rbn[3]; float lsn[3];
#define P3_LOAD(T) do { ran = __builtin_nontemporal_load((const u32x4*)(OA + (size_t)(T) * 512 + 8 * lane)); \
        _Pragma("unroll") for (int p = 0; p < 3; ++p) { rbn[p] = __builtin_nontemporal_load((const u32x4*)(OB + ((size_t)p * M + (T)) * 512 + 8 * lane)); lsn[p] = LSE[((size_t)p * M + (T)) * 8 + (lane >> 3)]; } } while (0)
    if (gw < M) P3_LOAD(gw);
    for (int t = gw; t < M; t += NGW) {
        const u32x4 ra = ran;
        u32x4 rb[3]; float ls[3];
#pragma unroll
        for (int p = 0; p < 3; ++p) { rb[p] = rbn[p]; ls[p] = lsn[p]; }
        if (t + NGW < M) P3_LOAD(t + NGW);
        float a[8], bsum[8];
#pragma unroll
        for (int i = 0; i < 4; ++i) { a[2 * i] = h2f((unsigned short)(ra[i] & 0xffffu)); a[2 * i + 1] = h2f((unsigned short)(ra[i] >> 16)); }
        const float mx = fmaxf(ls[0], fmaxf(ls[1], ls[2]));
        float w[3]; float ws_ = 0.f;
#pragma unroll
        for (int p = 0; p < 3; ++p) { w[p] = __expf(ls[p] - mx); ws_ += w[p]; }
        const float inv = 1.0f / ws_;
#pragma unroll
        for (int i = 0; i < 8; ++i) bsum[i] = 0.f;
#pragma unroll
        for (int p = 0; p < 3; ++p) { const float wp = w[p] * inv;
#pragma unroll
            for (int i = 0; i < 4; ++i) { bsum[2 * i] += wp * h2f((unsigned short)(rb[p][i] & 0xffffu)); bsum[2 * i + 1] += wp * h2f((unsigned short)(rb[p][i] >> 16)); } }
        float sa = 0.f, sb = 0.f;
#pragma unroll
        for (int i = 0; i < 8; ++i) { sa += a[i] * a[i]; sb += bsum[i] * bsum[i]; }
        const float rsa = 1.0f / sqrtf(wave_sum(sa) * (1.0f / 512.0f) + NORM_EPS), rsb = 1.0f / sqrtf(wave_sum(sb) * (1.0f / 512.0f) + NORM_EPS);
        u32x4 wa, wb;
#pragma unroll
        for (int i = 0; i < 4; ++i) { wa[i] = pk_h2(a[2 * i] * rsa * ga[i >> 1][(2 * i) & 3], a[2 * i + 1] * rsa * ga[i >> 1][(2 * i + 1) & 3]);
                                      wb[i] = pk_h2(bsum[2 * i] * rsb * gb[i >> 1][(2 * i) & 3], bsum[2 * i + 1] * rsb * gb[i >> 1][(2 * i + 1) & 3]); }
        *(u32x4*)(MX + (size_t)t * DM + 8 * lane) = wa;
        *(u32x4*)(MX + (size_t)t * DM + 512 + 8 * lane) = wb;
    }
#undef P3_LOAD
}

__device__ __forceinline__ void p6_topk(Frame& F);
__device__ __forceinline__ void p5_router(Frame& F, const XcdBarrier& bar) {
    const int gw = F.vcu * NWAVES + F.wave, NGW = F.G * NWAVES, lane = F.lane;
    LAS unsigned char* L = F.lds;
    for (int i = F.tid; i < DM * 4; i += NWAVES * 64) { const int k = i >> 2, c = i & 3; *(LAS f32x4*)(L + k * 64 + (k >> 2) * 16 + c * 16) = *(const f32x4*)(F.w_router + k * 16 + c * 4); }
    __syncthreads();
    const h16* X1 = (const h16*)(F.ws + WS_X1); unsigned char* H2 = F.ws + WS_H2; float* AFF = (float*)(F.ws + WS_AFF);
    f32x4 g[4];
#pragma unroll
    for (int j = 0; j < 4; ++j) g[j] = ((const f32x4*)F.g_ffn)[lane + 64 * j];
    u32x2 vn[4];
    LAS float* cscr = (LAS float*)(L + 69632 + F.wave * CV_SCR_BYTES);
    const float* const wg_ = F.w_gate; const float* const wu_ = F.w_up; const float* const wd_ = F.w_down; unsigned char* const ws_ = F.ws;
    const int JT = (int)((CV_TOTAL + (unsigned)NGW - 1u) / (unsigned)NGW), JP6 = JT;
    const int rows_ = (gw < M) ? (M - gw + NGW - 1) / NGW : 0, J1 = (4 + rows_ < JP6) ? 4 + rows_ : JP6;
    const unsigned POOL0 = (unsigned)(4 + (M + NGW - 1) / NGW) * (unsigned)NGW, POOL1 = ((unsigned)JP6 * (unsigned)NGW < CV_TOTAL) ? (unsigned)JP6 * (unsigned)NGW : CV_TOTAL;
    int cj = 0; bool cpendA = false, cpendB = false;
    ConvItem citA = conv8_decode(wg_, wu_, wd_, ws_, (unsigned)gw < CV_TOTAL ? (unsigned)gw : 0u), citB = citA; f32x4 cregA[8], cregB[8];
#define P5_PUMP1(PEND, ITEM, REG) do { __builtin_amdgcn_sched_barrier(0); if (PEND) conv8_finish(ITEM, REG, cscr, lane); __builtin_amdgcn_sched_barrier(0); \
        { const unsigned it_ = (unsigned)cj * (unsigned)NGW + (unsigned)gw; PEND = (cj < J1) && (it_ < CV_TOTAL); if (PEND) ITEM = conv8_decode(wg_, wu_, wd_, ws_, it_); ++cj; conv8_issue(ITEM, REG, lane); } __builtin_amdgcn_sched_barrier(0); } while (0)
#define P5_PUMP() do { if (cj & 1) P5_PUMP1(cpendB, citB, cregB); else P5_PUMP1(cpendA, citA, cregA); } while (0)
    P5_PUMP();
    P5_PUMP();
    P5_PUMP();
    P5_PUMP();
    xcd_wait(bar, (unsigned*)(F.ws + WS_CTL), CW_ARR2_TOP);
    if (gw < M) {
#pragma unroll
        for (int j = 0; j < 4; ++j) vn[j] = __builtin_nontemporal_load((const u32x2*)(X1 + (size_t)gw * DM) + lane + 64 * j);
    }
    for (int t = gw; t < M; t += NGW) {
        f32x4 v[4]; float s = 0.f;
#pragma unroll
        for (int j = 0; j < 4; ++j) { v[j].x = h2f((unsigned short)(vn[j].x & 0xffffu)); v[j].y = h2f((unsigned short)(vn[j].x >> 16)); v[j].z = h2f((unsigned short)(vn[j].y & 0xffffu)); v[j].w = h2f((unsigned short)(vn[j].y >> 16)); }
        if (t + NGW < M) {
#pragma unroll
            for (int j = 0; j < 4; ++j) vn[j] = __builtin_nontemporal_load((const u32x2*)(X1 + (size_t)(t + NGW) * DM) + lane + 64 * j);
        }
#pragma unroll
        for (int j = 0; j < 4; ++j) s += (v[j].x * v[j].x + v[j].y * v[j].y) + (v[j].z * v[j].z + v[j].w * v[j].w);
        const float rs = 1.0f / sqrtf(wave_sum(s) * (1.0f / DM) + NORM_EPS);
        unsigned* o4 = (unsigned*)(H2 + (size_t)t * DM) + lane;
        float acc[16];
#pragma unroll
        for (int e = 0; e < 16; ++e) acc[e] = 0.f;
#pragma unroll
        for (int j = 0; j < 4; ++j) {
            const f32x4 y = v[j] * rs * g[j];
            o4[64 * j] = pk_fp8x4(clamp8(y.x * S_H2), clamp8(y.y * S_H2), clamp8(y.z * S_H2), clamp8(y.w * S_H2));
#pragma unroll
            for (int c = 0; c < 4; ++c) {
                const int k = 256 * j + 4 * lane + c; LAS const f32x4* wr = (LAS const f32x4*)(L + k * 64 + (k >> 2) * 16);
#pragma unroll
                for (int q = 0; q < 4; ++q) { const f32x4 wv = wr[q];
#pragma unroll
                    for (int z = 0; z < 4; ++z) acc[4 * q + z] += y[c] * wv[z]; }
                if (c & 1) asm volatile("" ::: "memory");
            }
        }
        { const bool up = (lane & 32) != 0;
#pragma unroll
          for (int i = 0; i < 8; ++i) { const float send = up ? acc[i] : acc[i + 8], keep = up ? acc[i + 8] : acc[i]; acc[i] = keep + __shfl_xor(send, 32); } }
        { const bool up = (lane & 16) != 0;
#pragma unroll
          for (int i = 0; i < 4; ++i) { const float send = up ? acc[i] : acc[i + 4], keep = up ? acc[i + 4] : acc[i]; acc[i] = keep + __shfl_xor(send, 16); } }
        { const bool up = (lane & 8) != 0;
#pragma unroll
          for (int i = 0; i < 2; ++i) { const float send = up ? acc[i] : acc[i + 2], keep = up ? acc[i + 2] : acc[i]; acc[i] = keep + __shfl_xor(send, 8); } }
        float lg;
        { const bool up = (lane & 4) != 0; const float send = up ? acc[0] : acc[1], keep = up ? acc[1] : acc[0]; lg = keep + __shfl_xor(send, 4); }
        lg += __shfl_xor(lg, 2); lg += __shfl_xor(lg, 1);
        float mx = lg;
#pragma unroll
        for (int o = 4; o < 64; o <<= 1) mx = fmaxf(mx, __shfl_xor(mx, o));
        const float ex = __expf(lg - mx); float sm = ex;
#pragma unroll
        for (int o = 4; o < 64; o <<= 1) sm += __shfl_xor(sm, o);
        if ((lane & 3) == 0) { const int e = lane >> 2, b = t >> 12, sidx = t & (SEQ - 1); AFF[((size_t)(b * NE + e)) * SEQ + sidx] = ex / sm; }
        P5_PUMP();
    }
    unsigned* ctl = (unsigned*)(F.ws + WS_CTL); volatile LAS unsigned* sh = (volatile LAS unsigned*)(L + MISC_OFF);
    asm volatile("s_waitcnt vmcnt(8)" ::: "memory");
    LDS_WAIT(); __builtin_amdgcn_s_barrier();
    if (F.tid == 0) {
        const unsigned nloc = bar.st[0], old = xb_add(&ctl[CW_ARR_X + 64 * (int)bar.x], 1u);
        if (old + 1u == nloc) { __builtin_amdgcn_fence(__ATOMIC_RELEASE, "agent"); asm volatile("s_waitcnt vmcnt(0)" ::: "memory"); xb_add(&ctl[CW_ARR_TOP], 1u); }
    }
    const bool tk_wg = F.vcu < BATCH * NE; bool tk_done = !tk_wg; const unsigned nxcc = bar.st[1];
#define P5_TOPK() do { if (F.tid == 0) { __builtin_amdgcn_fence(__ATOMIC_ACQUIRE, "agent"); asm volatile("s_waitcnt vmcnt(0)" ::: "memory"); } __syncthreads(); p6_topk(F); tk_done = true; } while (0)
    unsigned par = 0u;
#pragma unroll 1
    for (; cj < J1; par ^= 1u) {
        if (!tk_done) {
            if (F.tid == 0) sh[2 + par] = (xb_ld(&ctl[CW_ARR_TOP]) == nxcc) ? 1u : 0u;
            LDS_WAIT(); __builtin_amdgcn_s_barrier();
            if (sh[2 + par] != 0u) P5_TOPK();
        }
        P5_PUMP();
    }
    if (POOL0 < POOL1 && M % NGW == 0) {
        unsigned* pctr = ctl + CW_CONV;
#define P5_PUMPD(PEND, ITEM, REG) do { __builtin_amdgcn_sched_barrier(0); if (PEND) conv8_finish(ITEM, REG, cscr, lane); __builtin_amdgcn_sched_barrier(0); \
        { PEND = it_ < POOL1; if (PEND) ITEM = conv8_decode(wg_, wu_, wd_, ws_, it_); ++cj; conv8_issue(ITEM, REG, lane); } __builtin_amdgcn_sched_barrier(0); } while (0)
        unsigned nb_ = 0u;
        if (F.tid == 0) nb_ = POOL0 + __hip_atomic_fetch_add(pctr, 16u, __ATOMIC_RELAXED, __HIP_MEMORY_SCOPE_AGENT);
#pragma unroll 1
        for (;; par ^= 1u) {
            if (F.tid == 0) { sh[par] = nb_; nb_ = POOL0 + __hip_atomic_fetch_add(pctr, 16u, __ATOMIC_RELAXED, __HIP_MEMORY_SCOPE_AGENT);
                              if (!tk_done) sh[2 + par] = (xb_ld(&ctl[CW_ARR_TOP]) == nxcc) ? 1u : 0u; }
            LDS_WAIT(); __builtin_amdgcn_s_barrier();
            const unsigned b_ = sh[par];
            if (!tk_done && sh[2 + par] != 0u) P5_TOPK();
            if (b_ >= POOL1) break;
            { const unsigned it_ = b_ + (unsigned)F.wave; if (cj & 1) P5_PUMPD(cpendB, citB, cregB); else P5_PUMPD(cpendA, citA, cregA); }
            { const unsigned it_ = b_ + 8u + (unsigned)F.wave; if (cj & 1) P5_PUMPD(cpendB, citB, cregB); else P5_PUMPD(cpendA, citA, cregA); }
        }
#undef P5_PUMPD
    } else {
#pragma unroll 1
        while (cj < JP6) { const int J1 = JP6; P5_PUMP(); }
    }
    bool tk_late = false;
    if (!tk_done) {
        if (F.tid == 0) XB_SPIN(xb_ld(&ctl[CW_ARR_TOP]) != nxcc, bar.bar);
        P5_TOPK(); tk_late = true;
    }
#undef P5_TOPK
#define P5_DRAIN() do { if (cj & 1) { if (cpendB) conv8_finish(citB, cregB, cscr, lane); if (cpendA) conv8_finish(citA, cregA, cscr, lane); } \
                        else        { if (cpendA) conv8_finish(citA, cregA, cscr, lane); if (cpendB) conv8_finish(citB, cregB, cscr, lane); } } while (0)
    const int cwx6 = CW_SEAM + 1088 * 4, cwtop6 = cwx6 + 1024;
    const bool late = !tk_late && (!cpendA || citA.N == DM) && (!cpendB || citB.N == DM);
    if (!late) P5_DRAIN();
    if (late) asm volatile("s_waitcnt vmcnt(8)" ::: "memory"); else asm volatile("s_waitcnt vmcnt(0)" ::: "memory");
    LDS_WAIT(); __builtin_amdgcn_s_barrier();
    if (F.tid == 0) {
        const unsigned nloc = bar.st[0], old = xb_add(&ctl[cwx6 + 64 * (int)bar.x], 1u);
        if (old + 1u == nloc) { __builtin_amdgcn_fence(__ATOMIC_RELEASE, "agent"); asm volatile("s_waitcnt vmcnt(0)" ::: "memory"); xb_add(&ctl[cwtop6], 1u); }
    }
    if (late) P5_DRAIN();
    xcd_wait(bar, ctl, cwtop6);
#undef P5_DRAIN
#undef P5_PUMP
#undef P5_PUMP1
}

__device__ __forceinline__ void p6_topk(Frame& F) {
    LAS unsigned* cnt = (LAS unsigned*)F.lds;
    const int tid = F.tid, lane = F.lane, wid = F.wave;
    const float* AFF = (const float*)(F.ws + WS_AFF);
    int* TOK = (int*)(F.ws + WS_TOK); float* GATE = (float*)(F.ws + WS_GATE); int* SLOT = (int*)(F.ws + WS_SLOT);
    for (int pair = F.vcu; pair < BATCH * NE; pair += F.G) {
        const int b = pair >> 4, e = pair & 15;
        const float* a = AFF + (size_t)pair * SEQ + 8 * tid;
        const f32x4 a0 = *(const f32x4*)a, a1 = *(const f32x4*)(a + 4);
        unsigned key[8];
#pragma unroll
        for (int j = 0; j < 4; ++j) { key[j] = __float_as_uint(a0[j]); key[4 + j] = __float_as_uint(a1[j]); }
        unsigned prefix = 0u;
        __syncthreads();
#pragma unroll 1
        for (int sft = 28; sft >= 0; sft -= 2) {
            const unsigned c1 = prefix | (1u << sft), c2 = prefix | (2u << sft), c3 = prefix | (3u << sft);
            unsigned n1 = 0, n2 = 0, n3 = 0;
#pragma unroll
            for (int j = 0; j < 8; ++j) { n1 += (unsigned)__popcll(__ballot(key[j] >= c1)); n2 += (unsigned)__popcll(__ballot(key[j] >= c2)); n3 += (unsigned)__popcll(__ballot(key[j] >= c3)); }
            LAS unsigned* cc = cnt + ((sft & 2) ? 24 : 0);
            if (lane == 0) { cc[wid] = n1; cc[8 + wid] = n2; cc[16 + wid] = n3; }
            __syncthreads();
            unsigned t1 = 0, t2 = 0, t3 = 0;
#pragma unroll
            for (int w = 0; w < 8; ++w) { t1 += cc[w]; t2 += cc[8 + w]; t3 += cc[16 + w]; }
            prefix = (t3 >= (unsigned)CAP) ? c3 : ((t2 >= (unsigned)CAP) ? c2 : ((t1 >= (unsigned)CAP) ? c1 : prefix));
        }
        unsigned cg = 0, ce = 0;
#pragma unroll
        for (int j = 0; j < 8; ++j) { cg += key[j] > prefix; ce += key[j] == prefix; }
        unsigned pk = (ce << 16) | cg, inc = pk;
#pragma unroll
        for (int o = 1; o < 64; o <<= 1) { const unsigned n = __shfl_up(inc, o); if (lane >= o) inc += n; }
        __syncthreads();
        LAS unsigned* ws_ = cnt + 48;
        if (lane == 63) ws_[wid] = inc;
        __syncthreads();
        unsigned base = 0, total = 0;
#pragma unroll
        for (int w = 0; w < 8; ++w) { const unsigned x = ws_[w]; if (w < wid) base += x; total += x; }
        const unsigned exc = base + inc - pk;
        unsigned gtb = exc & 0xffffu, eqb = exc >> 16;
        const unsigned need = (unsigned)CAP - (total & 0xffffu);
#pragma unroll
        for (int j = 0; j < 8; ++j) {
            const int sidx = 8 * tid + j; int slot = -1;
            if (key[j] > prefix) { slot = (int)(gtb + (eqb < need ? eqb : need)); ++gtb; }
            else if (key[j] == prefix) { if (eqb < need) slot = (int)(gtb + eqb); ++eqb; }
            SLOT[((size_t)(b * SEQ + sidx)) * NE + e] = slot;
            if (slot >= 0) { TOK[e * EROWS + b * CAP + slot] = b * SEQ + sidx; GATE[e * EROWS + b * CAP + slot] = __uint_as_float(key[j]); }
        }
        __syncthreads();
    }
}

__device__ __forceinline__ void p9_final(Frame& F) {
    const int gw = F.vcu * NWAVES + F.wave, NGW = F.G * NWAVES, lane = F.lane;
    const int* SLOT = (const int*)(F.ws + WS_SLOT); const unsigned char* YE = F.ws + WS_YE;
    f32x4 g[4];
#pragma unroll
    for (int j = 0; j < 4; ++j) g[j] = ((const f32x4*)F.g_final)[lane + 64 * j];
    int myslot = (gw < M) ? SLOT[(size_t)gw * NE + (lane & 15)] : -1;
    for (int t = gw; t < M; t += NGW) {
        f32x4* xr = (f32x4*)(F.out + (size_t)t * DM) + lane;
        const u32x2* xi = (const u32x2*)((const h16*)(F.ws + WS_X1) + (size_t)t * DM) + lane;
        f32x4 v[4];
#pragma unroll
        for (int j = 0; j < 4; ++j) { const u32x2 w = __builtin_nontemporal_load(xi + 64 * j); v[j].x = h2f((unsigned short)(w.x & 0xffffu)); v[j].y = h2f((unsigned short)(w.x >> 16)); v[j].z = h2f((unsigned short)(w.y & 0xffffu)); v[j].w = h2f((unsigned short)(w.y >> 16)); }
        const int slot_cur = myslot;
        const int tn = t + NGW;
        myslot = (tn < M) ? SLOT[(size_t)tn * NE + (lane & 15)] : -1;
        unsigned mask = (unsigned)(__ballot(slot_cur >= 0) & 0xffffull);
        const size_t ebase = (size_t)(t >> 12) * CAP;
        while (mask) {
            int e[4]; float w[4];
#pragma unroll
            for (int q = 0; q < 4; ++q) { const bool has = mask != 0u; e[q] = has ? (int)__builtin_ctz(mask) : e[0]; w[q] = has ? 1.f : 0.f; mask = has ? (mask & (mask - 1u)) : 0u; }
            unsigned y[4][4];
#pragma unroll
            for (int q = 0; q < 4; ++q) { const int sl = __builtin_amdgcn_readlane(slot_cur, e[q]);
                const unsigned* yr = (const unsigned*)(YE + ((size_t)e[q] * EROWS + ebase + sl) * DM) + lane;
#pragma unroll
                for (int j = 0; j < 4; ++j) y[q][j] = __builtin_nontemporal_load(yr + 64 * j); }
#pragma unroll
            for (int q = 0; q < 4; ++q) { const float wq = w[q] * (1.0f / S_YE);
#pragma unroll
                for (int j = 0; j < 4; ++j) { const auto lo2 = __builtin_amdgcn_cvt_pk_f32_fp8((int)y[q][j], false), hi2 = __builtin_amdgcn_cvt_pk_f32_fp8((int)y[q][j], true);
                    v[j].x += wq * lo2[0]; v[j].y += wq * lo2[1]; v[j].z += wq * hi2[0]; v[j].w += wq * hi2[1]; } }
        }
        float s = 0.f;
#pragma unroll
        for (int j = 0; j < 4; ++j) s += (v[j].x * v[j].x + v[j].y * v[j].y) + (v[j].z * v[j].z + v[j].w * v[j].w);
        const float rs = 1.0f / sqrtf(wave_sum(s) * (1.0f / DM) + NORM_EPS);
#pragma unroll
        for (int j = 0; j < 4; ++j) __builtin_nontemporal_store(v[j] * rs * g[j], xr + 64 * j);
    }
}

constexpr int NPHASE = 10;
struct Args { const float* in[13]; float* out; unsigned char* ws; int ph_lo, ph_hi, li, pad; };

__global__ void __launch_bounds__(NWAVES * 64, 2) mk_fwd(Args args) {
    extern __shared__ __attribute__((aligned(16))) unsigned char lds[];
    Frame F;
    F.lds = (LAS unsigned char*)lds;
    F.tid = threadIdx.x; F.lane = F.tid & 63; F.wave = __builtin_amdgcn_readfirstlane(F.tid >> 6);
    F.G = gridDim.x; { const int bx = blockIdx.x; F.vcu = (F.G % 8 == 0) ? (bx % 8) * (F.G / 8) + bx / 8 : bx; }
    F.x = args.in[0]; F.g_mix = args.in[1]; F.w_in = args.in[2]; F.a_sink = args.in[3]; F.g_out_a = args.in[4]; F.g_out_b = args.in[5]; F.w_out = args.in[6];
    F.g_ffn = args.in[7]; F.w_router = args.in[8]; F.w_gate = args.in[9]; F.w_up = args.in[10]; F.w_down = args.in[11]; F.g_final = args.in[12];
    F.out = args.out; F.ws = args.ws; F.tacc = 0;
    volatile LAS unsigned* MISC = (volatile LAS unsigned*)(F.lds + MISC_OFF);
    for (int u = F.tid; u < (LDS_BYTES - LDSCTL_OFF) / 4; u += NWAVES * 64) ((LAS unsigned*)(F.lds + LDSCTL_OFF))[u] = 0u;
    __syncthreads();
    const int lo = args.ph_lo, hi = args.ph_hi;
    const bool multi = (hi - lo) > 1;
    unsigned* barw = (unsigned*)(F.ws + WS_CTL) + CW_BAR + args.li * XCD_BAR_WORDS;
    XcdBarrier bar; bar.bar = barw; bar.x = 0; bar.st = nullptr;
    if (multi) bar = xcd_barrier_post(barw, MISC + 8);
#define IN(k) (((PH_MASK >> (k)) & 1) && lo <= (k) && (k) < hi)
#define SEAM(k) do { if (IN(k) && IN((k) + 1)) xcd_barrier(bar); } while (0)
#define TS0(k) do { if (TIME_PHASE == (k)) ts0_ = __builtin_amdgcn_s_memrealtime(); } while (0)
#define TS1(k) do { if (TIME_PHASE == (k)) ts1_ = __builtin_amdgcn_s_memrealtime(); } while (0)
    unsigned long long ts0_ = 0, ts1_ = 0;
#define REPS(k) for (int rep_ = 0; rep_ < 1 + ((REP_MASK >> (k)) & 1); ++rep_)
    unsigned long long tmx0_ = 0;
#define TMAX_BEGIN() do { if (TIME_PHASE >= 40) tmx0_ = __builtin_amdgcn_s_memrealtime(); } while (0)
#define TMAX_END(code) do { if (TIME_PHASE == (code) && F.tid == 0) __hip_atomic_fetch_max((unsigned*)(F.ws + WS_CTL) + 192, (unsigned)(__builtin_amdgcn_s_memrealtime() - tmx0_), __ATOMIC_RELAXED, __HIP_MEMORY_SCOPE_AGENT); } while (0)
#define TMIN_END(code) do { if (TIME_PHASE == (code) && F.tid == 0) __hip_atomic_fetch_max((unsigned*)(F.ws + WS_CTL) + 192, 1000000u - (unsigned)(__builtin_amdgcn_s_memrealtime() - tmx0_), __ATOMIC_RELAXED, __HIP_MEMORY_SCOPE_AGENT); } while (0)

    TS0(0);
    if (IN(0)) REPS(0) { p0_prologue(F); if (IN(0) && IN(1)) seam_work(F, bar, 0); }
    TS1(0);
    TS0(1);
    if (IN(1)) {
        pg8::DenseProb P{(const char*)(F.ws + WS_H), (const char*)(F.ws + WS_WIN), DM * 2};
        pg8::DenseOrder S; S.init(M, NIN - pg8::BM, F.G, (int)blockIdx.x, 1 + ((REP_MASK >> 1) & 1));
        pg8::EpiInProj E{(h16*)(F.ws + WS_PROJ), (const float*)(F.ws + WS_ROPE), (const float*)(F.ws + WS_RS)};
        TSEC_BEGIN(30); TMAX_BEGIN();
        pg8::gemm_phase<pg8::DenseProb, pg8::EpiInProj, pg8::DenseOrder, true>(F.lds, P, S, E);
        TSEC_END(30); TMAX_END(40); TMIN_END(42);
        TSEC_BEGIN(31);
        for (int u = F.vcu; u < (M / pg8::BM) * 4; u += F.G) pg8::tail_quarter(F.lds, P.A, P.Bt, E.O, E.rs, u);
        TSEC_END(31); TMAX_END(41); TMIN_END(43);
        if (IN(1) && IN(2)) seam_work(F, bar, 1);
    }
    TS1(1);
    TS0(2);
    if (IN(2)) REPS(2) { att::attn_phase(F); if (IN(2) && IN(3)) seam_work(F, bar, 2); }
    TS1(2);
    TS0(3);
    if (IN(3)) REPS(3) { p3_combine(F); if (IN(3) && IN(4)) seam_work(F, bar, 3); }
    TS1(3);
    TS0(4);
    if (IN(4)) {
        pg8::DenseProb P{(const char*)(F.ws + WS_MIXED), (const char*)(F.ws + WS_WOUT), DM * 2};
        pg8::DenseOrder S; S.init(M, DM, F.G, (int)blockIdx.x, 1 + ((REP_MASK >> 4) & 1));
        pg8::EpiResidual E{(const h16*)(F.ws + WS_H), (h16*)(F.ws + WS_X1)};
        pg8::gemm_phase<pg8::DenseProb, pg8::EpiResidual, pg8::DenseOrder, true>(F.lds, P, S, E);
        if (IN(4) && IN(5)) xcd_arrive(bar, (unsigned*)(F.ws + WS_CTL), CW_ARR2_X, CW_ARR2_TOP);
    }
    TS1(4);
    TS0(5);
    if (IN(5)) REPS(5) { TMAX_BEGIN(); p5_router(F, bar); if (TIME_PHASE == 48 || TIME_PHASE == 46) { asm volatile("s_waitcnt vmcnt(0)" ::: "memory"); __syncthreads(); } TMAX_END(48); TMIN_END(46); }
    TS1(5);
    TS0(6);
    if (IN(6)) { }
    TS1(6);
    TS0(7);
    if (IN(7)) {
        pg8::Moe1Prob P{(const char*)(F.ws + WS_H2), (const char*)(F.ws + WS_WGU), DM, (const int*)(F.ws + WS_TOK)};
        pg8::GroupOrder S; S.init(EROWS / 256, 4096 / 256, NE, F.G, F.vcu, 1 + ((REP_MASK >> 7) & 1));
        pg8::EpiSwiGLU E{F.ws + WS_HMID};
        pg8::gemm_phase<pg8::Moe1Prob, pg8::EpiSwiGLU, pg8::GroupOrder, true>(F.lds, P, S, E);
        SEAM(7);
    }
    TS1(7);
    TS0(8);
    if (IN(8)) {
        pg8::Moe2Prob P{(const char*)(F.ws + WS_HMID), (const char*)(F.ws + WS_WD), FF};
        pg8::GroupOrder S; S.init(EROWS / 256, DM / 256, NE, F.G, F.vcu, 1 + ((REP_MASK >> 8) & 1));
        pg8::EpiDown E{F.ws + WS_YE, (const float*)(F.ws + WS_GATE)};
        pg8::gemm_phase<pg8::Moe2Prob, pg8::EpiDown, pg8::GroupOrder, true>(F.lds, P, S, E);
        SEAM(8);
    }
    TS1(8);
    TS0(9);
    if (IN(9)) REPS(9) { p9_final(F); if (rep_ == 0 && ((REP_MASK >> 9) & 1)) xcd_barrier(bar); }
    TS1(9);
    if (TIME_PHASE >= 0 && blockIdx.x == 0 && F.tid == 0) { asm volatile("s_waitcnt vmcnt(0)" ::: "memory"); const unsigned tw_ = __hip_atomic_load((unsigned*)(F.ws + WS_CTL) + 192, __ATOMIC_RELAXED, __HIP_MEMORY_SCOPE_AGENT);
        const float tv_ = TIME_PHASE >= 40 ? ((TIME_PHASE & 2) ? (float)(1000000u - tw_) : (float)tw_) : (float)(TIME_PHASE >= 20 ? F.tacc : (ts1_ - ts0_));
        F.out[0] += tv_ * 0.01f * TIME_SCALE; }
#undef IN
#undef SEAM
}

extern "C" void kernel_launch(void* const* d_in, const int* in_sizes, int n_in, void* d_out, int out_size, void* d_ws, size_t ws_size, hipStream_t stream) {
    static int grid = 0;
    if (grid == 0) {
        if (n_in != 13 || in_sizes[0] != M * DM || out_size != M * DM || ws_size < WS_END) { fprintf(stderr, "kernel_launch: unexpected problem (n_in %d, ws %zu)\n", n_in, ws_size); grid = -1; return; }
        int dev = 0, cus = 0, per_cu = 0;
        if (hipGetDevice(&dev) != hipSuccess || hipDeviceGetAttribute(&cus, hipDeviceAttributeMultiprocessorCount, dev) != hipSuccess) { grid = -1; return; }
        if (hipFuncSetAttribute((const void*)mk_fwd, hipFuncAttributeMaxDynamicSharedMemorySize, LDS_BYTES) != hipSuccess) { fprintf(stderr, "kernel_launch: hipFuncSetAttribute failed\n"); grid = -1; return; }
        if (hipOccupancyMaxActiveBlocksPerMultiprocessor(&per_cu, (const void*)mk_fwd, NWAVES * 64, LDS_BYTES) != hipSuccess || per_cu < 1)
            fprintf(stderr, "kernel_launch: occupancy query reports %d blocks per CU\n", per_cu);
        (void)hipGetLastError();
        grid = cus;
    }
    if (grid < 0) return;
    (void)hipMemsetAsync((char*)d_ws + WS_CTL, 0, CTL_ZERO_BYTES, stream);
    Args a{};
    for (int i = 0; i < 13; ++i) a.in[i] = (const float*)d_in[i];
    a.out = (float*)d_out; a.ws = (unsigned char*)d_ws;
    if (MK_N_LAUNCHES == 1) {
        for (int pass = 0; pass < REP_ALL; ++pass) { a.ph_lo = 0; a.ph_hi = NPHASE; a.li = pass;
        hipLaunchKernelGGL(mk_fwd, dim3(grid), dim3(NWAVES * 64), LDS_BYTES, stream, a); }
    } else {
        for (int li = 0; li < NPHASE; ++li) { a.ph_lo = li; a.ph_hi = li + 1; a.li = 0;
            hipLaunchKernelGGL(mk_fwd, dim3(grid), dim3(NWAVES * 64), LDS_BYTES, stream, a); }
    }
}
```
